# Optimizing an MI355X kernel written in HIP

```python
import jax, jax.numpy as jnp
from jax import lax
import numpy as np

D_MODEL = 1024
BATCH = 8
SEQ = 4096
DEPTH = 2

PLE_DIM = 256
D_FF = 2752
M_HEADS = 4
M_HEAD_DIM = 256
M_WIDTH = M_HEADS * M_HEAD_DIM
M_CHUNK = 64
CONV_K = 4
A_Q_HEADS = 16
A_KV_HEADS = 4
A_HEAD_DIM = 64
A_GROUP = A_Q_HEADS // A_KV_HEADS
A_WIDTH = A_Q_HEADS * A_HEAD_DIM
A_KV_WIDTH = A_KV_HEADS * A_HEAD_DIM
WINDOW = 128
A_BLOCK = 128
EPS = 1e-6
N_IN = 4 * M_WIDTH + 2 * M_HEADS + A_WIDTH + 2 * A_KV_WIDTH + 2 * D_MODEL

kernel_name = "hybrid_mlstm_swa_macaron_ple"


def rmsnorm(x, g):
    xf = x.astype(jnp.float32)
    y = xf * lax.rsqrt(jnp.mean(xf * xf, axis=-1, keepdims=True) + EPS)
    return (y * g.astype(jnp.float32)).astype(x.dtype)


def head_rmsnorm(x, g):
    xf = x.astype(jnp.float32)
    y = xf * lax.rsqrt(jnp.mean(xf * xf, axis=-1, keepdims=True) + EPS)
    return y * g.astype(jnp.float32)


def swiglu(x, w_gate, w_up, w_down):
    return (jax.nn.silu(x @ w_gate) * (x @ w_up)) @ w_down


def causal_dwconv(x, w, b):
    c = x.shape[-1]
    y = lax.conv_general_dilated(x, w[:, None, :].astype(x.dtype), window_strides=(1,),
                                 padding=[(CONV_K - 1, 0)],
                                 dimension_numbers=("NWC", "WIO", "NWC"),
                                 feature_group_count=c)
    return y + b


def mlstm_chunkwise(q, k, v, ig, lf):
    bsz, t, nh, dh = q.shape
    nc = t // M_CHUNK

    def to_chunks(z):
        return z.reshape(bsz, nc, M_CHUNK, nh, dh).transpose(1, 0, 3, 2, 4)

    def g_chunks(z):
        return z.reshape(bsz, nc, M_CHUNK, nh).transpose(1, 0, 3, 2)

    causal = jnp.tril(jnp.ones((M_CHUNK, M_CHUNK), dtype=bool))

    def step(carry, xs):
        c_st, n_st, m_st = carry
        qc, kc, vc, ic, fc = xs
        b = jnp.cumsum(fc, axis=-1)
        dlog = jnp.where(causal, b[..., :, None] - b[..., None, :] + ic[..., None, :], -jnp.inf)
        inter = b + m_st[..., None]
        m_t = jnp.maximum(inter, jnp.max(dlog, axis=-1))
        w_intra = jnp.exp(dlog - m_t[..., None])
        w_inter = jnp.exp(inter - m_t)
        s = jnp.einsum("bhtk,bhsk->bhts", qc, kc) * w_intra
        num = jnp.einsum("bhts,bhsv->bhtv", s, vc) + w_inter[..., None] * jnp.einsum("bhtk,bhvk->bhtv", qc, c_st)
        den = jnp.sum(s, axis=-1) + w_inter * jnp.einsum("bhtk,bhk->bht", qc, n_st)
        h = num / jnp.maximum(jnp.abs(den), jnp.exp(-m_t))[..., None]
        b_last = b[..., -1]
        a = b_last[..., None] - b + ic
        m_new = jnp.maximum(b_last + m_st, jnp.max(a, axis=-1))
        w_state = jnp.exp(a - m_new[..., None])
        decay = jnp.exp(b_last + m_st - m_new)
        c_new = decay[..., None, None] * c_st + jnp.einsum("bhsv,bhsk->bhvk", vc * w_state[..., None], kc)
        n_new = decay[..., None] * n_st + jnp.einsum("bhs,bhsk->bhk", w_state, kc)
        return (c_new, n_new, m_new), h

    init = (jnp.zeros((bsz, nh, dh, dh), jnp.float32),
            jnp.zeros((bsz, nh, dh), jnp.float32),
            jnp.zeros((bsz, nh), jnp.float32))
    xs = (to_chunks(q), to_chunks(k), to_chunks(v), g_chunks(ig), g_chunks(lf))
    _, hs = lax.scan(step, init, xs)
    return hs.transpose(1, 0, 3, 2, 4).reshape(bsz, t, nh, dh)


def swa_gqa_sinks(q, k, v, sinks):
    bsz, t = q.shape[0], q.shape[1]
    nb = t // A_BLOCK
    qb = q.reshape(bsz, nb, A_BLOCK, A_KV_HEADS, A_GROUP, A_HEAD_DIM)

    def windows(z):
        zp = jnp.pad(z, ((0, 0), (A_BLOCK, 0), (0, 0), (0, 0)))
        zb = zp.reshape(bsz, nb + 1, A_BLOCK, A_KV_HEADS, A_HEAD_DIM)
        return jnp.concatenate([zb[:, :-1], zb[:, 1:]], axis=2)

    kw, vw = windows(k), windows(v)
    scores = jnp.einsum("bnqhgd,bnkhd->bnhgqk", qb, kw).astype(jnp.float32) * (A_HEAD_DIM ** -0.5)
    qi = jnp.arange(A_BLOCK)[:, None]
    kj = jnp.arange(2 * A_BLOCK)[None, :]
    rel = A_BLOCK + qi - kj
    band = (rel >= 0) & (rel < WINDOW)
    key_pos = jnp.arange(nb)[:, None, None] * A_BLOCK + kj[None] - A_BLOCK
    valid = band[None] & (key_pos >= 0)
    scores = jnp.where(valid[None, :, None, None], scores, -jnp.inf)
    sink = sinks.astype(jnp.float32).reshape(A_KV_HEADS, A_GROUP)[None, None, :, :, None, None]
    mx = jnp.maximum(jnp.max(scores, axis=-1, keepdims=True), sink)
    pr = jnp.exp(scores - mx)
    den = jnp.sum(pr, axis=-1, keepdims=True) + jnp.exp(sink - mx)
    attn = (pr / den).astype(v.dtype)
    out = jnp.einsum("bnhgqk,bnkhd->bnqhgd", attn, vw)
    return out.reshape(bsz, t, A_WIDTH)


def hybrid_layer(h, p_i, ffn1_norm, ffn1_w_gate, ffn1_w_up, ffn1_w_down, mix_norm, w_in,
                 m_conv_w, m_conv_b, m_igate_b, m_fgate_b, m_out_norm, a_q_norm, a_k_norm,
                 a_sinks, w_branch_m, w_branch_a, w_out, ffn2_norm, ffn2_w_gate, ffn2_w_up,
                 ffn2_w_down, ple_norm, ple_gate_w, ple_proj_w):
    bsz, t, _ = h.shape
    h = h + 0.5 * swiglu(rmsnorm(h, ffn1_norm), ffn1_w_gate, ffn1_w_up, ffn1_w_down)

    u = rmsnorm(h, mix_norm)
    z = u @ w_in
    sizes = [2 * M_WIDTH, M_WIDTH, M_WIDTH, M_HEADS, M_HEADS, A_WIDTH, A_KV_WIDTH, A_KV_WIDTH, D_MODEL, D_MODEL]
    offs = [int(o) for o in np.cumsum(sizes)[:-1]]
    m_qk, m_v, m_o, m_i, m_f, a_q, a_k, a_v, g_m, g_a = jnp.split(z, offs, axis=-1)

    m_qk = jax.nn.silu(causal_dwconv(m_qk, m_conv_w, m_conv_b))
    m_q, m_k = jnp.split(m_qk, 2, axis=-1)
    mq = m_q.astype(jnp.float32).reshape(bsz, t, M_HEADS, M_HEAD_DIM) * (M_HEAD_DIM ** -0.5)
    mk = m_k.astype(jnp.float32).reshape(bsz, t, M_HEADS, M_HEAD_DIM)
    mv = m_v.astype(jnp.float32).reshape(bsz, t, M_HEADS, M_HEAD_DIM)
    ig = m_i.astype(jnp.float32) + m_igate_b.astype(jnp.float32)
    lf = jax.nn.log_sigmoid(m_f.astype(jnp.float32) + m_fgate_b.astype(jnp.float32))
    hm = mlstm_chunkwise(mq, mk, mv, ig, lf)
    hm = head_rmsnorm(hm, m_out_norm.reshape(M_HEADS, M_HEAD_DIM)).reshape(bsz, t, M_WIDTH)
    hm = (jax.nn.sigmoid(m_o.astype(jnp.float32)) * hm).astype(h.dtype)

    aq = head_rmsnorm(a_q.reshape(bsz, t, A_Q_HEADS, A_HEAD_DIM), a_q_norm).astype(h.dtype)
    ak = head_rmsnorm(a_k.reshape(bsz, t, A_KV_HEADS, A_HEAD_DIM), a_k_norm).astype(h.dtype)
    av = a_v.reshape(bsz, t, A_KV_HEADS, A_HEAD_DIM)
    ha = swa_gqa_sinks(aq, ak, av, a_sinks)

    merged = jax.nn.sigmoid(g_m) * (hm @ w_branch_m) + jax.nn.sigmoid(g_a) * (ha @ w_branch_a)
    h = h + merged @ w_out

    h = h + 0.5 * swiglu(rmsnorm(h, ffn2_norm), ffn2_w_gate, ffn2_w_up, ffn2_w_down)

    h = h + jax.nn.sigmoid(rmsnorm(h, ple_norm) @ ple_gate_w) * (p_i @ ple_proj_w)
    return h


def setup_inputs(seed: int = 0) -> dict:
    key = jax.random.key(seed)
    ks = jax.random.split(key, 32)

    def w(k, fan_in, fan_out, scale=1.0):
        return jax.random.normal(k, (DEPTH, fan_in, fan_out), jnp.float32) * (scale * fan_in ** -0.5)

    def gain(k, n):
        return 1.0 + 0.05 * jax.random.normal(k, (DEPTH, n), jnp.float32)

    f_bias = jnp.linspace(3.0, 6.0, M_HEADS, dtype=jnp.float32)[None, :] + 0.1 * jax.random.normal(ks[10], (DEPTH, M_HEADS), jnp.float32)
    return {
        "x": jax.random.normal(ks[0], (BATCH, SEQ, D_MODEL), jnp.float32),
        "p": jax.random.normal(ks[1], (DEPTH, BATCH, SEQ, PLE_DIM), jnp.float32),
        "ffn1_norm": gain(ks[2], D_MODEL),
        "ffn1_w_gate": w(ks[3], D_MODEL, D_FF),
        "ffn1_w_up": w(ks[4], D_MODEL, D_FF),
        "ffn1_w_down": w(ks[5], D_FF, D_MODEL, 0.5),
        "mix_norm": gain(ks[6], D_MODEL),
        "w_in": w(ks[7], D_MODEL, N_IN),
        "m_conv_w": jax.random.normal(ks[8], (DEPTH, CONV_K, 2 * M_WIDTH), jnp.float32) * (CONV_K ** -0.5),
        "m_conv_b": 0.02 * jax.random.normal(ks[9], (DEPTH, 2 * M_WIDTH), jnp.float32),
        "m_igate_b": 0.1 * jax.random.normal(ks[11], (DEPTH, M_HEADS), jnp.float32),
        "m_fgate_b": f_bias,
        "m_out_norm": gain(ks[12], M_WIDTH),
        "a_q_norm": gain(ks[13], A_HEAD_DIM),
        "a_k_norm": gain(ks[14], A_HEAD_DIM),
        "a_sinks": 0.5 * jax.random.normal(ks[15], (DEPTH, A_Q_HEADS), jnp.float32),
        "w_branch_m": w(ks[16], M_WIDTH, D_MODEL),
        "w_branch_a": w(ks[17], A_WIDTH, D_MODEL),
        "w_out": w(ks[18], D_MODEL, D_MODEL, 0.5),
        "ffn2_norm": gain(ks[19], D_MODEL),
        "ffn2_w_gate": w(ks[20], D_MODEL, D_FF),
        "ffn2_w_up": w(ks[21], D_MODEL, D_FF),
        "ffn2_w_down": w(ks[22], D_FF, D_MODEL, 0.5),
        "ple_norm": gain(ks[23], D_MODEL),
        "ple_gate_w": w(ks[24], D_MODEL, D_MODEL),
        "ple_proj_w": w(ks[25], PLE_DIM, D_MODEL, 0.5),
    }


def reference(x, p, ffn1_norm, ffn1_w_gate, ffn1_w_up, ffn1_w_down, mix_norm, w_in,
              m_conv_w, m_conv_b, m_igate_b, m_fgate_b, m_out_norm, a_q_norm, a_k_norm,
              a_sinks, w_branch_m, w_branch_a, w_out, ffn2_norm, ffn2_w_gate, ffn2_w_up,
              ffn2_w_down, ple_norm, ple_gate_w, ple_proj_w):
    h = x
    for i in range(DEPTH):
        h = hybrid_layer(h, p[i], ffn1_norm[i], ffn1_w_gate[i], ffn1_w_up[i], ffn1_w_down[i],
                         mix_norm[i], w_in[i], m_conv_w[i], m_conv_b[i], m_igate_b[i],
                         m_fgate_b[i], m_out_norm[i], a_q_norm[i], a_k_norm[i], a_sinks[i],
                         w_branch_m[i], w_branch_a[i], w_out[i], ffn2_norm[i], ffn2_w_gate[i],
                         ffn2_w_up[i], ffn2_w_down[i], ple_norm[i], ple_gate_w[i], ple_proj_w[i])
    return h
```

```cpp
#include <hip/hip_runtime.h>
#include <hip/hip_cooperative_groups.h>
#include <cstdio>
#include <cstdint>
namespace cg = cooperative_groups;

#define LAS __attribute__((address_space(3)))
typedef unsigned short bf16;
typedef unsigned v4u __attribute__((ext_vector_type(4)));
typedef unsigned v2u __attribute__((ext_vector_type(2)));
typedef float f32x4 __attribute__((ext_vector_type(4)));
typedef short bf16x8 __attribute__((ext_vector_type(8)));
typedef short s16x4 __attribute__((ext_vector_type(4)));

constexpr int MROWS = 32768, DM = 1024, SEQ = 4096, NB = 8, DFF = 2752, DFFP = 2816, NIN = 7688, PLE = 256;
constexpr int ZW = 5632;
constexpr int ZC_V = 2048, ZC_O = 3072, ZC_AQ = 4096, ZC_AK = 5120, ZC_AV = 5376;
constexpr int NWIN = 7936;
constexpr float EPS = 1e-6f;
constexpr size_t MiB = 1u << 20;
constexpr size_t WS_WGU1 = 0, WS_WD1 = 11 * MiB, WS_WIN = 16 * MiB + 512 * 1024, WS_WA = 32 * MiB, WS_WB = 34 * MiB, WS_WOUT = 36 * MiB, WS_WPG = 38 * MiB,
                 WS_WP = 40 * MiB, WS_WGU2 = 40 * MiB + 512 * 1024, WS_WD2 = 51 * MiB + 512 * 1024;
constexpr size_t WS_ROWSS = 57 * MiB;
constexpr size_t WS_GIF = 59 * MiB;
constexpr size_t WS_Z = 62 * MiB;
constexpr size_t WS_HID = WS_Z, WS_PP = WS_Z + 178 * MiB, WS_HB2 = WS_Z + 242 * MiB;
constexpr size_t WS_HB = 414 * MiB;
constexpr size_t WS_PBF = 478 * MiB;
constexpr size_t WS_HALO = 494 * MiB;
constexpr size_t WS_RSA = 500 * MiB, WS_RSB = 502 * MiB;
constexpr size_t WS_END = 504 * MiB;
constexpr int LDS_BYTES = 147456;

typedef float f32x2_t __attribute__((ext_vector_type(2)));
typedef __bf16 bf16x2_t __attribute__((ext_vector_type(2)));
__device__ __forceinline__ unsigned cvt_pk_bf16(float lo, float hi) { f32x2_t v = {lo, hi}; bf16x2_t b = __builtin_convertvector(v, bf16x2_t); return __builtin_bit_cast(unsigned, b); }
__device__ __forceinline__ float bflo(unsigned w) { return __uint_as_float(w << 16); }
__device__ __forceinline__ float bfhi(unsigned w) { return __uint_as_float(w & 0xffff0000u); }
__device__ __forceinline__ float sigm(float x) { return __builtin_amdgcn_rcpf(1.0f + __expf(-x)); }
__device__ __forceinline__ float wave_sum(float v) {
#pragma unroll
    for (int o = 1; o < 64; o <<= 1) v += __shfl_xor(v, o);
    return v;
}
template <int CTRL, int ROWMASK> __device__ __forceinline__ float dppf(float old, float v) { return __int_as_float(__builtin_amdgcn_update_dpp(__float_as_int(old), __float_as_int(v), CTRL, ROWMASK, 0xf, false)); }
__device__ __forceinline__ float wave_scan_add(float v) {
    v += dppf<0x111, 0xf>(0.f, v); v += dppf<0x112, 0xf>(0.f, v); v += dppf<0x114, 0xf>(0.f, v); v += dppf<0x118, 0xf>(0.f, v);
    v += dppf<0x142, 0xa>(0.f, v); v += dppf<0x143, 0xc>(0.f, v); return v; }
__device__ __forceinline__ float wave_scan_max(float v) {
    const float I = -3.0e38f;
    v = fmaxf(v, dppf<0x111, 0xf>(I, v)); v = fmaxf(v, dppf<0x112, 0xf>(I, v)); v = fmaxf(v, dppf<0x114, 0xf>(I, v)); v = fmaxf(v, dppf<0x118, 0xf>(I, v));
    v = fmaxf(v, dppf<0x142, 0xa>(I, v)); v = fmaxf(v, dppf<0x143, 0xc>(I, v)); return v; }
#define LDS_WAIT() asm volatile("s_waitcnt lgkmcnt(0)" ::: "memory")
__device__ __forceinline__ int opaque_tid() { int t = threadIdx.x; asm volatile("" : "+v"(t)); return t; }

extern __shared__ __attribute__((aligned(16))) unsigned char g_lds[];
namespace pg8 {
constexpr int BM = 256, BK = 64, HALF = 128, HTB = HALF * BK * 2, STAGE_BYTES = 8 * HTB, NXCD = 8, WGM = 8;
constexpr int RSL_OFF = STAGE_BYTES;
__host__ __device__ __forceinline__ int lds_byte(int r, int c) { const int st = (r >> 4) * 2 + (c >> 5), rr = r & 15, cc = c & 31, ob = rr * 64 + cc * 2; return st * 1024 + (ob ^ (((ob >> 9) & 1) << 5)); }
__host__ __device__ __forceinline__ void stage_rc(int b, int& R, int& C) { const int st = b / 1024, sb = b % 1024, swz = sb ^ (((sb >> 9) & 1) << 5); R = (st >> 1) * 16 + swz / 64; C = (st & 1) * 32 + (swz % 64) / 2; }
__host__ __device__ __forceinline__ int perm32(int rho) { const int n = rho >> 4, i = rho & 15; return 8 * (i >> 2) + 4 * n + (i & 3); }
struct Unit { int pm, pn; };
struct Gemm { const bf16* A; const bf16* Bt; int M, N, K, lda, ldb; };
struct StaticOrder {
    int nM, nN, nwg, G, c;
    __device__ void init(int M, int N, int G_, int c_) { nM = M / BM; nN = N / BM; nwg = nM * nN; G = G_; c = c_; }
    __device__ bool next(int i, Unit& u) const {
        const int L = i * G + c; if (L >= nwg) return false;
        int wgid = L; { const int q = nwg / NXCD, r = nwg % NXCD, xcd = wgid % NXCD, off = wgid / NXCD; wgid = (xcd < r ? xcd * (q + 1) : r * (q + 1) + (xcd - r) * q) + off; }
        const int nig = WGM * nN, gid = wgid / nig, fm = gid * WGM, gsz = (nM - fm) < WGM ? (nM - fm) : WGM;
        u.pm = fm + ((wgid % nig) % gsz); u.pn = (wgid % nig) / gsz; return true;
    }
};
template <class Epi, bool ALIGN_EPI>
__device__ __forceinline__ void gemm_phase(LAS unsigned char* lds, const Gemm g, const StaticOrder& S, const Epi& E) {
    int tid_ = threadIdx.x; asm volatile("" : "+v"(tid_));
    const int tid = tid_, wid = __builtin_amdgcn_readfirstlane(tid >> 6), lane = tid & 63, wr = wid >> 2, wc = wid & 3, fr = lane & 15, fq = lane >> 4;
    const int K = g.K, nt = K / BK;
    unsigned voffA[2], voffB[2];
#pragma unroll
    for (int i = 0; i < 2; ++i) { int R, C; stage_rc(tid * 16 + i * 8192, R, C); const int Rb = Epi::PERM ? ((R & ~31) + perm32(R & 31)) : R;
        voffA[i] = (unsigned)(R * g.lda + C) * 2u; voffB[i] = (unsigned)(Rb * g.ldb + C) * 2u; }
    const size_t kstep = (size_t)(BK * 2);
    const size_t hstepA = (size_t)HALF * g.lda * 2, hstepB = (size_t)HALF * g.ldb * 2;
    const size_t tstepA = 2 * hstepA, tstepB = 2 * hstepB;
    const unsigned ldsw = (unsigned)wid * 1024u;
    const int aoff = lds_byte(wr * 64 + fr, fq * 8), boff = lds_byte(wc * 32 + fr, fq * 8);
#define PG8_SA(b, h) (((b) * 2 + (h)) * HTB)
#define PG8_SB(b, h) ((4 + (b) * 2 + (h)) * HTB)
#define PG8_STAGE(bufoff, gbase, voff) do { _Pragma("unroll") for (int _i = 0; _i < 2; ++_i) \
        __builtin_amdgcn_global_load_lds((const unsigned*)((const char*)(gbase) + (voff)[_i]), (LAS unsigned*)(lds + (bufoff) + ldsw + _i * 8192), 16, 0, 0); } while (0)
#define PG8_LDA(dst, b, h) do { _Pragma("unroll") for (int m = 0; m < 4; ++m) _Pragma("unroll") for (int k = 0; k < 2; ++k) dst[m][k] = *(const LAS bf16x8*)(lds + PG8_SA(b, h) + aoff + m * 2048 + k * 1024); } while (0)
#define PG8_LDB(dst, b, h) do { _Pragma("unroll") for (int n = 0; n < 2; ++n) _Pragma("unroll") for (int k = 0; k < 2; ++k) dst[n][k] = *(const LAS bf16x8*)(lds + PG8_SB(b, h) + boff + n * 2048 + k * 1024); } while (0)
#define PG8_MMA(ai, bj, At, Bt) do { __builtin_amdgcn_s_setprio(1); _Pragma("unroll") for (int m = 0; m < 4; ++m) _Pragma("unroll") for (int n = 0; n < 2; ++n) _Pragma("unroll") for (int k = 0; k < 2; ++k) \
        acc[ai][bj][m][n] = __builtin_amdgcn_mfma_f32_16x16x32_bf16(Bt[n][k], At[m][k], acc[ai][bj][m][n], 0, 0, 0); __builtin_amdgcn_s_setprio(0); } while (0)
#define PG8_WAIT_V(n) asm volatile("s_waitcnt vmcnt(" #n ")" ::: "memory")
#define PG8_WAIT_L(n) asm volatile("s_waitcnt lgkmcnt(" #n ")" ::: "memory")
#define PG8_BAR __builtin_amdgcn_s_barrier()
#define PG8_SCHED __builtin_amdgcn_sched_barrier(0)
    Unit cur, nxt; int ui = 0; int cpm = -1;
    if (!S.next(0, cur)) return;
    f32x4 acc[2][2][4][2];
#pragma unroll
    for (int a = 0; a < 2; ++a)
#pragma unroll
        for (int b = 0; b < 2; ++b)
#pragma unroll
            for (int m = 0; m < 4; ++m)
#pragma unroll
                for (int n = 0; n < 2; ++n) acc[a][b][m][n] = (f32x4){0.f, 0.f, 0.f, 0.f};
    bf16x8 At[4][2], B0[2][2], B1[2][2];
    const char* cA = (const char*)g.A + (size_t)cur.pm * tstepA; const char* cB = (const char*)g.Bt + (size_t)cur.pn * tstepB;
    PG8_STAGE(PG8_SB(0, 0), cB, voffB); PG8_STAGE(PG8_SB(0, 1), cB + hstepB, voffB); PG8_STAGE(PG8_SA(0, 0), cA, voffA); PG8_STAGE(PG8_SA(0, 1), cA + hstepA, voffA);
    if (wr == 1) PG8_BAR;
    PG8_WAIT_V(2); PG8_BAR;
    PG8_STAGE(PG8_SB(1, 0), cB + kstep, voffB); PG8_STAGE(PG8_SA(1, 0), cA + kstep, voffA); PG8_STAGE(PG8_SB(1, 1), cB + hstepB + kstep, voffB);
    PG8_WAIT_V(6); PG8_BAR;
    for (;;) {
        const bool has_next = S.next(ui + 1, nxt);
        const char* nA = has_next ? (const char*)g.A + (size_t)nxt.pm * tstepA : cA; const char* nB = has_next ? (const char*)g.Bt + (size_t)nxt.pn * tstepB : cB;
        for (int t = 0; t < nt; t += 2) {
            const bool last = (t == nt - 2);
            const char* a1 = cA + (size_t)(t + 1) * kstep;
            const char* a2 = last ? nA : cA + (size_t)(t + 2) * kstep; const char* b2 = last ? nB : cB + (size_t)(t + 2) * kstep;
            const char* a3 = a2 + kstep; const char* b3 = b2 + kstep;
            PG8_LDB(B0, 0, 0); PG8_LDB(B1, 0, 1); PG8_SCHED; PG8_LDA(At, 0, 0); PG8_STAGE(PG8_SA(1, 1), a1 + hstepA, voffA);
            PG8_WAIT_V(8); PG8_WAIT_L(0); PG8_BAR; PG8_MMA(0, 0, At, B0); PG8_MMA(0, 1, At, B1); PG8_BAR; PG8_SCHED;
            PG8_LDA(At, 0, 1); PG8_STAGE(PG8_SB(0, 0), b2, voffB); PG8_STAGE(PG8_SB(0, 1), b2 + hstepB, voffB); PG8_STAGE(PG8_SA(0, 0), a2, voffA);
            PG8_WAIT_V(8); PG8_WAIT_L(0); PG8_BAR; PG8_MMA(1, 0, At, B0); PG8_MMA(1, 1, At, B1); PG8_BAR; PG8_SCHED;
            PG8_LDB(B0, 1, 0); PG8_LDB(B1, 1, 1); PG8_SCHED; PG8_LDA(At, 1, 0); PG8_STAGE(PG8_SA(0, 1), a2 + hstepA, voffA);
            PG8_WAIT_V(8); PG8_WAIT_L(0); PG8_BAR; PG8_MMA(0, 0, At, B0); PG8_MMA(0, 1, At, B1); PG8_BAR; PG8_SCHED;
            PG8_LDA(At, 1, 1); PG8_STAGE(PG8_SB(1, 0), b3, voffB); PG8_STAGE(PG8_SB(1, 1), b3 + hstepB, voffB); PG8_STAGE(PG8_SA(1, 0), a3, voffA);
            PG8_WAIT_V(8); PG8_WAIT_L(0); PG8_BAR; PG8_MMA(1, 0, At, B0); PG8_MMA(1, 1, At, B1); PG8_BAR; PG8_SCHED;
        }
        if constexpr (ALIGN_EPI) { if (wr == 0) PG8_BAR; }
        if constexpr (Epi::USES_RS) {
            if (cur.pm != cpm) { cpm = cur.pm; const float* rp = E.rs_src();
#pragma unroll
                for (int j = 0; j < 2; ++j) { const int q = lane + 64 * j; const int row = cur.pm * 256 + (q >> 6) * 128 + wr * 64 + (q & 63);
                    const f32x4* p4 = (const f32x4*)(rp + (size_t)row * 16); const f32x4 t4 = (p4[0] + p4[1]) + (p4[2] + p4[3]);
                    ((LAS float*)(lds + RSL_OFF))[wid * 128 + q] = rsqrtf(((t4[0] + t4[1]) + (t4[2] + t4[3])) * (1.0f / 1024.0f) + 1e-6f); } }
        }
        E(acc, cur, wr, wc, fr, fq);
        if (!has_next) break;
#pragma unroll
        for (int a = 0; a < 2; ++a)
#pragma unroll
            for (int b = 0; b < 2; ++b)
#pragma unroll
                for (int m = 0; m < 4; ++m)
#pragma unroll
                    for (int n = 0; n < 2; ++n) acc[a][b][m][n] = (f32x4){0.f, 0.f, 0.f, 0.f};
        cur = nxt; cA = nA; cB = nB; ++ui;
        if constexpr (ALIGN_EPI) { if (wr == 1) PG8_BAR; }
    }
    PG8_WAIT_V(0);
    if constexpr (!ALIGN_EPI) { if (wr == 0) PG8_BAR; }
    PG8_BAR;
#undef PG8_SA
#undef PG8_SB
#undef PG8_STAGE
#undef PG8_LDA
#undef PG8_LDB
#undef PG8_MMA
#undef PG8_WAIT_V
#undef PG8_WAIT_L
#undef PG8_BAR
#undef PG8_SCHED
}
}

typedef const f32x4 (&AccRef)[2][2][4][2];
struct EpiSwiglu {
    static constexpr bool PERM = true, USES_RS = true;
    __device__ __forceinline__ const float* rs_src() const { return rowss; }
    bf16* O; const float* rowss;
    __device__ __forceinline__ void operator()(AccRef acc, const pg8::Unit& u, int, int, int, int) const {
        const int tid = opaque_tid(), wid = __builtin_amdgcn_readfirstlane(tid >> 6), wr = wid >> 2, wc = wid & 3, fr = tid & 15, fq = (tid & 63) >> 4;
        const int row0 = u.pm * 256 + wr * 64 + fr, col0 = u.pn * 128 + wc * 32 + 8 * fq;
#pragma unroll
        for (int ai = 0; ai < 2; ++ai)
#pragma unroll
            for (int m = 0; m < 4; ++m) {
                const int row = row0 + ai * 128 + m * 16; const float rs = ((const LAS float*)((LAS unsigned char*)g_lds + pg8::RSL_OFF))[wid * 128 + ai * 64 + m * 16 + fr];
                float o[8];
#pragma unroll
                for (int n = 0; n < 2; ++n)
#pragma unroll
                    for (int j = 0; j < 4; ++j) { const float gv = acc[ai][0][m][n][j] * rs, uv = acc[ai][1][m][n][j] * rs; o[n * 4 + j] = gv * sigm(gv) * uv; }
                v4u w; w.x = cvt_pk_bf16(o[0], o[1]); w.y = cvt_pk_bf16(o[2], o[3]); w.z = cvt_pk_bf16(o[4], o[5]); w.w = cvt_pk_bf16(o[6], o[7]);
                *(v4u*)(O + (size_t)row * DFFP + col0) = w; }
    }
};
template <int MODE> struct EpiRes {
    static constexpr bool PERM = false, USES_RS = (MODE == 1);
    __device__ __forceinline__ const float* rs_src() const { return rowss_in; }
    const float* hin; float* hout; bf16* hb; float* rowss_out; float alpha; const float* rowss_in; const bf16* pp;
    __device__ __forceinline__ void operator()(AccRef acc, const pg8::Unit& u, int, int, int, int) const {
        const int tid = opaque_tid(), wid = __builtin_amdgcn_readfirstlane(tid >> 6), wr = wid >> 2, wc = wid & 3, fr = tid & 15, fq = (tid & 63) >> 4;
        const int row0 = u.pm * 256 + wr * 64 + fr, col0 = u.pn * 256 + wc * 32 + 4 * fq;
#pragma unroll
        for (int ai = 0; ai < 2; ++ai)
#pragma unroll
            for (int m = 0; m < 4; ++m) {
                const int row = row0 + ai * 128 + m * 16; float ss = 0.f; float rs = 1.f;
                if (MODE == 1) rs = ((const LAS float*)((LAS unsigned char*)g_lds + pg8::RSL_OFF))[wid * 128 + ai * 64 + m * 16 + fr];
#pragma unroll
                for (int bj = 0; bj < 2; ++bj)
#pragma unroll
                    for (int n = 0; n < 2; ++n) {
                        const size_t off = (size_t)row * DM + col0 + bj * 128 + n * 16;
                        f32x4 h = *(const f32x4*)(hin + off); const f32x4 a = acc[ai][bj][m][n];
                        if (MODE == 0) h = h + a * alpha;
                        else { const v2u pw = *(const v2u*)(pp + off);
                            h[0] += sigm(a[0] * rs) * bflo(pw.x); h[1] += sigm(a[1] * rs) * bfhi(pw.x); h[2] += sigm(a[2] * rs) * bflo(pw.y); h[3] += sigm(a[3] * rs) * bfhi(pw.y); }
                        *(f32x4*)(hout + off) = h;
                        v2u w; w.x = cvt_pk_bf16(h[0], h[1]); w.y = cvt_pk_bf16(h[2], h[3]); *(v2u*)(hb + off) = w;
                        ss += (h[0] * h[0] + h[1] * h[1]) + (h[2] * h[2] + h[3] * h[3]); }
                ss += __shfl_xor(ss, 16); ss += __shfl_xor(ss, 32);
                if (fq == 0) rowss_out[(size_t)row * 16 + u.pn * 4 + wc] = ss;
                if (m == 3) asm volatile("" ::: "memory"); }
    }
};
template <int MODE> struct EpiBf {
    static constexpr bool PERM = true, USES_RS = (MODE == 1 || MODE == 4);
    __device__ __forceinline__ const float* rs_src() const { return rowss; }
    bf16* O; int ldo; const bf16* a1; int ld1; const bf16* a2; int ld2; const float* rowss; float* gif; bf16* halo;
    __device__ __forceinline__ void operator()(AccRef acc, const pg8::Unit& u, int, int, int, int) const {
        const int tid = opaque_tid(), wid = __builtin_amdgcn_readfirstlane(tid >> 6), wr = wid >> 2, wc = wid & 3, fr = tid & 15, fq = (tid & 63) >> 4;
        const int row0 = u.pm * 256 + wr * 64 + fr, col0 = u.pn * 256 + wc * 32 + 8 * fq;
        if (MODE == 4 && u.pn == 22) {
            if (wc == 0 && fq == 0) {
#pragma unroll
                for (int ai = 0; ai < 2; ++ai)
#pragma unroll
                    for (int m = 0; m < 4; ++m) { const int row = row0 + ai * 128 + m * 16; const float rs = ((const LAS float*)((LAS unsigned char*)g_lds + pg8::RSL_OFF))[wid * 128 + ai * 64 + m * 16 + fr];
                        *(f32x4*)(gif + (size_t)row * 8) = acc[ai][0][m][0] * rs; *(f32x4*)(gif + (size_t)row * 8 + 4) = acc[ai][0][m][1] * rs; }
            }
            return;
        }
        const bool sg = (MODE == 1) || (MODE == 4 && u.pn >= 12 && u.pn < 16);
#pragma unroll
        for (int ai = 0; ai < 2; ++ai)
#pragma unroll
            for (int m = 0; m < 4; ++m) {
                const int row = row0 + ai * 128 + m * 16; float rs = 1.f;
                if (MODE == 1 || MODE == 4) rs = ((const LAS float*)((LAS unsigned char*)g_lds + pg8::RSL_OFF))[wid * 128 + ai * 64 + m * 16 + fr];
#pragma unroll
                for (int bj = 0; bj < 2; ++bj) {
                    const int col = col0 + bj * 128; float o[8];
#pragma unroll
                    for (int n = 0; n < 2; ++n)
#pragma unroll
                        for (int j = 0; j < 4; ++j) o[n * 4 + j] = acc[ai][bj][m][n][j] * rs;
                    if (sg) {
#pragma unroll
                        for (int j = 0; j < 8; ++j) o[j] = sigm(o[j]); }
                    if (MODE == 2 || MODE == 3) {
                        const v4u x = *(const v4u*)(a1 + (size_t)row * ld1 + col);
                        float xf[8] = {bflo(x.x), bfhi(x.x), bflo(x.y), bfhi(x.y), bflo(x.z), bfhi(x.z), bflo(x.w), bfhi(x.w)};
                        if (MODE == 2) {
#pragma unroll
                            for (int j = 0; j < 8; ++j) o[j] *= xf[j]; }
                        else { const v4u y = *(const v4u*)(a2 + (size_t)row * ld2 + col);
                            float yf[8] = {bflo(y.x), bfhi(y.x), bflo(y.y), bfhi(y.y), bflo(y.z), bfhi(y.z), bflo(y.w), bfhi(y.w)};
#pragma unroll
                            for (int j = 0; j < 8; ++j) o[j] = xf[j] + yf[j] * o[j]; }
                    }
                    v4u w; w.x = cvt_pk_bf16(o[0], o[1]); w.y = cvt_pk_bf16(o[2], o[3]); w.z = cvt_pk_bf16(o[4], o[5]); w.w = cvt_pk_bf16(o[6], o[7]);
                    *(v4u*)(O + (size_t)row * ldo + col) = w;
                    if (MODE == 4 && m == 3) { if (u.pn < 8 && fr >= 13) *(v4u*)(halo + ((size_t)(row >> 6) * 3 + (fr - 13)) * 2048 + col) = w; } }
                if ((MODE == 2 || MODE == 3) && (m & 1)) asm volatile("" ::: "memory"); }
    }
};

struct Params { const float* in[26]; float* out; unsigned char* ws; int ph_lo, ph_hi; };
typedef const __attribute__((address_space(4))) unsigned char* KArg;
__device__ __forceinline__ KArg ka_get() { KArg k = (KArg)__builtin_amdgcn_kernarg_segment_ptr(); asm volatile("" : "+s"(k)); return k; }
__device__ __forceinline__ const float* ka_in(KArg k, int i) { return *(const float* const __attribute__((address_space(4)))*)(k + 8 * i); }
__device__ __forceinline__ float* ka_out(KArg k) { return *(float* const __attribute__((address_space(4)))*)(k + 208); }
__device__ __forceinline__ unsigned char* ka_ws(KArg k) { return *(unsigned char* const __attribute__((address_space(4)))*)(k + 216); }
static_assert(sizeof(Params) == 232, "kernarg layout");

template <int KIND>
__device__ __forceinline__ void tr_item(const float* src, const float* src2, int srcN, int Ksrc, const float* gain, bf16* WT, int Kd, int nblk, int item, LAS float* scr, int lane) {
    const int kb = item / nblk, nb = item % nblk, k0 = 64 * kb, n0 = 64 * nb;
    const int n = n0 + (lane & 15) * 4;
    const float* cp = nullptr;
    if (KIND == 0) cp = src + n;
    if (KIND == 1) { const int hid = (n >> 8) * 128 + (n & 127); if (hid < DFF) cp = (((n >> 7) & 1) ? src2 : src) + hid; }
    if (KIND == 2) { if (n < 4096) cp = src + n; else if (n < 5632) cp = src + n + 8; else if (n < 5888) { if (n - 5632 < 8) cp = src + 4096 + (n - 5632); } else cp = src + 5640 + (n - 5888); }
    f32x4 v[16];
#pragma unroll
    for (int i = 0; i < 16; ++i) { const int k = k0 + 4 * i + (lane >> 4);
        v[i] = (cp != nullptr && k < Ksrc) ? *(const f32x4*)(cp + (size_t)k * srcN) : (f32x4){0.f, 0.f, 0.f, 0.f}; }
#pragma unroll
    for (int i = 0; i < 16; ++i) { LAS float* d = scr + (4 * i + (lane >> 4)) * 65 + (lane & 15) * 4; d[0] = v[i][0]; d[1] = v[i][1]; d[2] = v[i][2]; d[3] = v[i][3]; }
    LDS_WAIT(); asm volatile("" ::: "memory");
    const int c = lane & 7;
    float gk[8];
#pragma unroll
    for (int e = 0; e < 8; ++e) gk[e] = 1.0f;
    if (gain) { const f32x4 a = *(const f32x4*)(gain + k0 + 8 * c), b = *(const f32x4*)(gain + k0 + 8 * c + 4); gk[0] = a[0]; gk[1] = a[1]; gk[2] = a[2]; gk[3] = a[3]; gk[4] = b[0]; gk[5] = b[1]; gk[6] = b[2]; gk[7] = b[3]; }
#pragma unroll
    for (int j = 0; j < 8; ++j) { const int nn = (lane >> 3) + 8 * j; const LAS float* sp = scr + (8 * c) * 65 + nn;
        v4u o; o.x = cvt_pk_bf16(sp[0 * 65] * gk[0], sp[1 * 65] * gk[1]); o.y = cvt_pk_bf16(sp[2 * 65] * gk[2], sp[3 * 65] * gk[3]); o.z = cvt_pk_bf16(sp[4 * 65] * gk[4], sp[5 * 65] * gk[5]); o.w = cvt_pk_bf16(sp[6 * 65] * gk[6], sp[7 * 65] * gk[7]);
        *(v4u*)(WT + (size_t)(n0 + nn) * Kd + k0 + 8 * c) = o; }
    LDS_WAIT(); asm volatile("" ::: "memory");
}

__device__ __forceinline__ void phase_convert(KArg P, int L, LAS unsigned char* lds, int vcu, int G) {
    const int tid = opaque_tid(); const int lane = tid & 63, wave = tid >> 6;
    LAS float* scr = (LAS float*)(lds + wave * 16640);
    const int gw = vcu * 8 + wave, NGW = G * 8;
    unsigned char* ws = ka_ws(P);
    constexpr int I_GU = 16 * 88, I_D = 44 * 16, I_IN = 16 * 124, I_SQ = 16 * 16, I_P = 4 * 16;
    const size_t oGU = (size_t)L * DM * DFF, oSQ = (size_t)L * DM * DM;
    int off = 0;
#define CONV_LOOP(ITEMS, CALL) do { for (int it = (gw - off % NGW + NGW) % NGW; it < (ITEMS); it += NGW) { CALL; } off += (ITEMS); } while (0)
    CONV_LOOP(I_GU, tr_item<1>(ka_in(P, 3) + oGU, ka_in(P, 4) + oGU, DFF, DM, ka_in(P, 2) + L * DM, (bf16*)(ws + WS_WGU1), DM, 88, it, scr, lane));
    CONV_LOOP(I_D,  tr_item<0>(ka_in(P, 5) + oGU, nullptr, DM, DFF, nullptr, (bf16*)(ws + WS_WD1), DFFP, 16, it, scr, lane));
    CONV_LOOP(I_IN, tr_item<2>(ka_in(P, 7) + (size_t)L * DM * NIN, nullptr, NIN, DM, ka_in(P, 6) + L * DM, (bf16*)(ws + WS_WIN), DM, 124, it, scr, lane));
    CONV_LOOP(I_SQ, tr_item<0>(ka_in(P, 16) + oSQ, nullptr, DM, DM, nullptr, (bf16*)(ws + WS_WA), DM, 16, it, scr, lane));
    CONV_LOOP(I_SQ, tr_item<0>(ka_in(P, 17) + oSQ, nullptr, DM, DM, nullptr, (bf16*)(ws + WS_WB), DM, 16, it, scr, lane));
    CONV_LOOP(I_SQ, tr_item<0>(ka_in(P, 18) + oSQ, nullptr, DM, DM, nullptr, (bf16*)(ws + WS_WOUT), DM, 16, it, scr, lane));
    CONV_LOOP(I_GU, tr_item<1>(ka_in(P, 20) + oGU, ka_in(P, 21) + oGU, DFF, DM, ka_in(P, 19) + L * DM, (bf16*)(ws + WS_WGU2), DM, 88, it, scr, lane));
    CONV_LOOP(I_D,  tr_item<0>(ka_in(P, 22) + oGU, nullptr, DM, DFF, nullptr, (bf16*)(ws + WS_WD2), DFFP, 16, it, scr, lane));
    CONV_LOOP(I_SQ, tr_item<0>(ka_in(P, 24) + oSQ, nullptr, DM, DM, ka_in(P, 23) + L * DM, (bf16*)(ws + WS_WPG), DM, 16, it, scr, lane));
    CONV_LOOP(I_P,  tr_item<0>(ka_in(P, 25) + (size_t)L * PLE * DM, nullptr, DM, PLE, nullptr, (bf16*)(ws + WS_WP), PLE, 16, it, scr, lane));
#undef CONV_LOOP
    const float* pl = ka_in(P, 1) + (size_t)L * MROWS * PLE; bf16* pbf = (bf16*)(ws + WS_PBF);
    for (int m0 = gw; m0 < MROWS; m0 += 4 * NGW) { f32x4 v[4];
#pragma unroll
        for (int k = 0; k < 4; ++k) { const int m = (m0 + k * NGW < MROWS) ? m0 + k * NGW : m0; v[k] = *(const f32x4*)(pl + (size_t)m * PLE + lane * 4); }
#pragma unroll
        for (int k = 0; k < 4; ++k) { const int m = m0 + k * NGW; if (m < MROWS) { v2u w; w.x = cvt_pk_bf16(v[k][0], v[k][1]); w.y = cvt_pk_bf16(v[k][2], v[k][3]); *(v2u*)(pbf + (size_t)m * PLE + lane * 4) = w; } } }
    if (L == 0) {
        float* rowss = (float*)(ws + WS_RSA); bf16* hb2 = (bf16*)(ws + WS_HB2); const float* x = ka_in(P, 0);
        for (int m0 = gw; m0 < MROWS; m0 += 2 * NGW) { f32x4 v[2][4];
#pragma unroll
            for (int k = 0; k < 2; ++k) { const int m = (m0 + k * NGW < MROWS) ? m0 + k * NGW : m0;
#pragma unroll
                for (int j = 0; j < 4; ++j) v[k][j] = *(const f32x4*)(x + (size_t)m * DM + j * 256 + lane * 4); }
#pragma unroll
            for (int k = 0; k < 2; ++k) { const int m = m0 + k * NGW; if (m >= MROWS) continue; float ss = 0.f;
#pragma unroll
                for (int j = 0; j < 4; ++j) { const f32x4 t = v[k][j];
                    v2u w; w.x = cvt_pk_bf16(t[0], t[1]); w.y = cvt_pk_bf16(t[2], t[3]); *(v2u*)(hb2 + (size_t)m * DM + j * 256 + lane * 4) = w;
                    ss += (t[0] * t[0] + t[1] * t[1]) + (t[2] * t[2] + t[3] * t[3]); }
                ss = wave_sum(ss); if (lane < 16) rowss[(size_t)m * 16 + lane] = (lane == 0) ? ss : 0.f; } }
    }
}

__device__ __forceinline__ void conv_pass(KArg P, int L, int vcu, int G) {
    const int tid = opaque_tid();
    bf16* Z = (bf16*)(ka_ws(P) + WS_Z); const bf16* halo = (const bf16*)(ka_ws(P) + WS_HALO);
    const float* cwp = ka_in(P, 8) + (size_t)L * 4 * 2048; const float* cbp = ka_in(P, 9) + (size_t)L * 2048;
    for (int rg = vcu * 2 + (tid >> 8); rg < 512; rg += 2 * G) {
        const int col = (tid & 255) * 8;
        float cw[4][8], cb[8];
#pragma unroll
        for (int j = 0; j < 4; ++j) { const f32x4 a = *(const f32x4*)(cwp + j * 2048 + col), b = *(const f32x4*)(cwp + j * 2048 + col + 4);
            cw[j][0] = a[0]; cw[j][1] = a[1]; cw[j][2] = a[2]; cw[j][3] = a[3]; cw[j][4] = b[0]; cw[j][5] = b[1]; cw[j][6] = b[2]; cw[j][7] = b[3]; }
        { const f32x4 a = *(const f32x4*)(cbp + col), b = *(const f32x4*)(cbp + col + 4); cb[0] = a[0]; cb[1] = a[1]; cb[2] = a[2]; cb[3] = a[3]; cb[4] = b[0]; cb[5] = b[1]; cb[6] = b[2]; cb[7] = b[3]; }
        v4u w0 = (v4u){0u, 0u, 0u, 0u}, w1 = w0, w2 = w0;
        if ((rg & 63) != 0) { const bf16* hp = halo + (size_t)(rg - 1) * 3 * 2048 + col; w0 = *(const v4u*)hp; w1 = *(const v4u*)(hp + 2048); w2 = *(const v4u*)(hp + 4096); }
        const float sc = (col < 1024) ? 0.0625f : 1.0f;
        bf16* zp = Z + (size_t)rg * 64 * ZW + col;
        for (int i0 = 0; i0 < 64; i0 += 8) {
            v4u x[8];
#pragma unroll
            for (int r = 0; r < 8; ++r) x[r] = *(const v4u*)(zp + (size_t)(i0 + r) * ZW);
#pragma unroll
            for (int r = 0; r < 8; ++r) {
                const v4u x3 = x[r]; float o[8];
#define CONV_E(e, W0, W1, W2, W3) o[e] = cb[e] + cw[0][e] * (W0) + cw[1][e] * (W1) + cw[2][e] * (W2) + cw[3][e] * (W3)
                CONV_E(0, bflo(w0.x), bflo(w1.x), bflo(w2.x), bflo(x3.x)); CONV_E(1, bfhi(w0.x), bfhi(w1.x), bfhi(w2.x), bfhi(x3.x));
                CONV_E(2, bflo(w0.y), bflo(w1.y), bflo(w2.y), bflo(x3.y)); CONV_E(3, bfhi(w0.y), bfhi(w1.y), bfhi(w2.y), bfhi(x3.y));
                CONV_E(4, bflo(w0.z), bflo(w1.z), bflo(w2.z), bflo(x3.z)); CONV_E(5, bfhi(w0.z), bfhi(w1.z), bfhi(w2.z), bfhi(x3.z));
                CONV_E(6, bflo(w0.w), bflo(w1.w), bflo(w2.w), bflo(x3.w)); CONV_E(7, bfhi(w0.w), bfhi(w1.w), bfhi(w2.w), bfhi(x3.w));
#undef CONV_E
#pragma unroll
                for (int e = 0; e < 8; ++e) o[e] = o[e] * sigm(o[e]) * sc;
                *(v4u*)(zp + (size_t)(i0 + r) * ZW) = (v4u){cvt_pk_bf16(o[0], o[1]), cvt_pk_bf16(o[2], o[3]), cvt_pk_bf16(o[4], o[5]), cvt_pk_bf16(o[6], o[7])};
                w0 = w1; w1 = w2; w2 = x3; }
        }
    }
}

constexpr int ML_QS = 0, ML_KS = 33792, ML_KT = 67584, ML_VT = 104448, ML_VWT = 109056, ML_CB = 113664, ML_PS = 130560, ML_FL = 139776;
constexpr int FL_A = 0, FL_MX = 64, FL_WIN = 128, FL_FLOOR = 192, FL_WST = 256, FL_SC = 320, FL_WSTB = 328, FL_GSZ = 360;
constexpr int FL_QN = 720;
constexpr int ML_NB = ML_FL + 784 * 4;
#define MFMA16(a, b, c) __builtin_amdgcn_mfma_f32_16x16x32_bf16((a), (b), (c), 0, 0, 0)

__device__ __forceinline__ void mlstm_unit(KArg P, int L, int b, int h, int vs, LAS unsigned char* lds) {
    const int tid = opaque_tid(), lane = tid & 63, w = __builtin_amdgcn_readfirstlane(tid >> 6), c = lane & 15, g = lane >> 4;
    bf16* Z = (bf16*)(ka_ws(P) + WS_Z); const float* gif = (const float*)(ka_ws(P) + WS_GIF);
    LAS float* FL = (LAS float*)(lds + ML_FL);
    const int cgp = lane, isk = cgp >> 5;
    const int zcol = (isk ? 1024 : 0) + h * 256 + (cgp & 31) * 8;
    const float bi = ka_in(P, 10)[L * 4 + h], bfg = ka_in(P, 11)[L * 4 + h];
    const size_t rowbase = (size_t)b * SEQ;
    for (int i = tid; i < 32 * 264 / 2; i += 512) ((LAS unsigned*)(lds + ML_CB))[i] = 0u;
    if (tid < 128) ((LAS unsigned*)(lds + ML_NB))[tid] = 0u;
    f32x4 Cn[2] = {(f32x4){0.f, 0.f, 0.f, 0.f}, (f32x4){0.f, 0.f, 0.f, 0.f}};
    f32x4 Cacc[2][2];
#pragma unroll
    for (int a = 0; a < 2; ++a)
#pragma unroll
        for (int d = 0; d < 2; ++d) Cacc[a][d] = (f32x4){0.f, 0.f, 0.f, 0.f};
    float m_st = 0.f;
    v4u raw[8]; v4u vraw = (v4u){0u, 0u, 0u, 0u}; float zi = 0.f, zf = 0.f;
    auto prefetch = [&](int ch) {
        const int t0 = ch * 64;
#pragma unroll
        for (int r = 0; r < 8; ++r) raw[r] = *(const v4u*)(Z + (rowbase + t0 + w * 8 + r) * ZW + zcol);
        if (tid < 256) vraw = *(const v4u*)(Z + (rowbase + t0 + (tid >> 2)) * ZW + ZC_V + h * 256 + vs * 32 + (tid & 3) * 8);
        if (tid >= 448) { zi = gif[(rowbase + t0 + lane) * 8 + h]; zf = gif[(rowbase + t0 + lane) * 8 + 4 + h]; }
    };
    auto gates = [&](LAS float* gb) {
        const float ig = zi + bi; const float xf = zf + bfg; const float lf = fminf(xf, 0.f) - __logf(1.0f + __expf(-fabsf(xf)));
        const float bsum = wave_scan_add(lf);
        const float a = ig - bsum; const float pm = wave_scan_max(a);
        const float Mx = fmaxf(m_st, pm);
        const float M63 = __int_as_float(__builtin_amdgcn_readlane(__float_as_int(Mx), 63)), blast = __int_as_float(__builtin_amdgcn_readlane(__float_as_int(bsum), 63));
        gb[FL_A + lane] = a; gb[FL_MX + lane] = Mx; gb[FL_WIN + lane] = __expf(m_st - Mx); gb[FL_FLOOR + lane] = __expf(-(bsum + Mx)); { const float wst = __expf(a - M63); gb[FL_WST + lane] = wst; ((LAS bf16*)(gb + FL_WSTB))[lane] = (bf16)(cvt_pk_bf16(wst, 0.f) & 0xffffu); }
        if (lane == 0) gb[FL_SC] = __expf(m_st - M63);
        m_st = blast + M63;
    };
    auto stage_qk = [&]() {
#pragma unroll
        for (int r = 0; r < 8; ++r) *(LAS v4u*)(lds + (isk ? ML_KS : ML_QS) + (w * 8 + r) * 528 + (cgp & 31) * 16) = raw[r];
    };
    auto stage_kt_v = [&](LAS float* gbn) {
        if (isk) {
#pragma unroll
            for (int e = 0; e < 8; ++e) {
                v4u t;
#define PKW(r) ((e >> 1) == 0 ? raw[r].x : (e >> 1) == 1 ? raw[r].y : (e >> 1) == 2 ? raw[r].z : raw[r].w)
                if (e & 1) { t.x = (PKW(0) >> 16) | (PKW(1) & 0xffff0000u); t.y = (PKW(2) >> 16) | (PKW(3) & 0xffff0000u); t.z = (PKW(4) >> 16) | (PKW(5) & 0xffff0000u); t.w = (PKW(6) >> 16) | (PKW(7) & 0xffff0000u); }
                else { t.x = (PKW(0) & 0xffffu) | (PKW(1) << 16); t.y = (PKW(2) & 0xffffu) | (PKW(3) << 16); t.z = (PKW(4) & 0xffffu) | (PKW(5) << 16); t.w = (PKW(6) & 0xffffu) | (PKW(7) << 16); }
#undef PKW
                *(LAS v4u*)(lds + ML_KT + ((cgp & 31) * 8 + e) * 144 + w * 16) = t; }
        }
        if (tid < 256) { const int s = tid >> 2, part = tid & 3; const float ws_ = gbn[FL_WST + s];
            const unsigned xs[4] = {vraw.x, vraw.y, vraw.z, vraw.w};
#pragma unroll
            for (int e = 0; e < 8; ++e) { const unsigned wd = xs[e >> 1]; const float v = (e & 1) ? bfhi(wd) : bflo(wd);
                *(LAS bf16*)(lds + ML_VT + (part * 8 + e) * 144 + s * 2) = (bf16)((e & 1) ? (wd >> 16) : (wd & 0xffffu));
                *(LAS bf16*)(lds + ML_VWT + (part * 8 + e) * 144 + s * 2) = (bf16)(cvt_pk_bf16(v * ws_, 0.f) & 0xffffu); } }
    };
    prefetch(0);
    if (w == 7) gates(FL);
    __syncthreads();
    stage_qk(); stage_kt_v(FL);
    __syncthreads();
    const int ttile = w >> 1, par = w & 1;
    for (int ch = 0; ch < 64; ++ch) {
        const int t0 = ch * 64;
        LAS float* GB = FL + (ch & 1) * FL_GSZ;
        if (ch + 1 < 64) prefetch(ch + 1);
        f32x4 accS0 = (f32x4){0.f, 0.f, 0.f, 0.f}, accS1 = accS0, accI = accS0, accN = accS0;
        const bf16x8 zero8 = (bf16x8){0, 0, 0, 0, 0, 0, 0, 0};
        {
            const LAS unsigned char* qp = lds + ML_QS + (ttile * 16 + c) * 528 + g * 16;
            const LAS unsigned char* k0p = lds + ML_KS + ((par * 2 + 0) * 16 + c) * 528 + g * 16;
            const LAS unsigned char* k1p = lds + ML_KS + ((par * 2 + 1) * 16 + c) * 528 + g * 16;
            const LAS unsigned char* cp = lds + ML_CB + (par * 16 + c) * 528 + g * 16;
#pragma unroll 2
            for (int kk = 0; kk < 8; ++kk) {
                const bf16x8 a = *(const LAS bf16x8*)(qp + kk * 64);
                const bf16x8 b0 = *(const LAS bf16x8*)(k0p + kk * 64), b1 = *(const LAS bf16x8*)(k1p + kk * 64), bc = *(const LAS bf16x8*)(cp + kk * 64);
                accS0 = MFMA16(a, b0, accS0); accS1 = MFMA16(a, b1, accS1); accI = MFMA16(a, bc, accI);
                { const bf16x8 bn = *(const LAS bf16x8*)(lds + ML_NB + kk * 64 + g * 16); accN = MFMA16(a, bn, accN); } }
#pragma unroll
            for (int r = 0; r < 4; ++r) { const int t = ttile * 16 + 4 * g + r; const float Mt = GB[FL_MX + t];
                const int s0 = (par * 2) * 16 + c, s1 = s0 + 16;
                const float w0 = (s0 <= t) ? __expf(GB[FL_A + s0] - Mt) : 0.f, w1 = (s1 <= t) ? __expf(GB[FL_A + s1] - Mt) : 0.f;
                *(LAS bf16*)(lds + ML_PS + t * 144 + s0 * 2) = (bf16)(cvt_pk_bf16(accS0[r] * w0, 0.f) & 0xffffu);
                *(LAS bf16*)(lds + ML_PS + t * 144 + s1 * 2) = (bf16)(cvt_pk_bf16(accS1[r] * w1, 0.f) & 0xffffu); }
        }
        __syncthreads();
        {
            f32x4 accP = (f32x4){0.f, 0.f, 0.f, 0.f}, accR = accP;
            const bf16x8 ones8 = (bf16x8){0x3f80, 0x3f80, 0x3f80, 0x3f80, 0x3f80, 0x3f80, 0x3f80, 0x3f80};
#pragma unroll
            for (int ks = 0; ks < 2; ++ks) {
                const bf16x8 a = *(const LAS bf16x8*)(lds + ML_PS + (ttile * 16 + c) * 144 + ks * 64 + g * 16);
                const bf16x8 bv = *(const LAS bf16x8*)(lds + ML_VT + (par * 16 + c) * 144 + ks * 64 + g * 16);
                accP = MFMA16(a, bv, accP); accR = MFMA16(a, ones8, accR); }
#pragma unroll
            for (int r = 0; r < 4; ++r) { const int t = ttile * 16 + 4 * g + r; const float wi = GB[FL_WIN + t];
                const float num = accP[r] + wi * accI[r]; const float den = accR[r] + wi * accN[r];
                const float hv = num * __builtin_amdgcn_rcpf(fmaxf(fabsf(den), GB[FL_FLOOR + t]));
                Z[(rowbase + t0 + t) * ZW + ZC_V + h * 256 + vs * 32 + par * 16 + c] = (bf16)(cvt_pk_bf16(hv, 0.f) & 0xffffu); }
            const float decay = GB[FL_SC];
            const LAS unsigned char* wsb = (const LAS unsigned char*)(GB + FL_WSTB);
#pragma unroll
            for (int kt = 0; kt < 2; ++kt) {
                bf16x8 bk[2];
#pragma unroll
                for (int ks = 0; ks < 2; ++ks) bk[ks] = *(const LAS bf16x8*)(lds + ML_KT + ((2 * w + kt) * 16 + c) * 144 + ks * 64 + g * 16);
#pragma unroll
                for (int vt = 0; vt < 2; ++vt) {
                    f32x4 cc = Cacc[kt][vt] * decay;
#pragma unroll
                    for (int ks = 0; ks < 2; ++ks) { const bf16x8 a = *(const LAS bf16x8*)(lds + ML_VWT + (vt * 16 + c) * 144 + ks * 64 + g * 16); cc = MFMA16(a, bk[ks], cc); }
                    Cacc[kt][vt] = cc;
#pragma unroll
                    for (int r = 0; r < 4; ++r) *(LAS bf16*)(lds + ML_CB + (vt * 16 + 4 * g + r) * 528 + ((2 * w + kt) * 16 + c) * 2) = (bf16)(cvt_pk_bf16(cc[r], 0.f) & 0xffffu);
                }
                f32x4 cn = Cn[kt] * decay;
#pragma unroll
                for (int ks = 0; ks < 2; ++ks) { const bf16x8 an = *(const LAS bf16x8*)(wsb + ks * 64 + g * 16); cn = MFMA16(an, bk[ks], cn); }
                Cn[kt] = cn;
                if (g == 0) *(LAS bf16*)(lds + ML_NB + ((2 * w + kt) * 16 + c) * 2) = (bf16)(cvt_pk_bf16(cn[0], 0.f) & 0xffffu);
            }
            if (w == 7 && ch + 1 < 64) gates(FL + ((ch + 1) & 1) * FL_GSZ);
            if (ch + 1 < 64) stage_qk();
        }
        __syncthreads();
        if (ch + 1 < 64) stage_kt_v(FL + ((ch + 1) & 1) * FL_GSZ);
    }
    __syncthreads();
}

constexpr int AT_K = 0, AT_VT = 36864;
__device__ __forceinline__ void attn_unit(KArg P, int L, int b, int nb, int kvh, LAS unsigned char* lds) {
    const int tid = opaque_tid(), lane = tid & 63, w = __builtin_amdgcn_readfirstlane(tid >> 6), c = lane & 15, g = lane >> 4;
    bf16* Z = (bf16*)(ka_ws(P) + WS_Z);
    const float* gq = ka_in(P, 13) + L * 64; const float* gk = ka_in(P, 14) + L * 64; const float* sinks = ka_in(P, 15) + L * 16;
    const size_t rowbase = (size_t)b * SEQ;
#pragma unroll
    for (int r = 0; r < 4; ++r) { const int item = tid + 512 * r, key = item >> 3, part = item & 7; const int t = nb * 128 - 128 + key;
        v4u kx = (v4u){0u, 0u, 0u, 0u}, vx = kx;
        if (t >= 0) { kx = *(const v4u*)(Z + (rowbase + t) * ZW + ZC_AK + kvh * 64 + part * 8); vx = *(const v4u*)(Z + (rowbase + t) * ZW + ZC_AV + kvh * 64 + part * 8); }
        float kf[8] = {bflo(kx.x), bfhi(kx.x), bflo(kx.y), bfhi(kx.y), bflo(kx.z), bfhi(kx.z), bflo(kx.w), bfhi(kx.w)};
        float ss = 0.f;
#pragma unroll
        for (int e = 0; e < 8; ++e) ss += kf[e] * kf[e];
        ss += __shfl_xor(ss, 1); ss += __shfl_xor(ss, 2); ss += __shfl_xor(ss, 4);
        const float rk = rsqrtf(ss * (1.0f / 64.0f) + EPS);
#pragma unroll
        for (int e = 0; e < 8; ++e) kf[e] = kf[e] * rk * gk[part * 8 + e];
        *(LAS v4u*)(lds + AT_K + key * 144 + part * 16) = (v4u){cvt_pk_bf16(kf[0], kf[1]), cvt_pk_bf16(kf[2], kf[3]), cvt_pk_bf16(kf[4], kf[5]), cvt_pk_bf16(kf[6], kf[7])};
        const unsigned xs[4] = {vx.x, vx.y, vx.z, vx.w};
#pragma unroll
        for (int e = 0; e < 8; ++e) { const unsigned wd = xs[e >> 1]; *(LAS bf16*)(lds + AT_VT + (part * 8 + e) * 528 + key * 2) = (bf16)((e & 1) ? (wd >> 16) : (wd & 0xffffu)); }
    }
    __syncthreads();
    const int tile0 = w & ~1;
    const int qi = 16 * w + c;
    for (int hg = 0; hg < 4; ++hg) {
        const int head = kvh * 4 + hg; const float sink = sinks[head];
        bf16* qrow = Z + (rowbase + nb * 128 + qi) * ZW + ZC_AQ + head * 64;
        bf16x8 qf[2];
        { const v4u x0 = *(const v4u*)(qrow + g * 8), x1 = *(const v4u*)(qrow + 32 + g * 8);
          float f[16] = {bflo(x0.x), bfhi(x0.x), bflo(x0.y), bfhi(x0.y), bflo(x0.z), bfhi(x0.z), bflo(x0.w), bfhi(x0.w), bflo(x1.x), bfhi(x1.x), bflo(x1.y), bfhi(x1.y), bflo(x1.z), bfhi(x1.z), bflo(x1.w), bfhi(x1.w)};
          float ss = 0.f;
#pragma unroll
          for (int e = 0; e < 16; ++e) ss += f[e] * f[e];
          ss += __shfl_xor(ss, 16); ss += __shfl_xor(ss, 32);
          const float rq = rsqrtf(ss * (1.0f / 64.0f) + EPS) * 0.125f;
#pragma unroll
          for (int e = 0; e < 8; ++e) { f[e] *= rq * gq[g * 8 + e]; f[8 + e] *= rq * gq[32 + g * 8 + e]; }
          v4u p0 = (v4u){cvt_pk_bf16(f[0], f[1]), cvt_pk_bf16(f[2], f[3]), cvt_pk_bf16(f[4], f[5]), cvt_pk_bf16(f[6], f[7])};
          v4u p1 = (v4u){cvt_pk_bf16(f[8], f[9]), cvt_pk_bf16(f[10], f[11]), cvt_pk_bf16(f[12], f[13]), cvt_pk_bf16(f[14], f[15])};
          qf[0] = __builtin_bit_cast(bf16x8, p0); qf[1] = __builtin_bit_cast(bf16x8, p1); }
        const int odd = w & 1;
        f32x4 sc[10]; float mx = sink;
#pragma unroll
        for (int tt = 0; tt < 10; ++tt) {
            f32x4 a = (f32x4){-1e30f, -1e30f, -1e30f, -1e30f};
            const bool empty = odd ? (tt == 0) : (tt == 9);
            if (!empty) {
                a = (f32x4){0.f, 0.f, 0.f, 0.f};
#pragma unroll
                for (int ks = 0; ks < 2; ++ks) { const bf16x8 kfr = *(const LAS bf16x8*)(lds + AT_K + ((tile0 + tt) * 16 + c) * 144 + ks * 64 + g * 16); a = MFMA16(kfr, qf[ks], a); }
                const bool partial = odd ? (tt == 1 || tt == 9) : (tt == 0 || tt == 8);
                if (partial || nb == 0) {
#pragma unroll
                    for (int r = 0; r < 4; ++r) { const int kj = (tile0 + tt) * 16 + 4 * g + r; const bool valid = (kj >= qi + 1) && (kj <= qi + 128) && (nb > 0 || kj >= 128);
                        a[r] = valid ? a[r] : -1e30f; } }
#pragma unroll
                for (int r = 0; r < 4; ++r) mx = fmaxf(mx, a[r]);
            }
            sc[tt] = a; }
        mx = fmaxf(mx, __shfl_xor(mx, 16)); mx = fmaxf(mx, __shfl_xor(mx, 32));
        float sum = 0.f;
#pragma unroll
        for (int tt = 0; tt < 10; ++tt)
#pragma unroll
            for (int r = 0; r < 4; ++r) { const float p = (sc[tt][r] > -1e29f) ? __expf(sc[tt][r] - mx) : 0.f; sc[tt][r] = p; sum += p; }
        sum += __shfl_xor(sum, 16); sum += __shfl_xor(sum, 32);
        const float inv = 1.0f / (sum + __expf(sink - mx));
        f32x4 oacc[4];
#pragma unroll
        for (int dt = 0; dt < 4; ++dt) oacc[dt] = (f32x4){0.f, 0.f, 0.f, 0.f};
#pragma unroll
        for (int u = 0; u < 5; ++u) {
            v4u pb = (v4u){cvt_pk_bf16(sc[2 * u][0], sc[2 * u][1]), cvt_pk_bf16(sc[2 * u][2], sc[2 * u][3]), cvt_pk_bf16(sc[2 * u + 1][0], sc[2 * u + 1][1]), cvt_pk_bf16(sc[2 * u + 1][2], sc[2 * u + 1][3])};
            const bf16x8 pfr = __builtin_bit_cast(bf16x8, pb);
#pragma unroll
            for (int dt = 0; dt < 4; ++dt) {
                const LAS unsigned char* vp = lds + AT_VT + (dt * 16 + c) * 528 + ((tile0 + 2 * u) * 16 + 4 * g) * 2;
                const v2u lo = *(const LAS v2u*)vp, hi = *(const LAS v2u*)(vp + 32);
                const v4u av = (v4u){lo.x, lo.y, hi.x, hi.y};
                oacc[dt] = MFMA16(__builtin_bit_cast(bf16x8, av), pfr, oacc[dt]); } }
#pragma unroll
        for (int dt = 0; dt < 4; ++dt) { const f32x4 o = oacc[dt] * inv; v2u wv; wv.x = cvt_pk_bf16(o[0], o[1]); wv.y = cvt_pk_bf16(o[2], o[3]);
            *(v2u*)(qrow + dt * 16 + 4 * g) = wv; }
    }
    __syncthreads();
}

__device__ __forceinline__ void phase_fin(KArg P, int L, int vcu, int G) {
    const int tid = opaque_tid(); const int lane = tid & 63, wave = tid >> 6; const int gw = vcu * 8 + wave, NGW = G * 8;
    bf16* Z = (bf16*)(ka_ws(P) + WS_Z); const float* gn = ka_in(P, 12) + L * DM;
    for (int base = gw; base < MROWS * 4; base += 4 * NGW) {
        v2u hv[4], ov[4]; f32x4 gv[4];
#pragma unroll
        for (int k = 0; k < 4; ++k) { int pair = base + k * NGW; if (pair >= MROWS * 4) pair = gw; const int row = pair >> 2, h = pair & 3;
            hv[k] = *(const v2u*)(Z + (size_t)row * ZW + ZC_V + h * 256 + lane * 4); ov[k] = *(const v2u*)(Z + (size_t)row * ZW + ZC_O + h * 256 + lane * 4);
            gv[k] = *(const f32x4*)(gn + h * 256 + lane * 4); }
#pragma unroll
        for (int k = 0; k < 4; ++k) { const int pair = base + k * NGW; if (pair >= MROWS * 4) continue; const int row = pair >> 2, h = pair & 3;
            const float x0 = bflo(hv[k].x), x1 = bfhi(hv[k].x), x2 = bflo(hv[k].y), x3 = bfhi(hv[k].y);
            const float ss = wave_sum((x0 * x0 + x1 * x1) + (x2 * x2 + x3 * x3));
            const float r = rsqrtf(ss * (1.0f / 256.0f) + EPS);
            v2u o; o.x = cvt_pk_bf16(bflo(ov[k].x) * x0 * r * gv[k][0], bfhi(ov[k].x) * x1 * r * gv[k][1]); o.y = cvt_pk_bf16(bflo(ov[k].y) * x2 * r * gv[k][2], bfhi(ov[k].y) * x3 * r * gv[k][3]);
            *(v2u*)(Z + (size_t)row * ZW + ZC_V + h * 256 + lane * 4) = o; } }
}


#define XB_TMO      128
#define XB_XCNT(j)  (256  + 64 * (j))
#define XB_XSUB(j)  (1280 + 64 * (j))
#define XB_XGEN(j)  (2304 + 64 * (j))
#define XB_TOP      3328
#define XB_TOPGEN   3392
#define XCD_BAR_WORDS 3456
#define XB_SPIN_CAP (1u << 24)
constexpr size_t WS_BAR = 60 * MiB;
constexpr int LDS_XB = 147400;
__device__ __forceinline__ unsigned xb_ld(unsigned* p)              { return __hip_atomic_load(p, __ATOMIC_RELAXED, __HIP_MEMORY_SCOPE_AGENT); }
__device__ __forceinline__ unsigned xb_add(unsigned* p, unsigned v) { return __hip_atomic_fetch_add(p, v, __ATOMIC_RELAXED, __HIP_MEMORY_SCOPE_AGENT); }
__device__ __forceinline__ unsigned xb_xcc_id() { return (unsigned)__builtin_amdgcn_s_getreg((3 << 11) | 20) & 0xFu; }
#define XB_SPIN(cond, bar) do { unsigned _sp = 0; while (cond) { __builtin_amdgcn_s_sleep(1); \
    if ((++_sp & 255u) == 0u) { if (xb_ld(&(bar)[XB_TMO])) break; if (_sp > XB_SPIN_CAP) { atomicAdd(&(bar)[XB_TMO], 1u); break; } } } } while (0)
__device__ __forceinline__ void xcd_barrier_complete(unsigned* bar, unsigned x, unsigned& nloc, unsigned& nx) {
    const unsigned G = gridDim.x * gridDim.y * gridDim.z;
    unsigned sum, cnt, mine, sp = 0u;
    for (;;) {
        sum = 0u; cnt = 0u; mine = 0u;
#pragma unroll
        for (unsigned j = 0; j < 16; ++j) { const unsigned c = xb_ld(&bar[XB_XCNT(j)]); sum += c; cnt += (c > 0u) ? 1u : 0u; mine = (j == x) ? c : mine; }
        if (sum == G) break;
        __builtin_amdgcn_s_sleep(1);
        if ((++sp & 255u) == 0u) { if (xb_ld(&bar[XB_TMO])) break; if (sp > XB_SPIN_CAP) { atomicAdd(&bar[XB_TMO], 1u); break; } }
    }
    nloc = mine > 0u ? mine : 1u; nx = cnt > 0u ? cnt : 1u;
}
__device__ __forceinline__ void xcd_barrier(unsigned* bar, volatile LAS unsigned* st) {
    asm volatile("s_waitcnt vmcnt(0)" ::: "memory");
    __syncthreads();
    if (threadIdx.x == 0) {
        const unsigned x = xb_xcc_id();
        __builtin_amdgcn_s_waitcnt(0);
        unsigned nloc = st[0], nx = st[1];
        if (nloc == 0u) { xcd_barrier_complete(bar, x, nloc, nx); st[0] = nloc; st[1] = nx; }
        const unsigned old = xb_add(&bar[XB_XSUB(x)], 1u);
        const unsigned gen = old / nloc;
        if (old + 1u == (gen + 1u) * nloc) {
            __builtin_amdgcn_fence(__ATOMIC_RELEASE, "agent");
            asm volatile("s_waitcnt vmcnt(0)" ::: "memory");
            const unsigned og = xb_add(&bar[XB_TOP], 1u);
            const unsigned tg = og / nx;
            if (og + 1u == (tg + 1u) * nx) xb_add(&bar[XB_TOPGEN], 1u);
            else XB_SPIN(xb_ld(&bar[XB_TOPGEN]) == tg, bar);
            __builtin_amdgcn_fence(__ATOMIC_ACQUIRE, "agent");
            xb_add(&bar[XB_XGEN(x)], 1u);
            asm volatile("s_waitcnt vmcnt(0)" ::: "memory");
        } else {
            XB_SPIN(xb_ld(&bar[XB_XGEN(x)]) == gen, bar);
            __builtin_amdgcn_fence(__ATOMIC_ACQUIRE, "agent");
            asm volatile("s_waitcnt vmcnt(0)" ::: "memory");
        }
    }
    __syncthreads();
}

constexpr int PH_PER_LAYER = 12;
#define PH_STOP 24
__global__ void __launch_bounds__(512, 2) hybrid_fwd(Params Pk) {
    LAS unsigned char* lds = (LAS unsigned char*)g_lds;
    cg::grid_group grid = cg::this_grid();
    if (threadIdx.x < 2) ((LAS unsigned*)(lds + LDS_XB))[threadIdx.x] = 0u;
    { const KArg P0 = ka_get(); unsigned* bar0 = (unsigned*)(ka_ws(P0) + WS_BAR); if (threadIdx.x == 0) (void)xb_add(&bar0[XB_XCNT(xb_xcc_id())], 1u); }
    __syncthreads();
    bool first = true;
    const int ph_lo = Pk.ph_lo, ph_hi = Pk.ph_hi;
    for (int ph = ph_lo; ph < ph_hi; ++ph) {
        if (!first) {
            if (ph_lo < 0) {
                asm volatile("s_waitcnt vmcnt(0) lgkmcnt(0)" ::: "memory"); grid.sync(); __builtin_amdgcn_fence(__ATOMIC_ACQUIRE, "agent"); asm volatile("s_waitcnt vmcnt(0)" ::: "memory");
            } else { const KArg Pb = ka_get(); xcd_barrier((unsigned*)(ka_ws(Pb) + WS_BAR), (volatile LAS unsigned*)(lds + LDS_XB)); }
        }
        first = false;
        const KArg P = ka_get();
        unsigned char* ws = ka_ws(P); float* out = ka_out(P); int G = gridDim.x, bx = blockIdx.x;
        asm volatile("" : "+s"(G), "+s"(bx));
        const int vcu = (G % 8 == 0) ? (bx % 8) * (G / 8) + bx / 8 : bx;
        bf16* Z = (bf16*)(ws + WS_Z); bf16* HB = (bf16*)(ws + WS_HB); bf16* HB2 = (bf16*)(ws + WS_HB2); bf16* HID = (bf16*)(ws + WS_HID); bf16* PPb = (bf16*)(ws + WS_PP); bf16* T = HB;
        const int L = ph / PH_PER_LAYER, q = ph % PH_PER_LAYER;
        float* RSA = (float*)(ws + WS_RSA); float* RSB = (float*)(ws + WS_RSB);
        pg8::StaticOrder S;
        switch (q) {
                case 0: phase_convert(P, L, lds, vcu, G); break;
        case 1: { pg8::Gemm gm{HB2, (const bf16*)(ws + WS_WGU1), MROWS, 5632, DM, DM, DM}; S.init(MROWS, 5632, G, bx);
                  EpiSwiglu E{HID, RSA}; pg8::gemm_phase<EpiSwiglu, true>(lds, gm, S, E); } break;
        case 2: { pg8::Gemm gm{HID, (const bf16*)(ws + WS_WD1), MROWS, DM, DFFP, DFFP, DFFP}; S.init(MROWS, DM, G, bx);
                  EpiRes<0> E{L == 0 ? ka_in(P, 0) : out, out, HB, RSB, 0.5f, nullptr, nullptr}; pg8::gemm_phase<EpiRes<0>, true>(lds, gm, S, E); } break;
        case 3: { pg8::Gemm gm{HB, (const bf16*)(ws + WS_WIN), MROWS, 5888, DM, DM, DM}; S.init(MROWS, 5888, G, bx);
                  EpiBf<4> E{Z, ZW, nullptr, 0, nullptr, 0, RSB, (float*)(ws + WS_GIF), (bf16*)(ws + WS_HALO)}; pg8::gemm_phase<EpiBf<4>, true>(lds, gm, S, E); } break;
        case 4: {
            conv_pass(P, L, vcu, G);
            for (int u = vcu; u < 1024; u += G) attn_unit(P, L, u >> 7, (u >> 2) & 31, u & 3, lds);
        } break;
        case 5: {
            for (int u = bx; u < 256; u += G) { const int bh = (u >> 6) * 8 + (u & 7), vs = (u >> 3) & 7; mlstm_unit(P, L, bh >> 2, bh & 3, vs, lds); }
        } break;
        case 6: { phase_fin(P, L, vcu, G);
                  pg8::Gemm gm{HB, (const bf16*)(ws + WS_WIN) + (size_t)5888 * DM, MROWS, 2048, DM, DM, DM}; S.init(MROWS, 2048, G, bx);
                  EpiBf<1> E{Z, ZW, nullptr, 0, nullptr, 0, RSB, nullptr, nullptr}; pg8::gemm_phase<EpiBf<1>, true>(lds, gm, S, E); } break;
        case 7: {
                  { pg8::Gemm gm{Z + ZC_V, (const bf16*)(ws + WS_WA), MROWS, DM, DM, ZW, DM}; S.init(MROWS, DM, G, bx);
                    EpiBf<2> E{T, DM, Z, ZW, nullptr, 0, nullptr, nullptr, nullptr}; pg8::gemm_phase<EpiBf<2>, true>(lds, gm, S, E); }
                  { pg8::Gemm gm{Z + ZC_AQ, (const bf16*)(ws + WS_WB), MROWS, DM, DM, ZW, DM}; S.init(MROWS, DM, G, bx);
                    EpiBf<3> E{Z, ZW, T, DM, Z + 1024, ZW, nullptr, nullptr, nullptr}; pg8::gemm_phase<EpiBf<3>, true>(lds, gm, S, E); } } break;
        case 8: { pg8::Gemm gm{Z, (const bf16*)(ws + WS_WOUT), MROWS, DM, DM, ZW, DM}; S.init(MROWS, DM, G, bx);
                  EpiRes<0> E{out, out, HB, RSA, 1.0f, nullptr, nullptr}; pg8::gemm_phase<EpiRes<0>, true>(lds, gm, S, E); } break;
        case 9: { pg8::Gemm gm{HB, (const bf16*)(ws + WS_WGU2), MROWS, 5632, DM, DM, DM}; S.init(MROWS, 5632, G, bx);
                  EpiSwiglu E{HID, RSA}; pg8::gemm_phase<EpiSwiglu, true>(lds, gm, S, E); } break;
        case 10: { { pg8::Gemm gm{HID, (const bf16*)(ws + WS_WD2), MROWS, DM, DFFP, DFFP, DFFP}; S.init(MROWS, DM, G, bx);
                     EpiRes<0> E{out, out, HB, RSB, 0.5f, nullptr, nullptr}; pg8::gemm_phase<EpiRes<0>, true>(lds, gm, S, E); }
                   { pg8::Gemm gm{(const bf16*)(ws + WS_PBF), (const bf16*)(ws + WS_WP), MROWS, DM, PLE, PLE, PLE}; S.init(MROWS, DM, G, bx);
                     EpiBf<0> E{PPb, DM, nullptr, 0, nullptr, 0, nullptr, nullptr}; pg8::gemm_phase<EpiBf<0>, true>(lds, gm, S, E); } } break;
        case 11: { pg8::Gemm gm{HB, (const bf16*)(ws + WS_WPG), MROWS, DM, DM, DM, DM}; S.init(MROWS, DM, G, bx);
                   EpiRes<1> E{out, out, HB2, RSA, 1.0f, RSB, PPb}; pg8::gemm_phase<EpiRes<1>, true>(lds, gm, S, E); } break;
        }
    }
}

extern "C" void kernel_launch(void* const* d_in, const int* in_sizes, int n_in, void* d_out, int out_size, void* d_ws, size_t ws_size, hipStream_t stream) {
    static int grid = 0;
    if (grid == 0) {
        if (n_in != 26 || out_size != MROWS * DM || ws_size < WS_END) { fprintf(stderr, "kernel_launch: unexpected problem (n_in %d out %d ws %zu)\n", n_in, out_size, ws_size); grid = -1; return; }
        int dev = 0, cus = 0, per_cu = 0;
        hipGetDevice(&dev); hipDeviceGetAttribute(&cus, hipDeviceAttributeMultiprocessorCount, dev);
        hipFuncSetAttribute((const void*)hybrid_fwd, hipFuncAttributeMaxDynamicSharedMemorySize, LDS_BYTES);
        hipOccupancyMaxActiveBlocksPerMultiprocessor(&per_cu, (const void*)hybrid_fwd, 512, LDS_BYTES);
        if (per_cu < 1) { fprintf(stderr, "kernel_launch: occupancy query says %d blocks/CU\n", per_cu); per_cu = 1; }
        (void)hipGetLastError();
        grid = cus;
    }
    if (grid < 0) return;
    if (hipMemsetAsync((char*)d_ws + WS_BAR, 0, 16384, stream) != hipSuccess) { fprintf(stderr, "kernel_launch: memset of barrier words failed\n"); return; }
    Params p{};
    for (int i = 0; i < 26; ++i) p.in[i] = (const float*)d_in[i];
    p.out = (float*)d_out; p.ws = (unsigned char*)d_ws; p.ph_lo = 0; p.ph_hi = PH_STOP;
    void* args[] = {&p};
    hipError_t e = hipLaunchCooperativeKernel((const void*)hybrid_fwd, dim3(grid), dim3(512), args, LDS_BYTES, stream);
    if (e != hipSuccess) fprintf(stderr, "cooperative launch failed: %s (grid %d)\n", hipGetErrorString(e), grid);
}
```

```cpp
#include <hip/hip_runtime.h>
#include <hip/hip_cooperative_groups.h>
#include <cstdio>
#include <cstdint>
namespace cg = cooperative_groups;

#define LAS __attribute__((address_space(3)))
typedef unsigned short bf16;
typedef unsigned v4u __attribute__((ext_vector_type(4)));
typedef unsigned v2u __attribute__((ext_vector_type(2)));
typedef float f32x4 __attribute__((ext_vector_type(4)));
typedef short bf16x8 __attribute__((ext_vector_type(8)));
typedef short s16x4 __attribute__((ext_vector_type(4)));

constexpr int MROWS = 32768, DM = 1024, SEQ = 4096, NB = 8, DFF = 2752, DFFP = 2816, NIN = 7688, PLE = 256;
constexpr int ZW = 5632;
constexpr int ZC_V = 2048, ZC_O = 3072, ZC_AQ = 4096, ZC_AK = 5120, ZC_AV = 5376;
constexpr int NWIN = 7936;
constexpr float EPS = 1e-6f;
constexpr size_t MiB = 1u << 20;
constexpr size_t WS_WGU1 = 0, WS_WD1 = 11 * MiB, WS_WIN = 16 * MiB + 512 * 1024, WS_WA = 32 * MiB, WS_WB = 34 * MiB, WS_WOUT = 36 * MiB, WS_WPG = 38 * MiB,
                 WS_WP = 40 * MiB, WS_WGU2 = 40 * MiB + 512 * 1024, WS_WD2 = 51 * MiB + 512 * 1024;
constexpr size_t WS_ROWSS = 57 * MiB;
constexpr size_t WS_GIF = 59 * MiB;
constexpr size_t WS_Z = 62 * MiB;
constexpr size_t WS_HID = WS_Z, WS_PP = WS_Z + 178 * MiB, WS_HB2 = WS_Z + 242 * MiB;
constexpr size_t WS_HB = 414 * MiB;
constexpr size_t WS_PBF = 478 * MiB;
constexpr size_t WS_HALO = 494 * MiB;
constexpr size_t WS_RSA = 500 * MiB, WS_RSB = 502 * MiB;
constexpr size_t WS_END = 504 * MiB;
constexpr int LDS_BYTES = 147456;

typedef float f32x2_t __attribute__((ext_vector_type(2)));
typedef __bf16 bf16x2_t __attribute__((ext_vector_type(2)));
__device__ __forceinline__ unsigned cvt_pk_bf16(float lo, float hi) { f32x2_t v = {lo, hi}; bf16x2_t b = __builtin_convertvector(v, bf16x2_t); return __builtin_bit_cast(unsigned, b); }
__device__ __forceinline__ float bflo(unsigned w) { return __uint_as_float(w << 16); }
__device__ __forceinline__ float bfhi(unsigned w) { return __uint_as_float(w & 0xffff0000u); }
__device__ __forceinline__ float sigm(float x) { return __builtin_amdgcn_rcpf(1.0f + __expf(-x)); }
__device__ __forceinline__ float wave_sum(float v) {
#pragma unroll
    for (int o = 1; o < 64; o <<= 1) v += __shfl_xor(v, o);
    return v;
}
template <int CTRL, int ROWMASK> __device__ __forceinline__ float dppf(float old, float v) { return __int_as_float(__builtin_amdgcn_update_dpp(__float_as_int(old), __float_as_int(v), CTRL, ROWMASK, 0xf, false)); }
__device__ __forceinline__ float wave_scan_add(float v) {
    v += dppf<0x111, 0xf>(0.f, v); v += dppf<0x112, 0xf>(0.f, v); v += dppf<0x114, 0xf>(0.f, v); v += dppf<0x118, 0xf>(0.f, v);
    v += dppf<0x142, 0xa>(0.f, v); v += dppf<0x143, 0xc>(0.f, v); return v; }
__device__ __forceinline__ float wave_scan_max(float v) {
    const float I = -3.0e38f;
    v = fmaxf(v, dppf<0x111, 0xf>(I, v)); v = fmaxf(v, dppf<0x112, 0xf>(I, v)); v = fmaxf(v, dppf<0x114, 0xf>(I, v)); v = fmaxf(v, dppf<0x118, 0xf>(I, v));
    v = fmaxf(v, dppf<0x142, 0xa>(I, v)); v = fmaxf(v, dppf<0x143, 0xc>(I, v)); return v; }
__device__ __forceinline__ float wave_sum_dpp(float v) { return __int_as_float(__builtin_amdgcn_readlane(__float_as_int(wave_scan_add(v)), 63)); }
#define LDS_WAIT() asm volatile("s_waitcnt lgkmcnt(0)" ::: "memory")
__device__ __forceinline__ int opaque_tid() { int t = threadIdx.x; asm volatile("" : "+v"(t)); return t; }

extern __shared__ __attribute__((aligned(16))) unsigned char g_lds[];
namespace pg8 {
constexpr int BM = 256, BK = 64, HALF = 128, HTB = HALF * BK * 2, STAGE_BYTES = 8 * HTB, NXCD = 8, WGM = 8;
constexpr int RSL_OFF = STAGE_BYTES;
__host__ __device__ __forceinline__ int lds_byte(int r, int c) { const int st = (r >> 4) * 2 + (c >> 5), rr = r & 15, cc = c & 31, ob = rr * 64 + cc * 2; return st * 1024 + (ob ^ (((ob >> 9) & 1) << 5)); }
__host__ __device__ __forceinline__ void stage_rc(int b, int& R, int& C) { const int st = b / 1024, sb = b % 1024, swz = sb ^ (((sb >> 9) & 1) << 5); R = (st >> 1) * 16 + swz / 64; C = (st & 1) * 32 + (swz % 64) / 2; }
__host__ __device__ __forceinline__ int perm32(int rho) { const int n = rho >> 4, i = rho & 15; return 8 * (i >> 2) + 4 * n + (i & 3); }
struct Unit { int pm, pn; };
struct Gemm { const bf16* A; const bf16* Bt; int M, N, K, lda, ldb; };
struct StaticOrder {
    int nM, nN, nwg, G, c;
    __device__ void init(int M, int N, int G_, int c_) { nM = M / BM; nN = N / BM; nwg = nM * nN; G = G_; c = c_; }
    __device__ bool next(int i, Unit& u) const {
        const int L = i * G + c; if (L >= nwg) return false;
        int wgid = L; { const int q = nwg / NXCD, r = nwg % NXCD, xcd = wgid % NXCD, off = wgid / NXCD; wgid = (xcd < r ? xcd * (q + 1) : r * (q + 1) + (xcd - r) * q) + off; }
        const int nig = WGM * nN, gid = wgid / nig, fm = gid * WGM, gsz = (nM - fm) < WGM ? (nM - fm) : WGM;
        u.pm = fm + ((wgid % nig) % gsz); u.pn = (wgid % nig) / gsz; return true;
    }
};
template <class Epi, bool ALIGN_EPI>
__device__ __forceinline__ void gemm_phase(LAS unsigned char* lds, const Gemm g, const StaticOrder& S, const Epi& E) {
    int tid_ = threadIdx.x; asm volatile("" : "+v"(tid_));
    const int tid = tid_, wid = __builtin_amdgcn_readfirstlane(tid >> 6), lane = tid & 63, wr = wid >> 2, wc = wid & 3, fr = lane & 15, fq = lane >> 4;
    const int K = g.K, nt = K / BK;
    unsigned voffA[2], voffB[2];
#pragma unroll
    for (int i = 0; i < 2; ++i) { int R, C; stage_rc(tid * 16 + i * 8192, R, C); const int Rb = Epi::PERM ? ((R & ~31) + perm32(R & 31)) : R;
        voffA[i] = (unsigned)(R * g.lda + C) * 2u; voffB[i] = (unsigned)(Rb * g.ldb + C) * 2u; }
    const size_t kstep = (size_t)(BK * 2);
    const size_t hstepA = (size_t)HALF * g.lda * 2, hstepB = (size_t)HALF * g.ldb * 2;
    const size_t tstepA = 2 * hstepA, tstepB = 2 * hstepB;
    const unsigned ldsw = (unsigned)wid * 1024u;
    const int aoff = lds_byte(wr * 64 + fr, fq * 8), boff = lds_byte(wc * 32 + fr, fq * 8);
#define PG8_SA(b, h) (((b) * 2 + (h)) * HTB)
#define PG8_SB(b, h) ((4 + (b) * 2 + (h)) * HTB)
#define PG8_STAGE(bufoff, gbase, voff) do { _Pragma("unroll") for (int _i = 0; _i < 2; ++_i) \
        __builtin_amdgcn_global_load_lds((const unsigned*)((const char*)(gbase) + (voff)[_i]), (LAS unsigned*)(lds + (bufoff) + ldsw + _i * 8192), 16, 0, 0); } while (0)
#define PG8_LDA(dst, b, h) do { _Pragma("unroll") for (int m = 0; m < 4; ++m) _Pragma("unroll") for (int k = 0; k < 2; ++k) dst[m][k] = *(const LAS bf16x8*)(lds + PG8_SA(b, h) + aoff + m * 2048 + k * 1024); } while (0)
#define PG8_LDB(dst, b, h) do { _Pragma("unroll") for (int n = 0; n < 2; ++n) _Pragma("unroll") for (int k = 0; k < 2; ++k) dst[n][k] = *(const LAS bf16x8*)(lds + PG8_SB(b, h) + boff + n * 2048 + k * 1024); } while (0)
#define PG8_MMA(ai, bj, At, Bt) do { __builtin_amdgcn_s_setprio(1); _Pragma("unroll") for (int m = 0; m < 4; ++m) _Pragma("unroll") for (int n = 0; n < 2; ++n) _Pragma("unroll") for (int k = 0; k < 2; ++k) \
        acc[ai][bj][m][n] = __builtin_amdgcn_mfma_f32_16x16x32_bf16(Bt[n][k], At[m][k], acc[ai][bj][m][n], 0, 0, 0); __builtin_amdgcn_s_setprio(0); } while (0)
#define PG8_WAIT_V(n) asm volatile("s_waitcnt vmcnt(" #n ")" ::: "memory")
#define PG8_WAIT_L(n) asm volatile("s_waitcnt lgkmcnt(" #n ")" ::: "memory")
#define PG8_BAR __builtin_amdgcn_s_barrier()
#define PG8_SCHED __builtin_amdgcn_sched_barrier(0)
    Unit cur, nxt; int ui = 0; int cpm = -1;
    if (!S.next(0, cur)) return;
    f32x4 acc[2][2][4][2];
#pragma unroll
    for (int a = 0; a < 2; ++a)
#pragma unroll
        for (int b = 0; b < 2; ++b)
#pragma unroll
            for (int m = 0; m < 4; ++m)
#pragma unroll
                for (int n = 0; n < 2; ++n) acc[a][b][m][n] = (f32x4){0.f, 0.f, 0.f, 0.f};
    bf16x8 At[4][2], B0[2][2], B1[2][2];
    const char* cA = (const char*)g.A + (size_t)cur.pm * tstepA; const char* cB = (const char*)g.Bt + (size_t)cur.pn * tstepB;
    PG8_STAGE(PG8_SB(0, 0), cB, voffB); PG8_STAGE(PG8_SB(0, 1), cB + hstepB, voffB); PG8_STAGE(PG8_SA(0, 0), cA, voffA); PG8_STAGE(PG8_SA(0, 1), cA + hstepA, voffA);
    if (wr == 1) PG8_BAR;
    PG8_WAIT_V(2); PG8_BAR;
    PG8_STAGE(PG8_SB(1, 0), cB + kstep, voffB); PG8_STAGE(PG8_SA(1, 0), cA + kstep, voffA); PG8_STAGE(PG8_SB(1, 1), cB + hstepB + kstep, voffB);
    PG8_WAIT_V(6); PG8_BAR;
    for (;;) {
        const bool has_next = S.next(ui + 1, nxt);
        const char* nA = has_next ? (const char*)g.A + (size_t)nxt.pm * tstepA : cA; const char* nB = has_next ? (const char*)g.Bt + (size_t)nxt.pn * tstepB : cB;
        for (int t = 0; t < nt; t += 2) {
            const bool last = (t == nt - 2);
            const char* a1 = cA + (size_t)(t + 1) * kstep;
            const char* a2 = last ? nA : cA + (size_t)(t + 2) * kstep; const char* b2 = last ? nB : cB + (size_t)(t + 2) * kstep;
            const char* a3 = a2 + kstep; const char* b3 = b2 + kstep;
            PG8_LDB(B0, 0, 0); PG8_LDB(B1, 0, 1); PG8_SCHED; PG8_LDA(At, 0, 0); PG8_STAGE(PG8_SA(1, 1), a1 + hstepA, voffA);
            PG8_WAIT_V(8); PG8_WAIT_L(0); PG8_BAR; PG8_MMA(0, 0, At, B0); PG8_MMA(0, 1, At, B1); PG8_BAR; PG8_SCHED;
            PG8_LDA(At, 0, 1); PG8_STAGE(PG8_SB(0, 0), b2, voffB); PG8_STAGE(PG8_SB(0, 1), b2 + hstepB, voffB); PG8_STAGE(PG8_SA(0, 0), a2, voffA);
            PG8_WAIT_V(8); PG8_WAIT_L(0); PG8_BAR; PG8_MMA(1, 0, At, B0); PG8_MMA(1, 1, At, B1); PG8_BAR; PG8_SCHED;
            PG8_LDB(B0, 1, 0); PG8_LDB(B1, 1, 1); PG8_SCHED; PG8_LDA(At, 1, 0); PG8_STAGE(PG8_SA(0, 1), a2 + hstepA, voffA);
            PG8_WAIT_V(8); PG8_WAIT_L(0); PG8_BAR; PG8_MMA(0, 0, At, B0); PG8_MMA(0, 1, At, B1); PG8_BAR; PG8_SCHED;
            PG8_LDA(At, 1, 1); PG8_STAGE(PG8_SB(1, 0), b3, voffB); PG8_STAGE(PG8_SB(1, 1), b3 + hstepB, voffB); PG8_STAGE(PG8_SA(1, 0), a3, voffA);
            PG8_WAIT_V(8); PG8_WAIT_L(0); PG8_BAR; PG8_MMA(1, 0, At, B0); PG8_MMA(1, 1, At, B1); PG8_BAR; PG8_SCHED;
        }
        if constexpr (ALIGN_EPI) { if (wr == 0) PG8_BAR; }
        if constexpr (Epi::USES_RS) {
            if (cur.pm != cpm) { cpm = cur.pm; const float* rp = E.rs_src();
#pragma unroll
                for (int j = 0; j < 2; ++j) { const int q = lane + 64 * j; const int row = cur.pm * 256 + (q >> 6) * 128 + wr * 64 + (q & 63);
                    const f32x4* p4 = (const f32x4*)(rp + (size_t)row * 16); const f32x4 t4 = (p4[0] + p4[1]) + (p4[2] + p4[3]);
                    ((LAS float*)(lds + RSL_OFF))[wid * 128 + q] = rsqrtf(((t4[0] + t4[1]) + (t4[2] + t4[3])) * (1.0f / 1024.0f) + 1e-6f); } }
        }
        E(acc, cur, wr, wc, fr, fq);
        if (!has_next) break;
#pragma unroll
        for (int a = 0; a < 2; ++a)
#pragma unroll
            for (int b = 0; b < 2; ++b)
#pragma unroll
                for (int m = 0; m < 4; ++m)
#pragma unroll
                    for (int n = 0; n < 2; ++n) acc[a][b][m][n] = (f32x4){0.f, 0.f, 0.f, 0.f};
        cur = nxt; cA = nA; cB = nB; ++ui;
        if constexpr (ALIGN_EPI) { if (wr == 1) PG8_BAR; }
    }
    PG8_WAIT_V(0);
    if constexpr (!ALIGN_EPI) { if (wr == 0) PG8_BAR; }
    PG8_BAR;
#undef PG8_SA
#undef PG8_SB
#undef PG8_STAGE
#undef PG8_LDA
#undef PG8_LDB
#undef PG8_MMA
#undef PG8_WAIT_V
#undef PG8_WAIT_L
#undef PG8_BAR
#undef PG8_SCHED
}
}

typedef const f32x4 (&AccRef)[2][2][4][2];
struct EpiSwiglu {
    static constexpr bool PERM = true, USES_RS = true;
    __device__ __forceinline__ const float* rs_src() const { return rowss; }
    bf16* O; const float* rowss;
    __device__ __forceinline__ void operator()(AccRef acc, const pg8::Unit& u, int, int, int, int) const {
        const int tid = opaque_tid(), wid = __builtin_amdgcn_readfirstlane(tid >> 6), wr = wid >> 2, wc = wid & 3, fr = tid & 15, fq = (tid & 63) >> 4;
        const int row0 = u.pm * 256 + wr * 64 + fr, col0 = u.pn * 128 + wc * 32 + 8 * fq;
#pragma unroll
        for (int ai = 0; ai < 2; ++ai)
#pragma unroll
            for (int m = 0; m < 4; ++m) {
                const int row = row0 + ai * 128 + m * 16; const float rs = ((const LAS float*)((LAS unsigned char*)g_lds + pg8::RSL_OFF))[wid * 128 + ai * 64 + m * 16 + fr];
                float o[8];
#pragma unroll
                for (int n = 0; n < 2; ++n)
#pragma unroll
                    for (int j = 0; j < 4; ++j) { const float gv = acc[ai][0][m][n][j] * rs, uv = acc[ai][1][m][n][j] * rs; o[n * 4 + j] = gv * sigm(gv) * uv; }
                v4u w; w.x = cvt_pk_bf16(o[0], o[1]); w.y = cvt_pk_bf16(o[2], o[3]); w.z = cvt_pk_bf16(o[4], o[5]); w.w = cvt_pk_bf16(o[6], o[7]);
                *(v4u*)(O + (size_t)row * DFFP + col0) = w; }
    }
};
template <int MODE> struct EpiRes {
    static constexpr bool PERM = false, USES_RS = (MODE == 1);
    __device__ __forceinline__ const float* rs_src() const { return rowss_in; }
    const float* hin; float* hout; bf16* hb; float* rowss_out; float alpha; const float* rowss_in; const bf16* pp;
    __device__ __forceinline__ void operator()(AccRef acc, const pg8::Unit& u, int, int, int, int) const {
        const int tid = opaque_tid(), wid = __builtin_amdgcn_readfirstlane(tid >> 6), wr = wid >> 2, wc = wid & 3, fr = tid & 15, fq = (tid & 63) >> 4;
        const int row0 = u.pm * 256 + wr * 64 + fr, col0 = u.pn * 256 + wc * 32 + 4 * fq;
#pragma unroll
        for (int ai = 0; ai < 2; ++ai)
#pragma unroll
            for (int m = 0; m < 4; ++m) {
                const int row = row0 + ai * 128 + m * 16; float ss = 0.f; float rs = 1.f;
                if (MODE == 1) rs = ((const LAS float*)((LAS unsigned char*)g_lds + pg8::RSL_OFF))[wid * 128 + ai * 64 + m * 16 + fr];
#pragma unroll
                for (int bj = 0; bj < 2; ++bj)
#pragma unroll
                    for (int n = 0; n < 2; ++n) {
                        const size_t off = (size_t)row * DM + col0 + bj * 128 + n * 16;
                        f32x4 h = *(const f32x4*)(hin + off); const f32x4 a = acc[ai][bj][m][n];
                        if (MODE == 0) h = h + a * alpha;
                        else { const v2u pw = *(const v2u*)(pp + off);
                            h[0] += sigm(a[0] * rs) * bflo(pw.x); h[1] += sigm(a[1] * rs) * bfhi(pw.x); h[2] += sigm(a[2] * rs) * bflo(pw.y); h[3] += sigm(a[3] * rs) * bfhi(pw.y); }
                        *(f32x4*)(hout + off) = h;
                        v2u w; w.x = cvt_pk_bf16(h[0], h[1]); w.y = cvt_pk_bf16(h[2], h[3]); *(v2u*)(hb + off) = w;
                        ss += (h[0] * h[0] + h[1] * h[1]) + (h[2] * h[2] + h[3] * h[3]); }
                ss += __shfl_xor(ss, 16); ss += __shfl_xor(ss, 32);
                if (fq == 0) rowss_out[(size_t)row * 16 + u.pn * 4 + wc] = ss;
                if (m == 3) asm volatile("" ::: "memory"); }
    }
};
template <int MODE> struct EpiBf {
    static constexpr bool PERM = true, USES_RS = (MODE == 1 || MODE == 4);
    __device__ __forceinline__ const float* rs_src() const { return rowss; }
    bf16* O; int ldo; const bf16* a1; int ld1; const bf16* a2; int ld2; const float* rowss; float* gif; bf16* halo;
    __device__ __forceinline__ void operator()(AccRef acc, const pg8::Unit& u, int, int, int, int) const {
        const int tid = opaque_tid(), wid = __builtin_amdgcn_readfirstlane(tid >> 6), wr = wid >> 2, wc = wid & 3, fr = tid & 15, fq = (tid & 63) >> 4;
        const int row0 = u.pm * 256 + wr * 64 + fr, col0 = u.pn * 256 + wc * 32 + 8 * fq;
        if (MODE == 4 && u.pn == 22) {
            if (wc == 0 && fq == 0) {
#pragma unroll
                for (int ai = 0; ai < 2; ++ai)
#pragma unroll
                    for (int m = 0; m < 4; ++m) { const int row = row0 + ai * 128 + m * 16; const float rs = ((const LAS float*)((LAS unsigned char*)g_lds + pg8::RSL_OFF))[wid * 128 + ai * 64 + m * 16 + fr];
                        *(f32x4*)(gif + (size_t)row * 8) = acc[ai][0][m][0] * rs; *(f32x4*)(gif + (size_t)row * 8 + 4) = acc[ai][0][m][1] * rs; }
            }
            return;
        }
        const bool sg = (MODE == 1) || (MODE == 4 && u.pn >= 12 && u.pn < 16);
#pragma unroll
        for (int ai = 0; ai < 2; ++ai)
#pragma unroll
            for (int m = 0; m < 4; ++m) {
                const int row = row0 + ai * 128 + m * 16; float rs = 1.f;
                if (MODE == 1 || MODE == 4) rs = ((const LAS float*)((LAS unsigned char*)g_lds + pg8::RSL_OFF))[wid * 128 + ai * 64 + m * 16 + fr];
#pragma unroll
                for (int bj = 0; bj < 2; ++bj) {
                    const int col = col0 + bj * 128; float o[8];
#pragma unroll
                    for (int n = 0; n < 2; ++n)
#pragma unroll
                        for (int j = 0; j < 4; ++j) o[n * 4 + j] = acc[ai][bj][m][n][j] * rs;
                    if (sg) {
#pragma unroll
                        for (int j = 0; j < 8; ++j) o[j] = sigm(o[j]); }
                    if (MODE == 2 || MODE == 3) {
                        const v4u x = *(const v4u*)(a1 + (size_t)row * ld1 + col);
                        float xf[8] = {bflo(x.x), bfhi(x.x), bflo(x.y), bfhi(x.y), bflo(x.z), bfhi(x.z), bflo(x.w), bfhi(x.w)};
                        if (MODE == 2) {
#pragma unroll
                            for (int j = 0; j < 8; ++j) o[j] *= xf[j]; }
                        else { const v4u y = *(const v4u*)(a2 + (size_t)row * ld2 + col);
                            float yf[8] = {bflo(y.x), bfhi(y.x), bflo(y.y), bfhi(y.y), bflo(y.z), bfhi(y.z), bflo(y.w), bfhi(y.w)};
#pragma unroll
                            for (int j = 0; j < 8; ++j) o[j] = xf[j] + yf[j] * o[j]; }
                    }
                    v4u w; w.x = cvt_pk_bf16(o[0], o[1]); w.y = cvt_pk_bf16(o[2], o[3]); w.z = cvt_pk_bf16(o[4], o[5]); w.w = cvt_pk_bf16(o[6], o[7]);
                    *(v4u*)(O + (size_t)row * ldo + col) = w;
                    if (MODE == 4 && m == 3) { if (u.pn < 8 && fr >= 13) *(v4u*)(halo + ((size_t)(row >> 6) * 3 + (fr - 13)) * 2048 + col) = w; } }
                if ((MODE == 2 || MODE == 3) && (m & 1)) asm volatile("" ::: "memory"); }
    }
};

struct Params { const float* in[26]; float* out; unsigned char* ws; int ph_lo, ph_hi; };
typedef const __attribute__((address_space(4))) unsigned char* KArg;
__device__ __forceinline__ KArg ka_get() { KArg k = (KArg)__builtin_amdgcn_kernarg_segment_ptr(); asm volatile("" : "+s"(k)); return k; }
__device__ __forceinline__ const float* ka_in(KArg k, int i) { return *(const float* const __attribute__((address_space(4)))*)(k + 8 * i); }
__device__ __forceinline__ float* ka_out(KArg k) { return *(float* const __attribute__((address_space(4)))*)(k + 208); }
__device__ __forceinline__ unsigned char* ka_ws(KArg k) { return *(unsigned char* const __attribute__((address_space(4)))*)(k + 216); }
static_assert(sizeof(Params) == 232, "kernarg layout");

template <int KIND>
__device__ __forceinline__ void tr_item(const float* src, const float* src2, int srcN, int Ksrc, const float* gain, bf16* WT, int Kd, int nblk, int item, LAS float* scr, int lane) {
    const int kb = item / nblk, nb = item % nblk, k0 = 64 * kb, n0 = 64 * nb;
    const int n = n0 + (lane & 15) * 4;
    const float* cp = nullptr;
    if (KIND == 0) cp = src + n;
    if (KIND == 1) { const int hid = (n >> 8) * 128 + (n & 127); if (hid < DFF) cp = (((n >> 7) & 1) ? src2 : src) + hid; }
    if (KIND == 2) { if (n < 4096) cp = src + n; else if (n < 5632) cp = src + n + 8; else if (n < 5888) { if (n - 5632 < 8) cp = src + 4096 + (n - 5632); } else cp = src + 5640 + (n - 5888); }
    f32x4 v[16];
#pragma unroll
    for (int i = 0; i < 16; ++i) { const int k = k0 + 4 * i + (lane >> 4);
        v[i] = (cp != nullptr && k < Ksrc) ? *(const f32x4*)(cp + (size_t)k * srcN) : (f32x4){0.f, 0.f, 0.f, 0.f}; }
#pragma unroll
    for (int i = 0; i < 16; ++i) { LAS float* d = scr + (4 * i + (lane >> 4)) * 65 + (lane & 15) * 4; d[0] = v[i][0]; d[1] = v[i][1]; d[2] = v[i][2]; d[3] = v[i][3]; }
    LDS_WAIT(); asm volatile("" ::: "memory");
    const int c = lane & 7;
    float gk[8];
#pragma unroll
    for (int e = 0; e < 8; ++e) gk[e] = 1.0f;
    if (gain) { const f32x4 a = *(const f32x4*)(gain + k0 + 8 * c), b = *(const f32x4*)(gain + k0 + 8 * c + 4); gk[0] = a[0]; gk[1] = a[1]; gk[2] = a[2]; gk[3] = a[3]; gk[4] = b[0]; gk[5] = b[1]; gk[6] = b[2]; gk[7] = b[3]; }
#pragma unroll
    for (int j = 0; j < 8; ++j) { const int nn = (lane >> 3) + 8 * j; const LAS float* sp = scr + (8 * c) * 65 + nn;
        v4u o; o.x = cvt_pk_bf16(sp[0 * 65] * gk[0], sp[1 * 65] * gk[1]); o.y = cvt_pk_bf16(sp[2 * 65] * gk[2], sp[3 * 65] * gk[3]); o.z = cvt_pk_bf16(sp[4 * 65] * gk[4], sp[5 * 65] * gk[5]); o.w = cvt_pk_bf16(sp[6 * 65] * gk[6], sp[7 * 65] * gk[7]);
        *(v4u*)(WT + (size_t)(n0 + nn) * Kd + k0 + 8 * c) = o; }
    LDS_WAIT(); asm volatile("" ::: "memory");
}

__device__ __forceinline__ void phase_convert(KArg P, int L, LAS unsigned char* lds, int vcu, int G) {
    const int tid = opaque_tid(); const int lane = tid & 63, wave = tid >> 6;
    LAS float* scr = (LAS float*)(lds + wave * 16640);
    const int gw = vcu * 8 + wave, NGW = G * 8;
    unsigned char* ws = ka_ws(P);
    constexpr int I_GU = 16 * 88, I_D = 44 * 16, I_IN = 16 * 124, I_SQ = 16 * 16, I_P = 4 * 16;
    const size_t oGU = (size_t)L * DM * DFF, oSQ = (size_t)L * DM * DM;
    int off = 0;
#define CONV_LOOP(ITEMS, CALL) do { for (int it = (gw - off % NGW + NGW) % NGW; it < (ITEMS); it += NGW) { CALL; } off += (ITEMS); } while (0)
    CONV_LOOP(I_GU, tr_item<1>(ka_in(P, 3) + oGU, ka_in(P, 4) + oGU, DFF, DM, ka_in(P, 2) + L * DM, (bf16*)(ws + WS_WGU1), DM, 88, it, scr, lane));
    CONV_LOOP(I_D,  tr_item<0>(ka_in(P, 5) + oGU, nullptr, DM, DFF, nullptr, (bf16*)(ws + WS_WD1), DFFP, 16, it, scr, lane));
    CONV_LOOP(I_IN, tr_item<2>(ka_in(P, 7) + (size_t)L * DM * NIN, nullptr, NIN, DM, ka_in(P, 6) + L * DM, (bf16*)(ws + WS_WIN), DM, 124, it, scr, lane));
    CONV_LOOP(I_SQ, tr_item<0>(ka_in(P, 16) + oSQ, nullptr, DM, DM, nullptr, (bf16*)(ws + WS_WA), DM, 16, it, scr, lane));
    CONV_LOOP(I_SQ, tr_item<0>(ka_in(P, 17) + oSQ, nullptr, DM, DM, nullptr, (bf16*)(ws + WS_WB), DM, 16, it, scr, lane));
    CONV_LOOP(I_SQ, tr_item<0>(ka_in(P, 18) + oSQ, nullptr, DM, DM, nullptr, (bf16*)(ws + WS_WOUT), DM, 16, it, scr, lane));
    CONV_LOOP(I_GU, tr_item<1>(ka_in(P, 20) + oGU, ka_in(P, 21) + oGU, DFF, DM, ka_in(P, 19) + L * DM, (bf16*)(ws + WS_WGU2), DM, 88, it, scr, lane));
    CONV_LOOP(I_D,  tr_item<0>(ka_in(P, 22) + oGU, nullptr, DM, DFF, nullptr, (bf16*)(ws + WS_WD2), DFFP, 16, it, scr, lane));
    CONV_LOOP(I_SQ, tr_item<0>(ka_in(P, 24) + oSQ, nullptr, DM, DM, ka_in(P, 23) + L * DM, (bf16*)(ws + WS_WPG), DM, 16, it, scr, lane));
    CONV_LOOP(I_P,  tr_item<0>(ka_in(P, 25) + (size_t)L * PLE * DM, nullptr, DM, PLE, nullptr, (bf16*)(ws + WS_WP), PLE, 16, it, scr, lane));
#undef CONV_LOOP
    const float* pl = ka_in(P, 1) + (size_t)L * MROWS * PLE; bf16* pbf = (bf16*)(ws + WS_PBF);
    for (int m0 = gw; m0 < MROWS; m0 += 4 * NGW) { f32x4 v[4];
#pragma unroll
        for (int k = 0; k < 4; ++k) { const int m = (m0 + k * NGW < MROWS) ? m0 + k * NGW : m0; v[k] = *(const f32x4*)(pl + (size_t)m * PLE + lane * 4); }
#pragma unroll
        for (int k = 0; k < 4; ++k) { const int m = m0 + k * NGW; if (m < MROWS) { v2u w; w.x = cvt_pk_bf16(v[k][0], v[k][1]); w.y = cvt_pk_bf16(v[k][2], v[k][3]); *(v2u*)(pbf + (size_t)m * PLE + lane * 4) = w; } } }
    if (L == 0) {
        float* rowss = (float*)(ws + WS_RSA); bf16* hb2 = (bf16*)(ws + WS_HB2); const float* x = ka_in(P, 0);
        for (int m0 = gw; m0 < MROWS; m0 += 2 * NGW) { f32x4 v[2][4];
#pragma unroll
            for (int k = 0; k < 2; ++k) { const int m = (m0 + k * NGW < MROWS) ? m0 + k * NGW : m0;
#pragma unroll
                for (int j = 0; j < 4; ++j) v[k][j] = *(const f32x4*)(x + (size_t)m * DM + j * 256 + lane * 4); }
#pragma unroll
            for (int k = 0; k < 2; ++k) { const int m = m0 + k * NGW; if (m >= MROWS) continue; float ss = 0.f;
#pragma unroll
                for (int j = 0; j < 4; ++j) { const f32x4 t = v[k][j];
                    v2u w; w.x = cvt_pk_bf16(t[0], t[1]); w.y = cvt_pk_bf16(t[2], t[3]); *(v2u*)(hb2 + (size_t)m * DM + j * 256 + lane * 4) = w;
                    ss += (t[0] * t[0] + t[1] * t[1]) + (t[2] * t[2] + t[3] * t[3]); }
                ss = wave_sum_dpp(ss); if (lane < 16) rowss[(size_t)m * 16 + lane] = (lane == 0) ? ss : 0.f; } }
    }
}

__device__ __forceinline__ void conv_pass(KArg P, int L, int vcu, int G) {
    const int tid = opaque_tid();
    bf16* Z = (bf16*)(ka_ws(P) + WS_Z); const bf16* halo = (const bf16*)(ka_ws(P) + WS_HALO);
    const float* cwp = ka_in(P, 8) + (size_t)L * 4 * 2048; const float* cbp = ka_in(P, 9) + (size_t)L * 2048;
    for (int rg = vcu * 2 + (tid >> 8); rg < 512; rg += 2 * G) {
        const int col = (tid & 255) * 8;
        float cw[4][8], cb[8];
#pragma unroll
        for (int j = 0; j < 4; ++j) { const f32x4 a = *(const f32x4*)(cwp + j * 2048 + col), b = *(const f32x4*)(cwp + j * 2048 + col + 4);
            cw[j][0] = a[0]; cw[j][1] = a[1]; cw[j][2] = a[2]; cw[j][3] = a[3]; cw[j][4] = b[0]; cw[j][5] = b[1]; cw[j][6] = b[2]; cw[j][7] = b[3]; }
        { const f32x4 a = *(const f32x4*)(cbp + col), b = *(const f32x4*)(cbp + col + 4); cb[0] = a[0]; cb[1] = a[1]; cb[2] = a[2]; cb[3] = a[3]; cb[4] = b[0]; cb[5] = b[1]; cb[6] = b[2]; cb[7] = b[3]; }
        v4u w0 = (v4u){0u, 0u, 0u, 0u}, w1 = w0, w2 = w0;
        if ((rg & 63) != 0) { const bf16* hp = halo + (size_t)(rg - 1) * 3 * 2048 + col; w0 = *(const v4u*)hp; w1 = *(const v4u*)(hp + 2048); w2 = *(const v4u*)(hp + 4096); }
        const float sc = (col < 1024) ? 0.0625f : 1.0f;
        bf16* zp = Z + (size_t)rg * 64 * ZW + col;
        for (int i0 = 0; i0 < 64; i0 += 8) {
            v4u x[8];
#pragma unroll
            for (int r = 0; r < 8; ++r) x[r] = *(const v4u*)(zp + (size_t)(i0 + r) * ZW);
#pragma unroll
            for (int r = 0; r < 8; ++r) {
                const v4u x3 = x[r]; float o[8];
#define CONV_E(e, W0, W1, W2, W3) o[e] = cb[e] + cw[0][e] * (W0) + cw[1][e] * (W1) + cw[2][e] * (W2) + cw[3][e] * (W3)
                CONV_E(0, bflo(w0.x), bflo(w1.x), bflo(w2.x), bflo(x3.x)); CONV_E(1, bfhi(w0.x), bfhi(w1.x), bfhi(w2.x), bfhi(x3.x));
                CONV_E(2, bflo(w0.y), bflo(w1.y), bflo(w2.y), bflo(x3.y)); CONV_E(3, bfhi(w0.y), bfhi(w1.y), bfhi(w2.y), bfhi(x3.y));
                CONV_E(4, bflo(w0.z), bflo(w1.z), bflo(w2.z), bflo(x3.z)); CONV_E(5, bfhi(w0.z), bfhi(w1.z), bfhi(w2.z), bfhi(x3.z));
                CONV_E(6, bflo(w0.w), bflo(w1.w), bflo(w2.w), bflo(x3.w)); CONV_E(7, bfhi(w0.w), bfhi(w1.w), bfhi(w2.w), bfhi(x3.w));
#undef CONV_E
#pragma unroll
                for (int e = 0; e < 8; ++e) o[e] = o[e] * sigm(o[e]) * sc;
                *(v4u*)(zp + (size_t)(i0 + r) * ZW) = (v4u){cvt_pk_bf16(o[0], o[1]), cvt_pk_bf16(o[2], o[3]), cvt_pk_bf16(o[4], o[5]), cvt_pk_bf16(o[6], o[7])};
                w0 = w1; w1 = w2; w2 = x3; }
        }
    }
}

constexpr int ML_QS = 0, ML_KS = 33792, ML_KT = 67584, ML_VT = 104448, ML_VWT = 109056, ML_CB = 113664, ML_PS = 130560, ML_FL = 139776;
constexpr int FL_A = 0, FL_MX = 64, FL_WIN = 128, FL_FLOOR = 192, FL_WST = 256, FL_SC = 320, FL_WSTB = 328, FL_GSZ = 360;
constexpr int FL_QN = 720;
constexpr int ML_NB = ML_FL + 784 * 4;
#define MFMA16(a, b, c) __builtin_amdgcn_mfma_f32_16x16x32_bf16((a), (b), (c), 0, 0, 0)

__device__ __forceinline__ void mlstm_unit(KArg P, int L, int b, int h, int vs, LAS unsigned char* lds) {
    const int tid = opaque_tid(), lane = tid & 63, w = __builtin_amdgcn_readfirstlane(tid >> 6), c = lane & 15, g = lane >> 4;
    bf16* Z = (bf16*)(ka_ws(P) + WS_Z); const float* gif = (const float*)(ka_ws(P) + WS_GIF);
    LAS float* FL = (LAS float*)(lds + ML_FL);
    const int cgp = lane, isk = cgp >> 5;
    const int zcol = (isk ? 1024 : 0) + h * 256 + (cgp & 31) * 8;
    const float bi = ka_in(P, 10)[L * 4 + h], bfg = ka_in(P, 11)[L * 4 + h];
    const size_t rowbase = (size_t)b * SEQ;
    for (int i = tid; i < 32 * 264 / 2; i += 512) ((LAS unsigned*)(lds + ML_CB))[i] = 0u;
    if (tid < 128) ((LAS unsigned*)(lds + ML_NB))[tid] = 0u;
    f32x4 Cn[2] = {(f32x4){0.f, 0.f, 0.f, 0.f}, (f32x4){0.f, 0.f, 0.f, 0.f}};
    f32x4 Cacc[2][2];
#pragma unroll
    for (int a = 0; a < 2; ++a)
#pragma unroll
        for (int d = 0; d < 2; ++d) Cacc[a][d] = (f32x4){0.f, 0.f, 0.f, 0.f};
    float m_st = 0.f;
    v4u raw[8]; v4u vraw = (v4u){0u, 0u, 0u, 0u}; float zi = 0.f, zf = 0.f;
    auto prefetch = [&](int ch) {
        const int t0 = ch * 64;
#pragma unroll
        for (int r = 0; r < 8; ++r) raw[r] = *(const v4u*)(Z + (rowbase + t0 + w * 8 + r) * ZW + zcol);
        if (tid < 256) vraw = *(const v4u*)(Z + (rowbase + t0 + (tid >> 2)) * ZW + ZC_V + h * 256 + vs * 32 + (tid & 3) * 8);
        if (tid >= 448) { zi = gif[(rowbase + t0 + lane) * 8 + h]; zf = gif[(rowbase + t0 + lane) * 8 + 4 + h]; }
    };
    auto gates = [&](LAS float* gb) {
        const float ig = zi + bi; const float xf = zf + bfg; const float lf = fminf(xf, 0.f) - __logf(1.0f + __expf(-fabsf(xf)));
        const float bsum = wave_scan_add(lf);
        const float a = ig - bsum; const float pm = wave_scan_max(a);
        const float Mx = fmaxf(m_st, pm);
        const float M63 = __int_as_float(__builtin_amdgcn_readlane(__float_as_int(Mx), 63)), blast = __int_as_float(__builtin_amdgcn_readlane(__float_as_int(bsum), 63));
        gb[FL_A + lane] = a; gb[FL_MX + lane] = Mx; gb[FL_WIN + lane] = __expf(m_st - Mx); gb[FL_FLOOR + lane] = __expf(-(bsum + Mx)); { const float wst = __expf(a - M63); gb[FL_WST + lane] = wst; ((LAS bf16*)(gb + FL_WSTB))[lane] = (bf16)(cvt_pk_bf16(wst, 0.f) & 0xffffu); }
        if (lane == 0) gb[FL_SC] = __expf(m_st - M63);
        m_st = blast + M63;
    };
    auto stage_qk = [&]() {
#pragma unroll
        for (int r = 0; r < 8; ++r) *(LAS v4u*)(lds + (isk ? ML_KS : ML_QS) + (w * 8 + r) * 528 + (cgp & 31) * 16) = raw[r];
    };
    auto stage_kt_v = [&](LAS float* gbn) {
        if (isk) {
#pragma unroll
            for (int e = 0; e < 8; ++e) {
                v4u t;
#define PKW(r) ((e >> 1) == 0 ? raw[r].x : (e >> 1) == 1 ? raw[r].y : (e >> 1) == 2 ? raw[r].z : raw[r].w)
                if (e & 1) { t.x = (PKW(0) >> 16) | (PKW(1) & 0xffff0000u); t.y = (PKW(2) >> 16) | (PKW(3) & 0xffff0000u); t.z = (PKW(4) >> 16) | (PKW(5) & 0xffff0000u); t.w = (PKW(6) >> 16) | (PKW(7) & 0xffff0000u); }
                else { t.x = (PKW(0) & 0xffffu) | (PKW(1) << 16); t.y = (PKW(2) & 0xffffu) | (PKW(3) << 16); t.z = (PKW(4) & 0xffffu) | (PKW(5) << 16); t.w = (PKW(6) & 0xffffu) | (PKW(7) << 16); }
#undef PKW
                *(LAS v4u*)(lds + ML_KT + ((cgp & 31) * 8 + e) * 144 + w * 16) = t; }
        }
        if (tid < 256) { const int s = tid >> 2, part = tid & 3; const float ws_ = gbn[FL_WST + s];
            const unsigned xs[4] = {vraw.x, vraw.y, vraw.z, vraw.w};
#pragma unroll
            for (int e = 0; e < 8; ++e) { const unsigned wd = xs[e >> 1]; const float v = (e & 1) ? bfhi(wd) : bflo(wd);
                *(LAS bf16*)(lds + ML_VT + (part * 8 + e) * 144 + s * 2) = (bf16)((e & 1) ? (wd >> 16) : (wd & 0xffffu));
                *(LAS bf16*)(lds + ML_VWT + (part * 8 + e) * 144 + s * 2) = (bf16)(cvt_pk_bf16(v * ws_, 0.f) & 0xffffu); } }
    };
    prefetch(0);
    if (w == 7) gates(FL);
    __syncthreads();
    stage_qk(); stage_kt_v(FL);
    __syncthreads();
    const int ttile = w >> 1, par = w & 1;
    for (int ch = 0; ch < 64; ++ch) {
        const int t0 = ch * 64;
        LAS float* GB = FL + (ch & 1) * FL_GSZ;
        if (ch + 1 < 64) prefetch(ch + 1);
        f32x4 accS0 = (f32x4){0.f, 0.f, 0.f, 0.f}, accS1 = accS0, accI = accS0, accN = accS0;
        const bf16x8 zero8 = (bf16x8){0, 0, 0, 0, 0, 0, 0, 0};
        {
            const LAS unsigned char* qp = lds + ML_QS + (ttile * 16 + c) * 528 + g * 16;
            const LAS unsigned char* k0p = lds + ML_KS + ((par * 2 + 0) * 16 + c) * 528 + g * 16;
            const LAS unsigned char* k1p = lds + ML_KS + ((par * 2 + 1) * 16 + c) * 528 + g * 16;
            const LAS unsigned char* cp = lds + ML_CB + (par * 16 + c) * 528 + g * 16;
#pragma unroll 2
            for (int kk = 0; kk < 8; ++kk) {
                const bf16x8 a = *(const LAS bf16x8*)(qp + kk * 64);
                const bf16x8 b0 = *(const LAS bf16x8*)(k0p + kk * 64), b1 = *(const LAS bf16x8*)(k1p + kk * 64), bc = *(const LAS bf16x8*)(cp + kk * 64);
                accS0 = MFMA16(a, b0, accS0); accS1 = MFMA16(a, b1, accS1); accI = MFMA16(a, bc, accI);
                { const bf16x8 bn = *(const LAS bf16x8*)(lds + ML_NB + kk * 64 + g * 16); accN = MFMA16(a, bn, accN); } }
#pragma unroll
            for (int r = 0; r < 4; ++r) { const int t = ttile * 16 + 4 * g + r; const float Mt = GB[FL_MX + t];
                const int s0 = (par * 2) * 16 + c, s1 = s0 + 16;
                const float w0 = (s0 <= t) ? __expf(GB[FL_A + s0] - Mt) : 0.f, w1 = (s1 <= t) ? __expf(GB[FL_A + s1] - Mt) : 0.f;
                *(LAS bf16*)(lds + ML_PS + t * 144 + s0 * 2) = (bf16)(cvt_pk_bf16(accS0[r] * w0, 0.f) & 0xffffu);
                *(LAS bf16*)(lds + ML_PS + t * 144 + s1 * 2) = (bf16)(cvt_pk_bf16(accS1[r] * w1, 0.f) & 0xffffu); }
        }
        __syncthreads();
        {
            f32x4 accP = (f32x4){0.f, 0.f, 0.f, 0.f}, accR = accP;
            const bf16x8 ones8 = (bf16x8){0x3f80, 0x3f80, 0x3f80, 0x3f80, 0x3f80, 0x3f80, 0x3f80, 0x3f80};
#pragma unroll
            for (int ks = 0; ks < 2; ++ks) {
                const bf16x8 a = *(const LAS bf16x8*)(lds + ML_PS + (ttile * 16 + c) * 144 + ks * 64 + g * 16);
                const bf16x8 bv = *(const LAS bf16x8*)(lds + ML_VT + (par * 16 + c) * 144 + ks * 64 + g * 16);
                accP = MFMA16(a, bv, accP); accR = MFMA16(a, ones8, accR); }
#pragma unroll
            for (int r = 0; r < 4; ++r) { const int t = ttile * 16 + 4 * g + r; const float wi = GB[FL_WIN + t];
                const float num = accP[r] + wi * accI[r]; const float den = accR[r] + wi * accN[r];
                const float hv = num * __builtin_amdgcn_rcpf(fmaxf(fabsf(den), GB[FL_FLOOR + t]));
                Z[(rowbase + t0 + t) * ZW + ZC_V + h * 256 + vs * 32 + par * 16 + c] = (bf16)(cvt_pk_bf16(hv, 0.f) & 0xffffu); }
            const float decay = GB[FL_SC];
            const LAS unsigned char* wsb = (const LAS unsigned char*)(GB + FL_WSTB);
#pragma unroll
            for (int kt = 0; kt < 2; ++kt) {
                bf16x8 bk[2];
#pragma unroll
                for (int ks = 0; ks < 2; ++ks) bk[ks] = *(const LAS bf16x8*)(lds + ML_KT + ((2 * w + kt) * 16 + c) * 144 + ks * 64 + g * 16);
#pragma unroll
                for (int vt = 0; vt < 2; ++vt) {
                    f32x4 cc = Cacc[kt][vt] * decay;
#pragma unroll
                    for (int ks = 0; ks < 2; ++ks) { const bf16x8 a = *(const LAS bf16x8*)(lds + ML_VWT + (vt * 16 + c) * 144 + ks * 64 + g * 16); cc = MFMA16(a, bk[ks], cc); }
                    Cacc[kt][vt] = cc;
#pragma unroll
                    for (int r = 0; r < 4; ++r) *(LAS bf16*)(lds + ML_CB + (vt * 16 + 4 * g + r) * 528 + ((2 * w + kt) * 16 + c) * 2) = (bf16)(cvt_pk_bf16(cc[r], 0.f) & 0xffffu);
                }
                f32x4 cn = Cn[kt] * decay;
#pragma unroll
                for (int ks = 0; ks < 2; ++ks) { const bf16x8 an = *(const LAS bf16x8*)(wsb + ks * 64 + g * 16); cn = MFMA16(an, bk[ks], cn); }
                Cn[kt] = cn;
                if (g == 0) *(LAS bf16*)(lds + ML_NB + ((2 * w + kt) * 16 + c) * 2) = (bf16)(cvt_pk_bf16(cn[0], 0.f) & 0xffffu);
            }
            if (w == 7 && ch + 1 < 64) gates(FL + ((ch + 1) & 1) * FL_GSZ);
            if (ch + 1 < 64) stage_qk();
        }
        __syncthreads();
        if (ch + 1 < 64) stage_kt_v(FL + ((ch + 1) & 1) * FL_GSZ);
    }
    __syncthreads();
}

constexpr int AT_K = 0, AT_VT = 36864;
__device__ __forceinline__ void attn_unit(KArg P, int L, int b, int nb, int kvh, LAS unsigned char* lds) {
    const int tid = opaque_tid(), lane = tid & 63, w = __builtin_amdgcn_readfirstlane(tid >> 6), c = lane & 15, g = lane >> 4;
    bf16* Z = (bf16*)(ka_ws(P) + WS_Z);
    const float* gq = ka_in(P, 13) + L * 64; const float* gk = ka_in(P, 14) + L * 64; const float* sinks = ka_in(P, 15) + L * 16;
    const size_t rowbase = (size_t)b * SEQ;
#pragma unroll
    for (int r = 0; r < 4; ++r) { const int item = tid + 512 * r, key = item >> 3, part = item & 7; const int t = nb * 128 - 128 + key;
        v4u kx = (v4u){0u, 0u, 0u, 0u}, vx = kx;
        if (t >= 0) { kx = *(const v4u*)(Z + (rowbase + t) * ZW + ZC_AK + kvh * 64 + part * 8); vx = *(const v4u*)(Z + (rowbase + t) * ZW + ZC_AV + kvh * 64 + part * 8); }
        float kf[8] = {bflo(kx.x), bfhi(kx.x), bflo(kx.y), bfhi(kx.y), bflo(kx.z), bfhi(kx.z), bflo(kx.w), bfhi(kx.w)};
        float ss = 0.f;
#pragma unroll
        for (int e = 0; e < 8; ++e) ss += kf[e] * kf[e];
        ss += __shfl_xor(ss, 1); ss += __shfl_xor(ss, 2); ss += __shfl_xor(ss, 4);
        const float rk = rsqrtf(ss * (1.0f / 64.0f) + EPS);
#pragma unroll
        for (int e = 0; e < 8; ++e) kf[e] = kf[e] * rk * gk[part * 8 + e];
        *(LAS v4u*)(lds + AT_K + key * 144 + part * 16) = (v4u){cvt_pk_bf16(kf[0], kf[1]), cvt_pk_bf16(kf[2], kf[3]), cvt_pk_bf16(kf[4], kf[5]), cvt_pk_bf16(kf[6], kf[7])};
        const unsigned xs[4] = {vx.x, vx.y, vx.z, vx.w};
#pragma unroll
        for (int e = 0; e < 8; ++e) { const unsigned wd = xs[e >> 1]; *(LAS bf16*)(lds + AT_VT + (part * 8 + e) * 528 + key * 2) = (bf16)((e & 1) ? (wd >> 16) : (wd & 0xffffu)); }
    }
    __syncthreads();
    const int tile0 = w & ~1;
    const int qi = 16 * w + c;
    for (int hg = 0; hg < 4; ++hg) {
        const int head = kvh * 4 + hg; const float sink = sinks[head];
        bf16* qrow = Z + (rowbase + nb * 128 + qi) * ZW + ZC_AQ + head * 64;
        bf16x8 qf[2];
        { const v4u x0 = *(const v4u*)(qrow + g * 8), x1 = *(const v4u*)(qrow + 32 + g * 8);
          float f[16] = {bflo(x0.x), bfhi(x0.x), bflo(x0.y), bfhi(x0.y), bflo(x0.z), bfhi(x0.z), bflo(x0.w), bfhi(x0.w), bflo(x1.x), bfhi(x1.x), bflo(x1.y), bfhi(x1.y), bflo(x1.z), bfhi(x1.z), bflo(x1.w), bfhi(x1.w)};
          float ss = 0.f;
#pragma unroll
          for (int e = 0; e < 16; ++e) ss += f[e] * f[e];
          ss += __shfl_xor(ss, 16); ss += __shfl_xor(ss, 32);
          const float rq = rsqrtf(ss * (1.0f / 64.0f) + EPS) * 0.125f;
#pragma unroll
          for (int e = 0; e < 8; ++e) { f[e] *= rq * gq[g * 8 + e]; f[8 + e] *= rq * gq[32 + g * 8 + e]; }
          v4u p0 = (v4u){cvt_pk_bf16(f[0], f[1]), cvt_pk_bf16(f[2], f[3]), cvt_pk_bf16(f[4], f[5]), cvt_pk_bf16(f[6], f[7])};
          v4u p1 = (v4u){cvt_pk_bf16(f[8], f[9]), cvt_pk_bf16(f[10], f[11]), cvt_pk_bf16(f[12], f[13]), cvt_pk_bf16(f[14], f[15])};
          qf[0] = __builtin_bit_cast(bf16x8, p0); qf[1] = __builtin_bit_cast(bf16x8, p1); }
        const int odd = w & 1;
        f32x4 sc[10]; float mx = sink;
#pragma unroll
        for (int tt = 0; tt < 10; ++tt) {
            f32x4 a = (f32x4){-1e30f, -1e30f, -1e30f, -1e30f};
            const bool empty = odd ? (tt == 0) : (tt == 9);
            if (!empty) {
                a = (f32x4){0.f, 0.f, 0.f, 0.f};
#pragma unroll
                for (int ks = 0; ks < 2; ++ks) { const bf16x8 kfr = *(const LAS bf16x8*)(lds + AT_K + ((tile0 + tt) * 16 + c) * 144 + ks * 64 + g * 16); a = MFMA16(kfr, qf[ks], a); }
                const bool partial = odd ? (tt == 1 || tt == 9) : (tt == 0 || tt == 8);
                if (partial || nb == 0) {
#pragma unroll
                    for (int r = 0; r < 4; ++r) { const int kj = (tile0 + tt) * 16 + 4 * g + r; const bool valid = (kj >= qi + 1) && (kj <= qi + 128) && (nb > 0 || kj >= 128);
                        a[r] = valid ? a[r] : -1e30f; } }
#pragma unroll
                for (int r = 0; r < 4; ++r) mx = fmaxf(mx, a[r]);
            }
            sc[tt] = a; }
        mx = fmaxf(mx, __shfl_xor(mx, 16)); mx = fmaxf(mx, __shfl_xor(mx, 32));
        float sum = 0.f;
#pragma unroll
        for (int tt = 0; tt < 10; ++tt)
#pragma unroll
            for (int r = 0; r < 4; ++r) { const float p = (sc[tt][r] > -1e29f) ? __expf(sc[tt][r] - mx) : 0.f; sc[tt][r] = p; sum += p; }
        sum += __shfl_xor(sum, 16); sum += __shfl_xor(sum, 32);
        const float inv = 1.0f / (sum + __expf(sink - mx));
        f32x4 oacc[4];
#pragma unroll
        for (int dt = 0; dt < 4; ++dt) oacc[dt] = (f32x4){0.f, 0.f, 0.f, 0.f};
#pragma unroll
        for (int u = 0; u < 5; ++u) {
            v4u pb = (v4u){cvt_pk_bf16(sc[2 * u][0], sc[2 * u][1]), cvt_pk_bf16(sc[2 * u][2], sc[2 * u][3]), cvt_pk_bf16(sc[2 * u + 1][0], sc[2 * u + 1][1]), cvt_pk_bf16(sc[2 * u + 1][2], sc[2 * u + 1][3])};
            const bf16x8 pfr = __builtin_bit_cast(bf16x8, pb);
#pragma unroll
            for (int dt = 0; dt < 4; ++dt) {
                const LAS unsigned char* vp = lds + AT_VT + (dt * 16 + c) * 528 + ((tile0 + 2 * u) * 16 + 4 * g) * 2;
                const v2u lo = *(const LAS v2u*)vp, hi = *(const LAS v2u*)(vp + 32);
                const v4u av = (v4u){lo.x, lo.y, hi.x, hi.y};
                oacc[dt] = MFMA16(__builtin_bit_cast(bf16x8, av), pfr, oacc[dt]); } }
#pragma unroll
        for (int dt = 0; dt < 4; ++dt) { const f32x4 o = oacc[dt] * inv; v2u wv; wv.x = cvt_pk_bf16(o[0], o[1]); wv.y = cvt_pk_bf16(o[2], o[3]);
            *(v2u*)(qrow + dt * 16 + 4 * g) = wv; }
    }
    __syncthreads();
}

__device__ __forceinline__ void phase_fin(KArg P, int L, int vcu, int G) {
    const int tid = opaque_tid(); const int lane = tid & 63, wave = tid >> 6; const int gw = vcu * 8 + wave, NGW = G * 8;
    bf16* Z = (bf16*)(ka_ws(P) + WS_Z); const float* gn = ka_in(P, 12) + L * DM;
    for (int base = gw; base < MROWS * 4; base += 8 * NGW) {
        v2u hv[8], ov[8];
#pragma unroll
        for (int k = 0; k < 8; ++k) { int pair = base + k * NGW; if (pair >= MROWS * 4) pair = gw; const int row = pair >> 2, h = pair & 3;
            hv[k] = *(const v2u*)(Z + (size_t)row * ZW + ZC_V + h * 256 + lane * 4); ov[k] = *(const v2u*)(Z + (size_t)row * ZW + ZC_O + h * 256 + lane * 4); }
#pragma unroll
        for (int k = 0; k < 8; ++k) { const int pair = base + k * NGW; if (pair >= MROWS * 4) continue; const int row = pair >> 2, h = pair & 3;
            const f32x4 gv = *(const f32x4*)(gn + h * 256 + lane * 4);
            const float x0 = bflo(hv[k].x), x1 = bfhi(hv[k].x), x2 = bflo(hv[k].y), x3 = bfhi(hv[k].y);
            const float ss = wave_sum_dpp((x0 * x0 + x1 * x1) + (x2 * x2 + x3 * x3));
            const float r = rsqrtf(ss * (1.0f / 256.0f) + EPS);
            v2u o; o.x = cvt_pk_bf16(bflo(ov[k].x) * x0 * r * gv[0], bfhi(ov[k].x) * x1 * r * gv[1]); o.y = cvt_pk_bf16(bflo(ov[k].y) * x2 * r * gv[2], bfhi(ov[k].y) * x3 * r * gv[3]);
            *(v2u*)(Z + (size_t)row * ZW + ZC_V + h * 256 + lane * 4) = o; } }
}


#define XB_TMO      128
#define XB_XCNT(j)  (256  + 64 * (j))
#define XB_XSUB(j)  (1280 + 64 * (j))
#define XB_XGEN(j)  (2304 + 64 * (j))
#define XB_TOP      3328
#define XB_TOPGEN   3392
#define XCD_BAR_WORDS 3456
#define XB_SPIN_CAP (1u << 24)
constexpr size_t WS_BAR = 60 * MiB;
constexpr int LDS_XB = 147400;
__device__ __forceinline__ unsigned xb_ld(unsigned* p)              { return __hip_atomic_load(p, __ATOMIC_RELAXED, __HIP_MEMORY_SCOPE_AGENT); }
__device__ __forceinline__ unsigned xb_add(unsigned* p, unsigned v) { return __hip_atomic_fetch_add(p, v, __ATOMIC_RELAXED, __HIP_MEMORY_SCOPE_AGENT); }
__device__ __forceinline__ unsigned xb_xcc_id() { return (unsigned)__builtin_amdgcn_s_getreg((3 << 11) | 20) & 0xFu; }
#define XB_SPIN(cond, bar) do { unsigned _sp = 0; while (cond) { __builtin_amdgcn_s_sleep(1); \
    if ((++_sp & 255u) == 0u) { if (xb_ld(&(bar)[XB_TMO])) break; if (_sp > XB_SPIN_CAP) { atomicAdd(&(bar)[XB_TMO], 1u); break; } } } } while (0)
__device__ __forceinline__ void xcd_barrier_complete(unsigned* bar, unsigned x, unsigned& nloc, unsigned& nx) {
    const unsigned G = gridDim.x * gridDim.y * gridDim.z;
    unsigned sum, cnt, mine, sp = 0u;
    for (;;) {
        sum = 0u; cnt = 0u; mine = 0u;
#pragma unroll
        for (unsigned j = 0; j < 16; ++j) { const unsigned c = xb_ld(&bar[XB_XCNT(j)]); sum += c; cnt += (c > 0u) ? 1u : 0u; mine = (j == x) ? c : mine; }
        if (sum == G) break;
        __builtin_amdgcn_s_sleep(1);
        if ((++sp & 255u) == 0u) { if (xb_ld(&bar[XB_TMO])) break; if (sp > XB_SPIN_CAP) { atomicAdd(&bar[XB_TMO], 1u); break; } }
    }
    nloc = mine > 0u ? mine : 1u; nx = cnt > 0u ? cnt : 1u;
}
__device__ __forceinline__ void xcd_barrier(unsigned* bar, volatile LAS unsigned* st) {
    asm volatile("s_waitcnt vmcnt(0)" ::: "memory");
    __syncthreads();
    if (threadIdx.x == 0) {
        const unsigned x = xb_xcc_id();
        __builtin_amdgcn_s_waitcnt(0);
        unsigned nloc = st[0], nx = st[1];
        if (nloc == 0u) { xcd_barrier_complete(bar, x, nloc, nx); st[0] = nloc; st[1] = nx; }
        const unsigned old = xb_add(&bar[XB_XSUB(x)], 1u);
        const unsigned gen = old / nloc;
        if (old + 1u == (gen + 1u) * nloc) {
            __builtin_amdgcn_fence(__ATOMIC_RELEASE, "agent");
            asm volatile("s_waitcnt vmcnt(0)" ::: "memory");
            const unsigned og = xb_add(&bar[XB_TOP], 1u);
            const unsigned tg = og / nx;
            if (og + 1u == (tg + 1u) * nx) xb_add(&bar[XB_TOPGEN], 1u);
            else XB_SPIN(xb_ld(&bar[XB_TOPGEN]) == tg, bar);
            __builtin_amdgcn_fence(__ATOMIC_ACQUIRE, "agent");
            xb_add(&bar[XB_XGEN(x)], 1u);
            asm volatile("s_waitcnt vmcnt(0)" ::: "memory");
        } else {
            XB_SPIN(xb_ld(&bar[XB_XGEN(x)]) == gen, bar);
            __builtin_amdgcn_fence(__ATOMIC_ACQUIRE, "agent");
            asm volatile("s_waitcnt vmcnt(0)" ::: "memory");
        }
    }
    __syncthreads();
}

constexpr int PH_PER_LAYER = 12;
#define PH_STOP 24
__global__ void __launch_bounds__(512, 2) hybrid_fwd(Params Pk) {
    LAS unsigned char* lds = (LAS unsigned char*)g_lds;
    cg::grid_group grid = cg::this_grid();
    if (threadIdx.x < 2) ((LAS unsigned*)(lds + LDS_XB))[threadIdx.x] = 0u;
    { const KArg P0 = ka_get(); unsigned* bar0 = (unsigned*)(ka_ws(P0) + WS_BAR); if (threadIdx.x == 0) (void)xb_add(&bar0[XB_XCNT(xb_xcc_id())], 1u); }
    __syncthreads();
    bool first = true;
    const int ph_lo = Pk.ph_lo, ph_hi = Pk.ph_hi;
    for (int ph = ph_lo; ph < ph_hi; ++ph) {
        if (!first) {
            if (ph_lo < 0) {
                asm volatile("s_waitcnt vmcnt(0) lgkmcnt(0)" ::: "memory"); grid.sync(); __builtin_amdgcn_fence(__ATOMIC_ACQUIRE, "agent"); asm volatile("s_waitcnt vmcnt(0)" ::: "memory");
            } else { const KArg Pb = ka_get(); xcd_barrier((unsigned*)(ka_ws(Pb) + WS_BAR), (volatile LAS unsigned*)(lds + LDS_XB)); }
        }
        first = false;
        const KArg P = ka_get();
        unsigned char* ws = ka_ws(P); float* out = ka_out(P); int G = gridDim.x, bx = blockIdx.x;
        asm volatile("" : "+s"(G), "+s"(bx));
        const int vcu = (G % 8 == 0) ? (bx % 8) * (G / 8) + bx / 8 : bx;
        bf16* Z = (bf16*)(ws + WS_Z); bf16* HB = (bf16*)(ws + WS_HB); bf16* HB2 = (bf16*)(ws + WS_HB2); bf16* HID = (bf16*)(ws + WS_HID); bf16* PPb = (bf16*)(ws + WS_PP); bf16* T = HB;
        const int L = ph / PH_PER_LAYER, q = ph % PH_PER_LAYER;
        float* RSA = (float*)(ws + WS_RSA); float* RSB = (float*)(ws + WS_RSB);
        pg8::StaticOrder S;
        switch (q) {
                case 0: phase_convert(P, L, lds, vcu, G); break;
        case 1: { pg8::Gemm gm{HB2, (const bf16*)(ws + WS_WGU1), MROWS, 5632, DM, DM, DM}; S.init(MROWS, 5632, G, bx);
                  EpiSwiglu E{HID, RSA}; pg8::gemm_phase<EpiSwiglu, true>(lds, gm, S, E); } break;
        case 2: { pg8::Gemm gm{HID, (const bf16*)(ws + WS_WD1), MROWS, DM, DFFP, DFFP, DFFP}; S.init(MROWS, DM, G, bx);
                  EpiRes<0> E{L == 0 ? ka_in(P, 0) : out, out, HB, RSB, 0.5f, nullptr, nullptr}; pg8::gemm_phase<EpiRes<0>, true>(lds, gm, S, E); } break;
        case 3: { pg8::Gemm gm{HB, (const bf16*)(ws + WS_WIN), MROWS, 5888, DM, DM, DM}; S.init(MROWS, 5888, G, bx);
                  EpiBf<4> E{Z, ZW, nullptr, 0, nullptr, 0, RSB, (float*)(ws + WS_GIF), (bf16*)(ws + WS_HALO)}; pg8::gemm_phase<EpiBf<4>, true>(lds, gm, S, E); } break;
        case 4: {
            conv_pass(P, L, vcu, G);
            for (int u = vcu; u < 1024; u += G) attn_unit(P, L, u >> 7, (u >> 2) & 31, u & 3, lds);
        } break;
        case 5: {
            for (int u = bx; u < 256; u += G) { const int bh = (u >> 6) * 8 + (u & 7), vs = (u >> 3) & 7; mlstm_unit(P, L, bh >> 2, bh & 3, vs, lds); }
        } break;
        case 6: { phase_fin(P, L, vcu, G);
                  pg8::Gemm gm{HB, (const bf16*)(ws + WS_WIN) + (size_t)5888 * DM, MROWS, 2048, DM, DM, DM}; S.init(MROWS, 2048, G, bx);
                  EpiBf<1> E{Z, ZW, nullptr, 0, nullptr, 0, RSB, nullptr, nullptr}; pg8::gemm_phase<EpiBf<1>, true>(lds, gm, S, E); } break;
        case 7: {
                  { pg8::Gemm gm{Z + ZC_V, (const bf16*)(ws + WS_WA), MROWS, DM, DM, ZW, DM}; S.init(MROWS, DM, G, bx);
                    EpiBf<2> E{T, DM, Z, ZW, nullptr, 0, nullptr, nullptr, nullptr}; pg8::gemm_phase<EpiBf<2>, true>(lds, gm, S, E); }
                  { pg8::Gemm gm{Z + ZC_AQ, (const bf16*)(ws + WS_WB), MROWS, DM, DM, ZW, DM}; S.init(MROWS, DM, G, bx);
                    EpiBf<3> E{Z, ZW, T, DM, Z + 1024, ZW, nullptr, nullptr, nullptr}; pg8::gemm_phase<EpiBf<3>, true>(lds, gm, S, E); } } break;
        case 8: { pg8::Gemm gm{Z, (const bf16*)(ws + WS_WOUT), MROWS, DM, DM, ZW, DM}; S.init(MROWS, DM, G, bx);
                  EpiRes<0> E{out, out, HB, RSA, 1.0f, nullptr, nullptr}; pg8::gemm_phase<EpiRes<0>, true>(lds, gm, S, E); } break;
        case 9: { pg8::Gemm gm{HB, (const bf16*)(ws + WS_WGU2), MROWS, 5632, DM, DM, DM}; S.init(MROWS, 5632, G, bx);
                  EpiSwiglu E{HID, RSA}; pg8::gemm_phase<EpiSwiglu, true>(lds, gm, S, E); } break;
        case 10: { { pg8::Gemm gm{HID, (const bf16*)(ws + WS_WD2), MROWS, DM, DFFP, DFFP, DFFP}; S.init(MROWS, DM, G, bx);
                     EpiRes<0> E{out, out, HB, RSB, 0.5f, nullptr, nullptr}; pg8::gemm_phase<EpiRes<0>, true>(lds, gm, S, E); }
                   { pg8::Gemm gm{(const bf16*)(ws + WS_PBF), (const bf16*)(ws + WS_WP), MROWS, DM, PLE, PLE, PLE}; S.init(MROWS, DM, G, bx);
                     EpiBf<0> E{PPb, DM, nullptr, 0, nullptr, 0, nullptr, nullptr}; pg8::gemm_phase<EpiBf<0>, true>(lds, gm, S, E); } } break;
        case 11: { pg8::Gemm gm{HB, (const bf16*)(ws + WS_WPG), MROWS, DM, DM, DM, DM}; S.init(MROWS, DM, G, bx);
                   EpiRes<1> E{out, out, HB2, RSA, 1.0f, RSB, PPb}; pg8::gemm_phase<EpiRes<1>, true>(lds, gm, S, E); } break;
        }
    }
}

extern "C" void kernel_launch(void* const* d_in, const int* in_sizes, int n_in, void* d_out, int out_size, void* d_ws, size_t ws_size, hipStream_t stream) {
    static int grid = 0;
    if (grid == 0) {
        if (n_in != 26 || out_size != MROWS * DM || ws_size < WS_END) { fprintf(stderr, "kernel_launch: unexpected problem (n_in %d out %d ws %zu)\n", n_in, out_size, ws_size); grid = -1; return; }
        int dev = 0, cus = 0, per_cu = 0;
        hipGetDevice(&dev); hipDeviceGetAttribute(&cus, hipDeviceAttributeMultiprocessorCount, dev);
        hipFuncSetAttribute((const void*)hybrid_fwd, hipFuncAttributeMaxDynamicSharedMemorySize, LDS_BYTES);
        hipOccupancyMaxActiveBlocksPerMultiprocessor(&per_cu, (const void*)hybrid_fwd, 512, LDS_BYTES);
        if (per_cu < 1) { fprintf(stderr, "kernel_launch: occupancy query says %d blocks/CU\n", per_cu); per_cu = 1; }
        (void)hipGetLastError();
        grid = cus;
    }
    if (grid < 0) return;
    if (hipMemsetAsync((char*)d_ws + WS_BAR, 0, 16384, stream) != hipSuccess) { fprintf(stderr, "kernel_launch: memset of barrier words failed\n"); return; }
    Params p{};
    for (int i = 0; i < 26; ++i) p.in[i] = (const float*)d_in[i];
    p.out = (float*)d_out; p.ws = (unsigned char*)d_ws; p.ph_lo = 0; p.ph_hi = PH_STOP;
    void* args[] = {&p};
    hipError_t e = hipLaunchCooperativeKernel((const void*)hybrid_fwd, dim3(grid), dim3(512), args, LDS_BYTES, stream);
    if (e != hipSuccess) fprintf(stderr, "cooperative launch failed: %s (grid %d)\n", hipGetErrorString(e), grid);
}
```

```cpp
#include <hip/hip_runtime.h>
#include <hip/hip_cooperative_groups.h>
#include <cstdio>
#include <cstdint>
namespace cg = cooperative_groups;

#define LAS __attribute__((address_space(3)))
typedef unsigned short bf16;
typedef unsigned v4u __attribute__((ext_vector_type(4)));
typedef unsigned v2u __attribute__((ext_vector_type(2)));
typedef float f32x4 __attribute__((ext_vector_type(4)));
typedef short bf16x8 __attribute__((ext_vector_type(8)));
typedef short s16x4 __attribute__((ext_vector_type(4)));

constexpr int MROWS = 32768, DM = 1024, SEQ = 4096, NB = 8, DFF = 2752, DFFP = 2816, NIN = 7688, PLE = 256;
constexpr int ZW = 5632;
constexpr int ZC_V = 2048, ZC_O = 3072, ZC_AQ = 4096, ZC_AK = 5120, ZC_AV = 5376;
constexpr int NWIN = 7936;
constexpr float EPS = 1e-6f;
constexpr size_t MiB = 1u << 20;
constexpr size_t WS_WGU1 = 0, WS_WD1 = 11 * MiB, WS_WIN = 16 * MiB + 512 * 1024, WS_WA = 32 * MiB, WS_WB = 34 * MiB, WS_WOUT = 36 * MiB, WS_WPG = 38 * MiB,
                 WS_WP = 40 * MiB, WS_WGU2 = 40 * MiB + 512 * 1024, WS_WD2 = 51 * MiB + 512 * 1024;
constexpr size_t WS_ROWSS = 57 * MiB;
constexpr size_t WS_GIF = 59 * MiB;
constexpr size_t WS_Z = 62 * MiB;
constexpr size_t WS_HID = WS_Z, WS_PP = WS_Z + 178 * MiB, WS_HB2 = WS_Z + 242 * MiB;
constexpr size_t WS_HB = 414 * MiB;
constexpr size_t WS_PBF = 478 * MiB;
constexpr size_t WS_HALO = 494 * MiB;
constexpr size_t WS_RSA = 500 * MiB, WS_RSB = 502 * MiB;
constexpr size_t WS_END = 504 * MiB;
constexpr int LDS_BYTES = 147456;

typedef float f32x2_t __attribute__((ext_vector_type(2)));
typedef __bf16 bf16x2_t __attribute__((ext_vector_type(2)));
__device__ __forceinline__ unsigned cvt_pk_bf16(float lo, float hi) { f32x2_t v = {lo, hi}; bf16x2_t b = __builtin_convertvector(v, bf16x2_t); return __builtin_bit_cast(unsigned, b); }
__device__ __forceinline__ float bflo(unsigned w) { return __uint_as_float(w << 16); }
__device__ __forceinline__ float bfhi(unsigned w) { return __uint_as_float(w & 0xffff0000u); }
__device__ __forceinline__ float sigm(float x) { return __builtin_amdgcn_rcpf(1.0f + __expf(-x)); }
__device__ __forceinline__ float wave_sum(float v) {
#pragma unroll
    for (int o = 1; o < 64; o <<= 1) v += __shfl_xor(v, o);
    return v;
}
template <int CTRL, int ROWMASK> __device__ __forceinline__ float dppf(float old, float v) { return __int_as_float(__builtin_amdgcn_update_dpp(__float_as_int(old), __float_as_int(v), CTRL, ROWMASK, 0xf, false)); }
__device__ __forceinline__ float wave_scan_add(float v) {
    v += dppf<0x111, 0xf>(0.f, v); v += dppf<0x112, 0xf>(0.f, v); v += dppf<0x114, 0xf>(0.f, v); v += dppf<0x118, 0xf>(0.f, v);
    v += dppf<0x142, 0xa>(0.f, v); v += dppf<0x143, 0xc>(0.f, v); return v; }
__device__ __forceinline__ float wave_scan_max(float v) {
    const float I = -3.0e38f;
    v = fmaxf(v, dppf<0x111, 0xf>(I, v)); v = fmaxf(v, dppf<0x112, 0xf>(I, v)); v = fmaxf(v, dppf<0x114, 0xf>(I, v)); v = fmaxf(v, dppf<0x118, 0xf>(I, v));
    v = fmaxf(v, dppf<0x142, 0xa>(I, v)); v = fmaxf(v, dppf<0x143, 0xc>(I, v)); return v; }
__device__ __forceinline__ float wave_sum_dpp(float v) { return __int_as_float(__builtin_amdgcn_readlane(__float_as_int(wave_scan_add(v)), 63)); }
#define LDS_WAIT() asm volatile("s_waitcnt lgkmcnt(0)" ::: "memory")
__device__ __forceinline__ int opaque_tid() { int t = threadIdx.x; asm volatile("" : "+v"(t)); return t; }

extern __shared__ __attribute__((aligned(16))) unsigned char g_lds[];
namespace pg8 {
constexpr int BM = 256, BK = 64, HALF = 128, HTB = HALF * BK * 2, STAGE_BYTES = 8 * HTB, NXCD = 8, WGM = 8;
constexpr int RSL_OFF = STAGE_BYTES;
__host__ __device__ __forceinline__ int lds_byte(int r, int c) { const int st = (r >> 4) * 2 + (c >> 5), rr = r & 15, cc = c & 31, ob = rr * 64 + cc * 2; return st * 1024 + (ob ^ (((ob >> 9) & 1) << 5)); }
__host__ __device__ __forceinline__ void stage_rc(int b, int& R, int& C) { const int st = b / 1024, sb = b % 1024, swz = sb ^ (((sb >> 9) & 1) << 5); R = (st >> 1) * 16 + swz / 64; C = (st & 1) * 32 + (swz % 64) / 2; }
__host__ __device__ __forceinline__ int perm32(int rho) { const int n = rho >> 4, i = rho & 15; return 8 * (i >> 2) + 4 * n + (i & 3); }
struct Unit { int pm, pn; };
struct Gemm { const bf16* A; const bf16* Bt; int M, N, K, lda, ldb; };
struct StaticOrder {
    int nM, nN, nwg, G, c;
    __device__ void init(int M, int N, int G_, int c_) { nM = M / BM; nN = N / BM; nwg = nM * nN; G = G_; c = c_; }
    __device__ bool next(int i, Unit& u) const {
        const int L = i * G + c; if (L >= nwg) return false;
        int wgid = L; { const int q = nwg / NXCD, r = nwg % NXCD, xcd = wgid % NXCD, off = wgid / NXCD; wgid = (xcd < r ? xcd * (q + 1) : r * (q + 1) + (xcd - r) * q) + off; }
        const int nig = WGM * nN, gid = wgid / nig, fm = gid * WGM, gsz = (nM - fm) < WGM ? (nM - fm) : WGM;
        u.pm = fm + ((wgid % nig) % gsz); u.pn = (wgid % nig) / gsz; return true;
    }
};
template <class Epi, bool ALIGN_EPI>
__device__ __forceinline__ void gemm_phase(LAS unsigned char* lds, const Gemm g, const StaticOrder& S, const Epi& E) {
    int tid_ = threadIdx.x; asm volatile("" : "+v"(tid_));
    const int tid = tid_, wid = __builtin_amdgcn_readfirstlane(tid >> 6), lane = tid & 63, wr = wid >> 2, wc = wid & 3, fr = lane & 15, fq = lane >> 4;
    const int K = g.K, nt = K / BK;
    unsigned voffA[2], voffB[2];
#pragma unroll
    for (int i = 0; i < 2; ++i) { int R, C; stage_rc(tid * 16 + i * 8192, R, C); const int Rb = Epi::PERM ? ((R & ~31) + perm32(R & 31)) : R;
        voffA[i] = (unsigned)(R * g.lda + C) * 2u; voffB[i] = (unsigned)(Rb * g.ldb + C) * 2u; }
    const size_t kstep = (size_t)(BK * 2);
    const size_t hstepA = (size_t)HALF * g.lda * 2, hstepB = (size_t)HALF * g.ldb * 2;
    const size_t tstepA = 2 * hstepA, tstepB = 2 * hstepB;
    const unsigned ldsw = (unsigned)wid * 1024u;
    const int aoff = lds_byte(wr * 64 + fr, fq * 8), boff = lds_byte(wc * 32 + fr, fq * 8);
#define PG8_SA(b, h) (((b) * 2 + (h)) * HTB)
#define PG8_SB(b, h) ((4 + (b) * 2 + (h)) * HTB)
#define PG8_STAGE(bufoff, gbase, voff) do { _Pragma("unroll") for (int _i = 0; _i < 2; ++_i) \
        __builtin_amdgcn_global_load_lds((const unsigned*)((const char*)(gbase) + (voff)[_i]), (LAS unsigned*)(lds + (bufoff) + ldsw + _i * 8192), 16, 0, 0); } while (0)
#define PG8_LDA(dst, b, h) do { _Pragma("unroll") for (int m = 0; m < 4; ++m) _Pragma("unroll") for (int k = 0; k < 2; ++k) dst[m][k] = *(const LAS bf16x8*)(lds + PG8_SA(b, h) + aoff + m * 2048 + k * 1024); } while (0)
#define PG8_LDB(dst, b, h) do { _Pragma("unroll") for (int n = 0; n < 2; ++n) _Pragma("unroll") for (int k = 0; k < 2; ++k) dst[n][k] = *(const LAS bf16x8*)(lds + PG8_SB(b, h) + boff + n * 2048 + k * 1024); } while (0)
#define PG8_MMA(ai, bj, At, Bt) do { __builtin_amdgcn_s_setprio(1); _Pragma("unroll") for (int m = 0; m < 4; ++m) _Pragma("unroll") for (int n = 0; n < 2; ++n) _Pragma("unroll") for (int k = 0; k < 2; ++k) \
        acc[ai][bj][m][n] = __builtin_amdgcn_mfma_f32_16x16x32_bf16(Bt[n][k], At[m][k], acc[ai][bj][m][n], 0, 0, 0); __builtin_amdgcn_s_setprio(0); } while (0)
#define PG8_WAIT_V(n) asm volatile("s_waitcnt vmcnt(" #n ")" ::: "memory")
#define PG8_WAIT_L(n) asm volatile("s_waitcnt lgkmcnt(" #n ")" ::: "memory")
#define PG8_BAR __builtin_amdgcn_s_barrier()
#define PG8_SCHED __builtin_amdgcn_sched_barrier(0)
    Unit cur, nxt; int ui = 0; int cpm = -1;
    if (!S.next(0, cur)) return;
    f32x4 acc[2][2][4][2];
#pragma unroll
    for (int a = 0; a < 2; ++a)
#pragma unroll
        for (int b = 0; b < 2; ++b)
#pragma unroll
            for (int m = 0; m < 4; ++m)
#pragma unroll
                for (int n = 0; n < 2; ++n) acc[a][b][m][n] = (f32x4){0.f, 0.f, 0.f, 0.f};
    bf16x8 At[4][2], B0[2][2], B1[2][2];
    const char* cA = (const char*)g.A + (size_t)cur.pm * tstepA; const char* cB = (const char*)g.Bt + (size_t)cur.pn * tstepB;
    PG8_STAGE(PG8_SB(0, 0), cB, voffB); PG8_STAGE(PG8_SB(0, 1), cB + hstepB, voffB); PG8_STAGE(PG8_SA(0, 0), cA, voffA); PG8_STAGE(PG8_SA(0, 1), cA + hstepA, voffA);
    if (wr == 1) PG8_BAR;
    PG8_WAIT_V(2); PG8_BAR;
    PG8_STAGE(PG8_SB(1, 0), cB + kstep, voffB); PG8_STAGE(PG8_SA(1, 0), cA + kstep, voffA); PG8_STAGE(PG8_SB(1, 1), cB + hstepB + kstep, voffB);
    PG8_WAIT_V(6); PG8_BAR;
    for (;;) {
        const bool has_next = S.next(ui + 1, nxt);
        const char* nA = has_next ? (const char*)g.A + (size_t)nxt.pm * tstepA : cA; const char* nB = has_next ? (const char*)g.Bt + (size_t)nxt.pn * tstepB : cB;
        for (int t = 0; t < nt; t += 2) {
            const bool last = (t == nt - 2);
            const char* a1 = cA + (size_t)(t + 1) * kstep;
            const char* a2 = last ? nA : cA + (size_t)(t + 2) * kstep; const char* b2 = last ? nB : cB + (size_t)(t + 2) * kstep;
            const char* a3 = a2 + kstep; const char* b3 = b2 + kstep;
            PG8_LDB(B0, 0, 0); PG8_LDB(B1, 0, 1); PG8_SCHED; PG8_LDA(At, 0, 0); PG8_STAGE(PG8_SA(1, 1), a1 + hstepA, voffA);
            PG8_WAIT_V(8); PG8_WAIT_L(0); PG8_BAR; PG8_MMA(0, 0, At, B0); PG8_MMA(0, 1, At, B1); PG8_BAR; PG8_SCHED;
            PG8_LDA(At, 0, 1); PG8_STAGE(PG8_SB(0, 0), b2, voffB); PG8_STAGE(PG8_SB(0, 1), b2 + hstepB, voffB); PG8_STAGE(PG8_SA(0, 0), a2, voffA);
            PG8_WAIT_V(8); PG8_WAIT_L(0); PG8_BAR; PG8_MMA(1, 0, At, B0); PG8_MMA(1, 1, At, B1); PG8_BAR; PG8_SCHED;
            PG8_LDB(B0, 1, 0); PG8_LDB(B1, 1, 1); PG8_SCHED; PG8_LDA(At, 1, 0); PG8_STAGE(PG8_SA(0, 1), a2 + hstepA, voffA);
            PG8_WAIT_V(8); PG8_WAIT_L(0); PG8_BAR; PG8_MMA(0, 0, At, B0); PG8_MMA(0, 1, At, B1); PG8_BAR; PG8_SCHED;
            PG8_LDA(At, 1, 1); PG8_STAGE(PG8_SB(1, 0), b3, voffB); PG8_STAGE(PG8_SB(1, 1), b3 + hstepB, voffB); PG8_STAGE(PG8_SA(1, 0), a3, voffA);
            PG8_WAIT_V(8); PG8_WAIT_L(0); PG8_BAR; PG8_MMA(1, 0, At, B0); PG8_MMA(1, 1, At, B1); PG8_BAR; PG8_SCHED;
        }
        if constexpr (ALIGN_EPI) { if (wr == 0) PG8_BAR; }
        if constexpr (Epi::USES_RS) {
            if (cur.pm != cpm) { cpm = cur.pm; const float* rp = E.rs_src();
#pragma unroll
                for (int j = 0; j < 2; ++j) { const int q = lane + 64 * j; const int row = cur.pm * 256 + (q >> 6) * 128 + wr * 64 + (q & 63);
                    const f32x4* p4 = (const f32x4*)(rp + (size_t)row * 16); const f32x4 t4 = (p4[0] + p4[1]) + (p4[2] + p4[3]);
                    ((LAS float*)(lds + RSL_OFF))[wid * 128 + q] = rsqrtf(((t4[0] + t4[1]) + (t4[2] + t4[3])) * (1.0f / 1024.0f) + 1e-6f); } }
        }
        E(acc, cur, wr, wc, fr, fq);
        if (!has_next) break;
#pragma unroll
        for (int a = 0; a < 2; ++a)
#pragma unroll
            for (int b = 0; b < 2; ++b)
#pragma unroll
                for (int m = 0; m < 4; ++m)
#pragma unroll
                    for (int n = 0; n < 2; ++n) acc[a][b][m][n] = (f32x4){0.f, 0.f, 0.f, 0.f};
        cur = nxt; cA = nA; cB = nB; ++ui;
        if constexpr (ALIGN_EPI) { if (wr == 1) PG8_BAR; }
    }
    PG8_WAIT_V(0);
    if constexpr (!ALIGN_EPI) { if (wr == 0) PG8_BAR; }
    PG8_BAR;
#undef PG8_SA
#undef PG8_SB
#undef PG8_STAGE
#undef PG8_LDA
#undef PG8_LDB
#undef PG8_MMA
#undef PG8_WAIT_V
#undef PG8_WAIT_L
#undef PG8_BAR
#undef PG8_SCHED
}
}

typedef const f32x4 (&AccRef)[2][2][4][2];
struct EpiSwiglu {
    static constexpr bool PERM = true, USES_RS = true;
    __device__ __forceinline__ const float* rs_src() const { return rowss; }
    bf16* O; const float* rowss;
    __device__ __forceinline__ void operator()(AccRef acc, const pg8::Unit& u, int, int, int, int) const {
        const int tid = opaque_tid(), wid = __builtin_amdgcn_readfirstlane(tid >> 6), wr = wid >> 2, wc = wid & 3, fr = tid & 15, fq = (tid & 63) >> 4;
        const int row0 = u.pm * 256 + wr * 64 + fr, col0 = u.pn * 128 + wc * 32 + 8 * fq;
#pragma unroll
        for (int ai = 0; ai < 2; ++ai)
#pragma unroll
            for (int m = 0; m < 4; ++m) {
                const int row = row0 + ai * 128 + m * 16; const float rs = ((const LAS float*)((LAS unsigned char*)g_lds + pg8::RSL_OFF))[wid * 128 + ai * 64 + m * 16 + fr];
                float o[8];
#pragma unroll
                for (int n = 0; n < 2; ++n)
#pragma unroll
                    for (int j = 0; j < 4; ++j) { const float gv = acc[ai][0][m][n][j] * rs, uv = acc[ai][1][m][n][j] * rs; o[n * 4 + j] = gv * sigm(gv) * uv; }
                v4u w; w.x = cvt_pk_bf16(o[0], o[1]); w.y = cvt_pk_bf16(o[2], o[3]); w.z = cvt_pk_bf16(o[4], o[5]); w.w = cvt_pk_bf16(o[6], o[7]);
                *(v4u*)(O + (size_t)row * DFFP + col0) = w; }
    }
};
template <int MODE> struct EpiRes {
    static constexpr bool PERM = false, USES_RS = (MODE == 1);
    __device__ __forceinline__ const float* rs_src() const { return rowss_in; }
    const float* hin; float* hout; bf16* hb; float* rowss_out; float alpha; const float* rowss_in; const bf16* pp; const bf16* hinb;
    __device__ __forceinline__ void operator()(AccRef acc, const pg8::Unit& u, int, int, int, int) const {
        const int tid = opaque_tid(), wid = __builtin_amdgcn_readfirstlane(tid >> 6), wr = wid >> 2, wc = wid & 3, fr = tid & 15, fq = (tid & 63) >> 4;
        const int row0 = u.pm * 256 + wr * 64 + fr, col0 = u.pn * 256 + wc * 32 + 4 * fq;
#pragma unroll
        for (int ai = 0; ai < 2; ++ai)
#pragma unroll
            for (int m = 0; m < 4; ++m) {
                const int row = row0 + ai * 128 + m * 16; float ss = 0.f; float rs = 1.f;
                if (MODE == 1) rs = ((const LAS float*)((LAS unsigned char*)g_lds + pg8::RSL_OFF))[wid * 128 + ai * 64 + m * 16 + fr];
#pragma unroll
                for (int bj = 0; bj < 2; ++bj)
#pragma unroll
                    for (int n = 0; n < 2; ++n) {
                        const size_t off = (size_t)row * DM + col0 + bj * 128 + n * 16;
                        f32x4 h; const f32x4 a = acc[ai][bj][m][n];
                        if (hin) h = *(const f32x4*)(hin + off); else { const v2u hw = *(const v2u*)(hinb + off); h = (f32x4){bflo(hw.x), bfhi(hw.x), bflo(hw.y), bfhi(hw.y)}; }
                        if (MODE == 0) h = h + a * alpha;
                        else { const v2u pw = *(const v2u*)(pp + off);
                            h[0] += sigm(a[0] * rs) * bflo(pw.x); h[1] += sigm(a[1] * rs) * bfhi(pw.x); h[2] += sigm(a[2] * rs) * bflo(pw.y); h[3] += sigm(a[3] * rs) * bfhi(pw.y); }
                        if (hout) *(f32x4*)(hout + off) = h;
                        if (hb) { v2u w; w.x = cvt_pk_bf16(h[0], h[1]); w.y = cvt_pk_bf16(h[2], h[3]); *(v2u*)(hb + off) = w; }
                        ss += (h[0] * h[0] + h[1] * h[1]) + (h[2] * h[2] + h[3] * h[3]); }
                ss += __shfl_xor(ss, 16); ss += __shfl_xor(ss, 32);
                if (fq == 0) rowss_out[(size_t)row * 16 + u.pn * 4 + wc] = ss;
                if (m == 3) asm volatile("" ::: "memory"); }
    }
};
template <int MODE> struct EpiBf {
    static constexpr bool PERM = true, USES_RS = (MODE == 1 || MODE == 4);
    __device__ __forceinline__ const float* rs_src() const { return rowss; }
    bf16* O; int ldo; const bf16* a1; int ld1; const bf16* a2; int ld2; const float* rowss; float* gif; bf16* halo;
    __device__ __forceinline__ void operator()(AccRef acc, const pg8::Unit& u, int, int, int, int) const {
        const int tid = opaque_tid(), wid = __builtin_amdgcn_readfirstlane(tid >> 6), wr = wid >> 2, wc = wid & 3, fr = tid & 15, fq = (tid & 63) >> 4;
        const int row0 = u.pm * 256 + wr * 64 + fr, col0 = u.pn * 256 + wc * 32 + 8 * fq;
        if (MODE == 4 && u.pn == 22) {
            if (wc == 0 && fq == 0) {
#pragma unroll
                for (int ai = 0; ai < 2; ++ai)
#pragma unroll
                    for (int m = 0; m < 4; ++m) { const int row = row0 + ai * 128 + m * 16; const float rs = ((const LAS float*)((LAS unsigned char*)g_lds + pg8::RSL_OFF))[wid * 128 + ai * 64 + m * 16 + fr];
                        *(f32x4*)(gif + (size_t)row * 8) = acc[ai][0][m][0] * rs; *(f32x4*)(gif + (size_t)row * 8 + 4) = acc[ai][0][m][1] * rs; }
            }
            return;
        }
        const bool sg = (MODE == 1) || (MODE == 4 && u.pn >= 12 && u.pn < 16);
#pragma unroll
        for (int ai = 0; ai < 2; ++ai)
#pragma unroll
            for (int m = 0; m < 4; ++m) {
                const int row = row0 + ai * 128 + m * 16; float rs = 1.f;
                if (MODE == 1 || MODE == 4) rs = ((const LAS float*)((LAS unsigned char*)g_lds + pg8::RSL_OFF))[wid * 128 + ai * 64 + m * 16 + fr];
#pragma unroll
                for (int bj = 0; bj < 2; ++bj) {
                    const int col = col0 + bj * 128; float o[8];
#pragma unroll
                    for (int n = 0; n < 2; ++n)
#pragma unroll
                        for (int j = 0; j < 4; ++j) o[n * 4 + j] = acc[ai][bj][m][n][j] * rs;
                    if (sg) {
#pragma unroll
                        for (int j = 0; j < 8; ++j) o[j] = sigm(o[j]); }
                    if (MODE == 2 || MODE == 3) {
                        const v4u x = *(const v4u*)(a1 + (size_t)row * ld1 + col);
                        float xf[8] = {bflo(x.x), bfhi(x.x), bflo(x.y), bfhi(x.y), bflo(x.z), bfhi(x.z), bflo(x.w), bfhi(x.w)};
                        if (MODE == 2) {
#pragma unroll
                            for (int j = 0; j < 8; ++j) o[j] *= xf[j]; }
                        else { const v4u y = *(const v4u*)(a2 + (size_t)row * ld2 + col);
                            float yf[8] = {bflo(y.x), bfhi(y.x), bflo(y.y), bfhi(y.y), bflo(y.z), bfhi(y.z), bflo(y.w), bfhi(y.w)};
#pragma unroll
                            for (int j = 0; j < 8; ++j) o[j] = xf[j] + yf[j] * o[j]; }
                    }
                    v4u w; w.x = cvt_pk_bf16(o[0], o[1]); w.y = cvt_pk_bf16(o[2], o[3]); w.z = cvt_pk_bf16(o[4], o[5]); w.w = cvt_pk_bf16(o[6], o[7]);
                    *(v4u*)(O + (size_t)row * ldo + col) = w;
                    if (MODE == 4 && m == 3) { if (u.pn < 8 && fr >= 13) *(v4u*)(halo + ((size_t)(row >> 6) * 3 + (fr - 13)) * 2048 + col) = w; } }
                if ((MODE == 2 || MODE == 3) && (m & 1)) asm volatile("" ::: "memory"); }
    }
};

struct Params { const float* in[26]; float* out; unsigned char* ws; int ph_lo, ph_hi; };
typedef const __attribute__((address_space(4))) unsigned char* KArg;
__device__ __forceinline__ KArg ka_get() { KArg k = (KArg)__builtin_amdgcn_kernarg_segment_ptr(); asm volatile("" : "+s"(k)); return k; }
__device__ __forceinline__ const float* ka_in(KArg k, int i) { return *(const float* const __attribute__((address_space(4)))*)(k + 8 * i); }
__device__ __forceinline__ float* ka_out(KArg k) { return *(float* const __attribute__((address_space(4)))*)(k + 208); }
__device__ __forceinline__ unsigned char* ka_ws(KArg k) { return *(unsigned char* const __attribute__((address_space(4)))*)(k + 216); }
static_assert(sizeof(Params) == 232, "kernarg layout");

template <int KIND>
__device__ __forceinline__ void tr_item(const float* src, const float* src2, int srcN, int Ksrc, const float* gain, bf16* WT, int Kd, int nblk, int item, LAS float* scr, int lane) {
    const int kb = item / nblk, nb = item % nblk, k0 = 64 * kb, n0 = 64 * nb;
    const int n = n0 + (lane & 15) * 4;
    const float* cp = nullptr;
    if (KIND == 0) cp = src + n;
    if (KIND == 1) { const int hid = (n >> 8) * 128 + (n & 127); if (hid < DFF) cp = (((n >> 7) & 1) ? src2 : src) + hid; }
    if (KIND == 2) { if (n < 4096) cp = src + n; else if (n < 5632) cp = src + n + 8; else if (n < 5888) { if (n - 5632 < 8) cp = src + 4096 + (n - 5632); } else cp = src + 5640 + (n - 5888); }
    f32x4 v[16];
#pragma unroll
    for (int i = 0; i < 16; ++i) { const int k = k0 + 4 * i + (lane >> 4);
        v[i] = (cp != nullptr && k < Ksrc) ? *(const f32x4*)(cp + (size_t)k * srcN) : (f32x4){0.f, 0.f, 0.f, 0.f}; }
#pragma unroll
    for (int i = 0; i < 16; ++i) { LAS float* d = scr + (4 * i + (lane >> 4)) * 65 + (lane & 15) * 4; d[0] = v[i][0]; d[1] = v[i][1]; d[2] = v[i][2]; d[3] = v[i][3]; }
    LDS_WAIT(); asm volatile("" ::: "memory");
    const int c = lane & 7;
    float gk[8];
#pragma unroll
    for (int e = 0; e < 8; ++e) gk[e] = 1.0f;
    if (gain) { const f32x4 a = *(const f32x4*)(gain + k0 + 8 * c), b = *(const f32x4*)(gain + k0 + 8 * c + 4); gk[0] = a[0]; gk[1] = a[1]; gk[2] = a[2]; gk[3] = a[3]; gk[4] = b[0]; gk[5] = b[1]; gk[6] = b[2]; gk[7] = b[3]; }
#pragma unroll
    for (int j = 0; j < 8; ++j) { const int nn = (lane >> 3) + 8 * j; const LAS float* sp = scr + (8 * c) * 65 + nn;
        v4u o; o.x = cvt_pk_bf16(sp[0 * 65] * gk[0], sp[1 * 65] * gk[1]); o.y = cvt_pk_bf16(sp[2 * 65] * gk[2], sp[3 * 65] * gk[3]); o.z = cvt_pk_bf16(sp[4 * 65] * gk[4], sp[5 * 65] * gk[5]); o.w = cvt_pk_bf16(sp[6 * 65] * gk[6], sp[7 * 65] * gk[7]);
        *(v4u*)(WT + (size_t)(n0 + nn) * Kd + k0 + 8 * c) = o; }
    LDS_WAIT(); asm volatile("" ::: "memory");
}

__device__ __forceinline__ void phase_convert(KArg P, int L, LAS unsigned char* lds, int vcu, int G) {
    const int tid = opaque_tid(); const int lane = tid & 63, wave = tid >> 6;
    LAS float* scr = (LAS float*)(lds + wave * 16640);
    const int gw = vcu * 8 + wave, NGW = G * 8;
    unsigned char* ws = ka_ws(P);
    constexpr int I_GU = 16 * 88, I_D = 44 * 16, I_IN = 16 * 124, I_SQ = 16 * 16, I_P = 4 * 16;
    const size_t oGU = (size_t)L * DM * DFF, oSQ = (size_t)L * DM * DM;
    int off = 0;
#define CONV_LOOP(ITEMS, CALL) do { for (int it = (gw - off % NGW + NGW) % NGW; it < (ITEMS); it += NGW) { CALL; } off += (ITEMS); } while (0)
    CONV_LOOP(I_GU, tr_item<1>(ka_in(P, 3) + oGU, ka_in(P, 4) + oGU, DFF, DM, ka_in(P, 2) + L * DM, (bf16*)(ws + WS_WGU1), DM, 88, it, scr, lane));
    CONV_LOOP(I_D,  tr_item<0>(ka_in(P, 5) + oGU, nullptr, DM, DFF, nullptr, (bf16*)(ws + WS_WD1), DFFP, 16, it, scr, lane));
    CONV_LOOP(I_IN, tr_item<2>(ka_in(P, 7) + (size_t)L * DM * NIN, nullptr, NIN, DM, ka_in(P, 6) + L * DM, (bf16*)(ws + WS_WIN), DM, 124, it, scr, lane));
    CONV_LOOP(I_SQ, tr_item<0>(ka_in(P, 16) + oSQ, nullptr, DM, DM, nullptr, (bf16*)(ws + WS_WA), DM, 16, it, scr, lane));
    CONV_LOOP(I_SQ, tr_item<0>(ka_in(P, 17) + oSQ, nullptr, DM, DM, nullptr, (bf16*)(ws + WS_WB), DM, 16, it, scr, lane));
    CONV_LOOP(I_SQ, tr_item<0>(ka_in(P, 18) + oSQ, nullptr, DM, DM, nullptr, (bf16*)(ws + WS_WOUT), DM, 16, it, scr, lane));
    CONV_LOOP(I_GU, tr_item<1>(ka_in(P, 20) + oGU, ka_in(P, 21) + oGU, DFF, DM, ka_in(P, 19) + L * DM, (bf16*)(ws + WS_WGU2), DM, 88, it, scr, lane));
    CONV_LOOP(I_D,  tr_item<0>(ka_in(P, 22) + oGU, nullptr, DM, DFF, nullptr, (bf16*)(ws + WS_WD2), DFFP, 16, it, scr, lane));
    CONV_LOOP(I_SQ, tr_item<0>(ka_in(P, 24) + oSQ, nullptr, DM, DM, ka_in(P, 23) + L * DM, (bf16*)(ws + WS_WPG), DM, 16, it, scr, lane));
    CONV_LOOP(I_P,  tr_item<0>(ka_in(P, 25) + (size_t)L * PLE * DM, nullptr, DM, PLE, nullptr, (bf16*)(ws + WS_WP), PLE, 16, it, scr, lane));
#undef CONV_LOOP
    const float* pl = ka_in(P, 1) + (size_t)L * MROWS * PLE; bf16* pbf = (bf16*)(ws + WS_PBF);
    for (int m0 = gw; m0 < MROWS; m0 += 4 * NGW) { f32x4 v[4];
#pragma unroll
        for (int k = 0; k < 4; ++k) { const int m = (m0 + k * NGW < MROWS) ? m0 + k * NGW : m0; v[k] = *(const f32x4*)(pl + (size_t)m * PLE + lane * 4); }
#pragma unroll
        for (int k = 0; k < 4; ++k) { const int m = m0 + k * NGW; if (m < MROWS) { v2u w; w.x = cvt_pk_bf16(v[k][0], v[k][1]); w.y = cvt_pk_bf16(v[k][2], v[k][3]); *(v2u*)(pbf + (size_t)m * PLE + lane * 4) = w; } } }
    if (L == 0) {
        float* rowss = (float*)(ws + WS_RSA); bf16* hb2 = (bf16*)(ws + WS_HB2); const float* x = ka_in(P, 0);
        for (int m0 = gw; m0 < MROWS; m0 += 2 * NGW) { f32x4 v[2][4];
#pragma unroll
            for (int k = 0; k < 2; ++k) { const int m = (m0 + k * NGW < MROWS) ? m0 + k * NGW : m0;
#pragma unroll
                for (int j = 0; j < 4; ++j) v[k][j] = *(const f32x4*)(x + (size_t)m * DM + j * 256 + lane * 4); }
#pragma unroll
            for (int k = 0; k < 2; ++k) { const int m = m0 + k * NGW; if (m >= MROWS) continue; float ss = 0.f;
#pragma unroll
                for (int j = 0; j < 4; ++j) { const f32x4 t = v[k][j];
                    v2u w; w.x = cvt_pk_bf16(t[0], t[1]); w.y = cvt_pk_bf16(t[2], t[3]); *(v2u*)(hb2 + (size_t)m * DM + j * 256 + lane * 4) = w;
                    ss += (t[0] * t[0] + t[1] * t[1]) + (t[2] * t[2] + t[3] * t[3]); }
                ss = wave_sum_dpp(ss); if (lane < 16) rowss[(size_t)m * 16 + lane] = (lane == 0) ? ss : 0.f; } }
    }
}

__device__ __forceinline__ void conv_pass(KArg P, int L, int vcu, int G) {
    const int tid = opaque_tid();
    bf16* Z = (bf16*)(ka_ws(P) + WS_Z); const bf16* halo = (const bf16*)(ka_ws(P) + WS_HALO);
    const float* cwp = ka_in(P, 8) + (size_t)L * 4 * 2048; const float* cbp = ka_in(P, 9) + (size_t)L * 2048;
    for (int rg = vcu * 2 + (tid >> 8); rg < 512; rg += 2 * G) {
        const int col = (tid & 255) * 8;
        float cw[4][8], cb[8];
#pragma unroll
        for (int j = 0; j < 4; ++j) { const f32x4 a = *(const f32x4*)(cwp + j * 2048 + col), b = *(const f32x4*)(cwp + j * 2048 + col + 4);
            cw[j][0] = a[0]; cw[j][1] = a[1]; cw[j][2] = a[2]; cw[j][3] = a[3]; cw[j][4] = b[0]; cw[j][5] = b[1]; cw[j][6] = b[2]; cw[j][7] = b[3]; }
        { const f32x4 a = *(const f32x4*)(cbp + col), b = *(const f32x4*)(cbp + col + 4); cb[0] = a[0]; cb[1] = a[1]; cb[2] = a[2]; cb[3] = a[3]; cb[4] = b[0]; cb[5] = b[1]; cb[6] = b[2]; cb[7] = b[3]; }
        v4u w0 = (v4u){0u, 0u, 0u, 0u}, w1 = w0, w2 = w0;
        if ((rg & 63) != 0) { const bf16* hp = halo + (size_t)(rg - 1) * 3 * 2048 + col; w0 = *(const v4u*)hp; w1 = *(const v4u*)(hp + 2048); w2 = *(const v4u*)(hp + 4096); }
        const float sc = (col < 1024) ? 0.0625f : 1.0f;
        bf16* zp = Z + (size_t)rg * 64 * ZW + col;
        for (int i0 = 0; i0 < 64; i0 += 8) {
            v4u x[8];
#pragma unroll
            for (int r = 0; r < 8; ++r) x[r] = *(const v4u*)(zp + (size_t)(i0 + r) * ZW);
#pragma unroll
            for (int r = 0; r < 8; ++r) {
                const v4u x3 = x[r]; float o[8];
#define CONV_E(e, W0, W1, W2, W3) o[e] = cb[e] + cw[0][e] * (W0) + cw[1][e] * (W1) + cw[2][e] * (W2) + cw[3][e] * (W3)
                CONV_E(0, bflo(w0.x), bflo(w1.x), bflo(w2.x), bflo(x3.x)); CONV_E(1, bfhi(w0.x), bfhi(w1.x), bfhi(w2.x), bfhi(x3.x));
                CONV_E(2, bflo(w0.y), bflo(w1.y), bflo(w2.y), bflo(x3.y)); CONV_E(3, bfhi(w0.y), bfhi(w1.y), bfhi(w2.y), bfhi(x3.y));
                CONV_E(4, bflo(w0.z), bflo(w1.z), bflo(w2.z), bflo(x3.z)); CONV_E(5, bfhi(w0.z), bfhi(w1.z), bfhi(w2.z), bfhi(x3.z));
                CONV_E(6, bflo(w0.w), bflo(w1.w), bflo(w2.w), bflo(x3.w)); CONV_E(7, bfhi(w0.w), bfhi(w1.w), bfhi(w2.w), bfhi(x3.w));
#undef CONV_E
#pragma unroll
                for (int e = 0; e < 8; ++e) o[e] = o[e] * sigm(o[e]) * sc;
                *(v4u*)(zp + (size_t)(i0 + r) * ZW) = (v4u){cvt_pk_bf16(o[0], o[1]), cvt_pk_bf16(o[2], o[3]), cvt_pk_bf16(o[4], o[5]), cvt_pk_bf16(o[6], o[7])};
                w0 = w1; w1 = w2; w2 = x3; }
        }
    }
}

constexpr int ML_QS = 0, ML_KS = 33792, ML_KT = 67584, ML_VT = 104448, ML_VWT = 109056, ML_CB = 113664, ML_PS = 130560, ML_FL = 139776;
constexpr int FL_A = 0, FL_MX = 64, FL_WIN = 128, FL_FLOOR = 192, FL_WST = 256, FL_SC = 320, FL_WSTB = 328, FL_GSZ = 360;
constexpr int FL_QN = 720;
constexpr int ML_NB = ML_FL + 784 * 4;
#define MFMA16(a, b, c) __builtin_amdgcn_mfma_f32_16x16x32_bf16((a), (b), (c), 0, 0, 0)

__device__ __forceinline__ void mlstm_unit(KArg P, int L, int b, int h, int vs, LAS unsigned char* lds) {
    const int tid = opaque_tid(), lane = tid & 63, w = __builtin_amdgcn_readfirstlane(tid >> 6), c = lane & 15, g = lane >> 4;
    bf16* Z = (bf16*)(ka_ws(P) + WS_Z); const float* gif = (const float*)(ka_ws(P) + WS_GIF);
    LAS float* FL = (LAS float*)(lds + ML_FL);
    const int cgp = lane, isk = cgp >> 5;
    const int zcol = (isk ? 1024 : 0) + h * 256 + (cgp & 31) * 8;
    const float bi = ka_in(P, 10)[L * 4 + h], bfg = ka_in(P, 11)[L * 4 + h];
    const size_t rowbase = (size_t)b * SEQ;
    for (int i = tid; i < 32 * 264 / 2; i += 512) ((LAS unsigned*)(lds + ML_CB))[i] = 0u;
    if (tid < 128) ((LAS unsigned*)(lds + ML_NB))[tid] = 0u;
    f32x4 Cn[2] = {(f32x4){0.f, 0.f, 0.f, 0.f}, (f32x4){0.f, 0.f, 0.f, 0.f}};
    f32x4 Cacc[2][2];
#pragma unroll
    for (int a = 0; a < 2; ++a)
#pragma unroll
        for (int d = 0; d < 2; ++d) Cacc[a][d] = (f32x4){0.f, 0.f, 0.f, 0.f};
    float m_st = 0.f;
    v4u raw[8]; v4u vraw = (v4u){0u, 0u, 0u, 0u}; float zi = 0.f, zf = 0.f;
    auto prefetch = [&](int ch) {
        const int t0 = ch * 64;
#pragma unroll
        for (int r = 0; r < 8; ++r) raw[r] = *(const v4u*)(Z + (rowbase + t0 + w * 8 + r) * ZW + zcol);
        if (tid < 256) vraw = *(const v4u*)(Z + (rowbase + t0 + (tid >> 2)) * ZW + ZC_V + h * 256 + vs * 32 + (tid & 3) * 8);
        if (tid >= 448) { zi = gif[(rowbase + t0 + lane) * 8 + h]; zf = gif[(rowbase + t0 + lane) * 8 + 4 + h]; }
    };
    auto gates = [&](LAS float* gb) {
        const float ig = zi + bi; const float xf = zf + bfg; const float lf = fminf(xf, 0.f) - __logf(1.0f + __expf(-fabsf(xf)));
        const float bsum = wave_scan_add(lf);
        const float a = ig - bsum; const float pm = wave_scan_max(a);
        const float Mx = fmaxf(m_st, pm);
        const float M63 = __int_as_float(__builtin_amdgcn_readlane(__float_as_int(Mx), 63)), blast = __int_as_float(__builtin_amdgcn_readlane(__float_as_int(bsum), 63));
        gb[FL_A + lane] = a; gb[FL_MX + lane] = Mx; gb[FL_WIN + lane] = __expf(m_st - Mx); gb[FL_FLOOR + lane] = __expf(-(bsum + Mx)); { const float wst = __expf(a - M63); gb[FL_WST + lane] = wst; ((LAS bf16*)(gb + FL_WSTB))[lane] = (bf16)(cvt_pk_bf16(wst, 0.f) & 0xffffu); }
        if (lane == 0) gb[FL_SC] = __expf(m_st - M63);
        m_st = blast + M63;
    };
    auto stage_qk = [&]() {
#pragma unroll
        for (int r = 0; r < 8; ++r) *(LAS v4u*)(lds + (isk ? ML_KS : ML_QS) + (w * 8 + r) * 528 + (cgp & 31) * 16) = raw[r];
    };
    auto stage_kt_v = [&](LAS float* gbn) {
        if (isk) {
#pragma unroll
            for (int e = 0; e < 8; ++e) {
                v4u t;
#define PKW(r) ((e >> 1) == 0 ? raw[r].x : (e >> 1) == 1 ? raw[r].y : (e >> 1) == 2 ? raw[r].z : raw[r].w)
                if (e & 1) { t.x = (PKW(0) >> 16) | (PKW(1) & 0xffff0000u); t.y = (PKW(2) >> 16) | (PKW(3) & 0xffff0000u); t.z = (PKW(4) >> 16) | (PKW(5) & 0xffff0000u); t.w = (PKW(6) >> 16) | (PKW(7) & 0xffff0000u); }
                else { t.x = (PKW(0) & 0xffffu) | (PKW(1) << 16); t.y = (PKW(2) & 0xffffu) | (PKW(3) << 16); t.z = (PKW(4) & 0xffffu) | (PKW(5) << 16); t.w = (PKW(6) & 0xffffu) | (PKW(7) << 16); }
#undef PKW
                *(LAS v4u*)(lds + ML_KT + ((cgp & 31) * 8 + e) * 144 + w * 16) = t; }
        }
        if (tid < 256) { const int s = tid >> 2, part = tid & 3; const float ws_ = gbn[FL_WST + s];
            const unsigned xs[4] = {vraw.x, vraw.y, vraw.z, vraw.w};
#pragma unroll
            for (int e = 0; e < 8; ++e) { const unsigned wd = xs[e >> 1]; const float v = (e & 1) ? bfhi(wd) : bflo(wd);
                *(LAS bf16*)(lds + ML_VT + (part * 8 + e) * 144 + s * 2) = (bf16)((e & 1) ? (wd >> 16) : (wd & 0xffffu));
                *(LAS bf16*)(lds + ML_VWT + (part * 8 + e) * 144 + s * 2) = (bf16)(cvt_pk_bf16(v * ws_, 0.f) & 0xffffu); } }
    };
    prefetch(0);
    if (w == 7) gates(FL);
    __syncthreads();
    stage_qk(); stage_kt_v(FL);
    __syncthreads();
    const int ttile = w >> 1, par = w & 1;
    for (int ch = 0; ch < 64; ++ch) {
        const int t0 = ch * 64;
        LAS float* GB = FL + (ch & 1) * FL_GSZ;
        if (ch + 1 < 64) prefetch(ch + 1);
        f32x4 accS0 = (f32x4){0.f, 0.f, 0.f, 0.f}, accS1 = accS0, accI = accS0, accN = accS0;
        const bf16x8 zero8 = (bf16x8){0, 0, 0, 0, 0, 0, 0, 0};
        {
            const LAS unsigned char* qp = lds + ML_QS + (ttile * 16 + c) * 528 + g * 16;
            const LAS unsigned char* k0p = lds + ML_KS + ((par * 2 + 0) * 16 + c) * 528 + g * 16;
            const LAS unsigned char* k1p = lds + ML_KS + ((par * 2 + 1) * 16 + c) * 528 + g * 16;
            const LAS unsigned char* cp = lds + ML_CB + (par * 16 + c) * 528 + g * 16;
#pragma unroll 2
            for (int kk = 0; kk < 8; ++kk) {
                const bf16x8 a = *(const LAS bf16x8*)(qp + kk * 64);
                const bf16x8 b0 = *(const LAS bf16x8*)(k0p + kk * 64), b1 = *(const LAS bf16x8*)(k1p + kk * 64), bc = *(const LAS bf16x8*)(cp + kk * 64);
                accS0 = MFMA16(a, b0, accS0); accS1 = MFMA16(a, b1, accS1); accI = MFMA16(a, bc, accI);
                { const bf16x8 bn = *(const LAS bf16x8*)(lds + ML_NB + kk * 64 + g * 16); accN = MFMA16(a, bn, accN); } }
#pragma unroll
            for (int r = 0; r < 4; ++r) { const int t = ttile * 16 + 4 * g + r; const float Mt = GB[FL_MX + t];
                const int s0 = (par * 2) * 16 + c, s1 = s0 + 16;
                const float w0 = (s0 <= t) ? __expf(GB[FL_A + s0] - Mt) : 0.f, w1 = (s1 <= t) ? __expf(GB[FL_A + s1] - Mt) : 0.f;
                *(LAS bf16*)(lds + ML_PS + t * 144 + s0 * 2) = (bf16)(cvt_pk_bf16(accS0[r] * w0, 0.f) & 0xffffu);
                *(LAS bf16*)(lds + ML_PS + t * 144 + s1 * 2) = (bf16)(cvt_pk_bf16(accS1[r] * w1, 0.f) & 0xffffu); }
        }
        __syncthreads();
        {
            f32x4 accP = (f32x4){0.f, 0.f, 0.f, 0.f}, accR = accP;
            const bf16x8 ones8 = (bf16x8){0x3f80, 0x3f80, 0x3f80, 0x3f80, 0x3f80, 0x3f80, 0x3f80, 0x3f80};
#pragma unroll
            for (int ks = 0; ks < 2; ++ks) {
                const bf16x8 a = *(const LAS bf16x8*)(lds + ML_PS + (ttile * 16 + c) * 144 + ks * 64 + g * 16);
                const bf16x8 bv = *(const LAS bf16x8*)(lds + ML_VT + (par * 16 + c) * 144 + ks * 64 + g * 16);
                accP = MFMA16(a, bv, accP); accR = MFMA16(a, ones8, accR); }
#pragma unroll
            for (int r = 0; r < 4; ++r) { const int t = ttile * 16 + 4 * g + r; const float wi = GB[FL_WIN + t];
                const float num = accP[r] + wi * accI[r]; const float den = accR[r] + wi * accN[r];
                const float hv = num * __builtin_amdgcn_rcpf(fmaxf(fabsf(den), GB[FL_FLOOR + t]));
                Z[(rowbase + t0 + t) * ZW + ZC_V + h * 256 + vs * 32 + par * 16 + c] = (bf16)(cvt_pk_bf16(hv, 0.f) & 0xffffu); }
            const float decay = GB[FL_SC];
            const LAS unsigned char* wsb = (const LAS unsigned char*)(GB + FL_WSTB);
#pragma unroll
            for (int kt = 0; kt < 2; ++kt) {
                bf16x8 bk[2];
#pragma unroll
                for (int ks = 0; ks < 2; ++ks) bk[ks] = *(const LAS bf16x8*)(lds + ML_KT + ((2 * w + kt) * 16 + c) * 144 + ks * 64 + g * 16);
#pragma unroll
                for (int vt = 0; vt < 2; ++vt) {
                    f32x4 cc = Cacc[kt][vt] * decay;
#pragma unroll
                    for (int ks = 0; ks < 2; ++ks) { const bf16x8 a = *(const LAS bf16x8*)(lds + ML_VWT + (vt * 16 + c) * 144 + ks * 64 + g * 16); cc = MFMA16(a, bk[ks], cc); }
                    Cacc[kt][vt] = cc;
#pragma unroll
                    for (int r = 0; r < 4; ++r) *(LAS bf16*)(lds + ML_CB + (vt * 16 + 4 * g + r) * 528 + ((2 * w + kt) * 16 + c) * 2) = (bf16)(cvt_pk_bf16(cc[r], 0.f) & 0xffffu);
                }
                f32x4 cn = Cn[kt] * decay;
#pragma unroll
                for (int ks = 0; ks < 2; ++ks) { const bf16x8 an = *(const LAS bf16x8*)(wsb + ks * 64 + g * 16); cn = MFMA16(an, bk[ks], cn); }
                Cn[kt] = cn;
                if (g == 0) *(LAS bf16*)(lds + ML_NB + ((2 * w + kt) * 16 + c) * 2) = (bf16)(cvt_pk_bf16(cn[0], 0.f) & 0xffffu);
            }
            if (w == 7 && ch + 1 < 64) gates(FL + ((ch + 1) & 1) * FL_GSZ);
            if (ch + 1 < 64) stage_qk();
        }
        __syncthreads();
        if (ch + 1 < 64) stage_kt_v(FL + ((ch + 1) & 1) * FL_GSZ);
    }
    __syncthreads();
}

constexpr int AT_K = 0, AT_VT = 36864;
__device__ __forceinline__ void attn_unit(KArg P, int L, int b, int nb, int kvh, LAS unsigned char* lds) {
    const int tid = opaque_tid(), lane = tid & 63, w = __builtin_amdgcn_readfirstlane(tid >> 6), c = lane & 15, g = lane >> 4;
    bf16* Z = (bf16*)(ka_ws(P) + WS_Z);
    const float* gq = ka_in(P, 13) + L * 64; const float* gk = ka_in(P, 14) + L * 64; const float* sinks = ka_in(P, 15) + L * 16;
    const size_t rowbase = (size_t)b * SEQ;
#pragma unroll
    for (int r = 0; r < 4; ++r) { const int item = tid + 512 * r, key = item >> 3, part = item & 7; const int t = nb * 128 - 128 + key;
        v4u kx = (v4u){0u, 0u, 0u, 0u}, vx = kx;
        if (t >= 0) { kx = *(const v4u*)(Z + (rowbase + t) * ZW + ZC_AK + kvh * 64 + part * 8); vx = *(const v4u*)(Z + (rowbase + t) * ZW + ZC_AV + kvh * 64 + part * 8); }
        float kf[8] = {bflo(kx.x), bfhi(kx.x), bflo(kx.y), bfhi(kx.y), bflo(kx.z), bfhi(kx.z), bflo(kx.w), bfhi(kx.w)};
        float ss = 0.f;
#pragma unroll
        for (int e = 0; e < 8; ++e) ss += kf[e] * kf[e];
        ss += __shfl_xor(ss, 1); ss += __shfl_xor(ss, 2); ss += __shfl_xor(ss, 4);
        const float rk = rsqrtf(ss * (1.0f / 64.0f) + EPS);
#pragma unroll
        for (int e = 0; e < 8; ++e) kf[e] = kf[e] * rk * gk[part * 8 + e];
        *(LAS v4u*)(lds + AT_K + key * 144 + part * 16) = (v4u){cvt_pk_bf16(kf[0], kf[1]), cvt_pk_bf16(kf[2], kf[3]), cvt_pk_bf16(kf[4], kf[5]), cvt_pk_bf16(kf[6], kf[7])};
        const unsigned xs[4] = {vx.x, vx.y, vx.z, vx.w};
#pragma unroll
        for (int e = 0; e < 8; ++e) { const unsigned wd = xs[e >> 1]; *(LAS bf16*)(lds + AT_VT + (part * 8 + e) * 528 + key * 2) = (bf16)((e & 1) ? (wd >> 16) : (wd & 0xffffu)); }
    }
    __syncthreads();
    const int tile0 = w & ~1;
    const int qi = 16 * w + c;
    for (int hg = 0; hg < 4; ++hg) {
        const int head = kvh * 4 + hg; const float sink = sinks[head];
        bf16* qrow = Z + (rowbase + nb * 128 + qi) * ZW + ZC_AQ + head * 64;
        bf16x8 qf[2];
        { const v4u x0 = *(const v4u*)(qrow + g * 8), x1 = *(const v4u*)(qrow + 32 + g * 8);
          float f[16] = {bflo(x0.x), bfhi(x0.x), bflo(x0.y), bfhi(x0.y), bflo(x0.z), bfhi(x0.z), bflo(x0.w), bfhi(x0.w), bflo(x1.x), bfhi(x1.x), bflo(x1.y), bfhi(x1.y), bflo(x1.z), bfhi(x1.z), bflo(x1.w), bfhi(x1.w)};
          float ss = 0.f;
#pragma unroll
          for (int e = 0; e < 16; ++e) ss += f[e] * f[e];
          ss += __shfl_xor(ss, 16); ss += __shfl_xor(ss, 32);
          const float rq = rsqrtf(ss * (1.0f / 64.0f) + EPS) * 0.125f;
#pragma unroll
          for (int e = 0; e < 8; ++e) { f[e] *= rq * gq[g * 8 + e]; f[8 + e] *= rq * gq[32 + g * 8 + e]; }
          v4u p0 = (v4u){cvt_pk_bf16(f[0], f[1]), cvt_pk_bf16(f[2], f[3]), cvt_pk_bf16(f[4], f[5]), cvt_pk_bf16(f[6], f[7])};
          v4u p1 = (v4u){cvt_pk_bf16(f[8], f[9]), cvt_pk_bf16(f[10], f[11]), cvt_pk_bf16(f[12], f[13]), cvt_pk_bf16(f[14], f[15])};
          qf[0] = __builtin_bit_cast(bf16x8, p0); qf[1] = __builtin_bit_cast(bf16x8, p1); }
        const int odd = w & 1;
        f32x4 sc[10]; float mx = sink;
#pragma unroll
        for (int tt = 0; tt < 10; ++tt) {
            f32x4 a = (f32x4){-1e30f, -1e30f, -1e30f, -1e30f};
            const bool empty = odd ? (tt == 0) : (tt == 9);
            if (!empty) {
                a = (f32x4){0.f, 0.f, 0.f, 0.f};
#pragma unroll
                for (int ks = 0; ks < 2; ++ks) { const bf16x8 kfr = *(const LAS bf16x8*)(lds + AT_K + ((tile0 + tt) * 16 + c) * 144 + ks * 64 + g * 16); a = MFMA16(kfr, qf[ks], a); }
                const bool partial = odd ? (tt == 1 || tt == 9) : (tt == 0 || tt == 8);
                if (partial || nb == 0) {
#pragma unroll
                    for (int r = 0; r < 4; ++r) { const int kj = (tile0 + tt) * 16 + 4 * g + r; const bool valid = (kj >= qi + 1) && (kj <= qi + 128) && (nb > 0 || kj >= 128);
                        a[r] = valid ? a[r] : -1e30f; } }
#pragma unroll
                for (int r = 0; r < 4; ++r) mx = fmaxf(mx, a[r]);
            }
            sc[tt] = a; }
        mx = fmaxf(mx, __shfl_xor(mx, 16)); mx = fmaxf(mx, __shfl_xor(mx, 32));
        float sum = 0.f;
#pragma unroll
        for (int tt = 0; tt < 10; ++tt)
#pragma unroll
            for (int r = 0; r < 4; ++r) { const float p = (sc[tt][r] > -1e29f) ? __expf(sc[tt][r] - mx) : 0.f; sc[tt][r] = p; sum += p; }
        sum += __shfl_xor(sum, 16); sum += __shfl_xor(sum, 32);
        const float inv = 1.0f / (sum + __expf(sink - mx));
        f32x4 oacc[4];
#pragma unroll
        for (int dt = 0; dt < 4; ++dt) oacc[dt] = (f32x4){0.f, 0.f, 0.f, 0.f};
#pragma unroll
        for (int u = 0; u < 5; ++u) {
            v4u pb = (v4u){cvt_pk_bf16(sc[2 * u][0], sc[2 * u][1]), cvt_pk_bf16(sc[2 * u][2], sc[2 * u][3]), cvt_pk_bf16(sc[2 * u + 1][0], sc[2 * u + 1][1]), cvt_pk_bf16(sc[2 * u + 1][2], sc[2 * u + 1][3])};
            const bf16x8 pfr = __builtin_bit_cast(bf16x8, pb);
#pragma unroll
            for (int dt = 0; dt < 4; ++dt) {
                const LAS unsigned char* vp = lds + AT_VT + (dt * 16 + c) * 528 + ((tile0 + 2 * u) * 16 + 4 * g) * 2;
                const v2u lo = *(const LAS v2u*)vp, hi = *(const LAS v2u*)(vp + 32);
                const v4u av = (v4u){lo.x, lo.y, hi.x, hi.y};
                oacc[dt] = MFMA16(__builtin_bit_cast(bf16x8, av), pfr, oacc[dt]); } }
#pragma unroll
        for (int dt = 0; dt < 4; ++dt) { const f32x4 o = oacc[dt] * inv; v2u wv; wv.x = cvt_pk_bf16(o[0], o[1]); wv.y = cvt_pk_bf16(o[2], o[3]);
            *(v2u*)(qrow + dt * 16 + 4 * g) = wv; }
    }
    __syncthreads();
}

__device__ __forceinline__ void phase_fin(KArg P, int L, int vcu, int G) {
    const int tid = opaque_tid(); const int lane = tid & 63, wave = tid >> 6; const int gw = vcu * 8 + wave, NGW = G * 8;
    bf16* Z = (bf16*)(ka_ws(P) + WS_Z); const float* gn = ka_in(P, 12) + L * DM;
    for (int base = gw; base < MROWS * 4; base += 8 * NGW) {
        v2u hv[8], ov[8];
#pragma unroll
        for (int k = 0; k < 8; ++k) { int pair = base + k * NGW; if (pair >= MROWS * 4) pair = gw; const int row = pair >> 2, h = pair & 3;
            hv[k] = *(const v2u*)(Z + (size_t)row * ZW + ZC_V + h * 256 + lane * 4); ov[k] = *(const v2u*)(Z + (size_t)row * ZW + ZC_O + h * 256 + lane * 4); }
#pragma unroll
        for (int k = 0; k < 8; ++k) { const int pair = base + k * NGW; if (pair >= MROWS * 4) continue; const int row = pair >> 2, h = pair & 3;
            const f32x4 gv = *(const f32x4*)(gn + h * 256 + lane * 4);
            const float x0 = bflo(hv[k].x), x1 = bfhi(hv[k].x), x2 = bflo(hv[k].y), x3 = bfhi(hv[k].y);
            const float ss = wave_sum_dpp((x0 * x0 + x1 * x1) + (x2 * x2 + x3 * x3));
            const float r = rsqrtf(ss * (1.0f / 256.0f) + EPS);
            v2u o; o.x = cvt_pk_bf16(bflo(ov[k].x) * x0 * r * gv[0], bfhi(ov[k].x) * x1 * r * gv[1]); o.y = cvt_pk_bf16(bflo(ov[k].y) * x2 * r * gv[2], bfhi(ov[k].y) * x3 * r * gv[3]);
            *(v2u*)(Z + (size_t)row * ZW + ZC_V + h * 256 + lane * 4) = o; } }
}


#define XB_TMO      128
#define XB_XCNT(j)  (256  + 64 * (j))
#define XB_XSUB(j)  (1280 + 64 * (j))
#define XB_XGEN(j)  (2304 + 64 * (j))
#define XB_TOP      3328
#define XB_TOPGEN   3392
#define XCD_BAR_WORDS 3456
#define XB_SPIN_CAP (1u << 24)
constexpr size_t WS_BAR = 60 * MiB;
constexpr int LDS_XB = 147400;
__device__ __forceinline__ unsigned xb_ld(unsigned* p)              { return __hip_atomic_load(p, __ATOMIC_RELAXED, __HIP_MEMORY_SCOPE_AGENT); }
__device__ __forceinline__ unsigned xb_add(unsigned* p, unsigned v) { return __hip_atomic_fetch_add(p, v, __ATOMIC_RELAXED, __HIP_MEMORY_SCOPE_AGENT); }
__device__ __forceinline__ unsigned xb_xcc_id() { return (unsigned)__builtin_amdgcn_s_getreg((3 << 11) | 20) & 0xFu; }
#define XB_SPIN(cond, bar) do { unsigned _sp = 0; while (cond) { __builtin_amdgcn_s_sleep(1); \
    if ((++_sp & 255u) == 0u) { if (xb_ld(&(bar)[XB_TMO])) break; if (_sp > XB_SPIN_CAP) { atomicAdd(&(bar)[XB_TMO], 1u); break; } } } } while (0)
__device__ __forceinline__ void xcd_barrier_complete(unsigned* bar, unsigned x, unsigned& nloc, unsigned& nx) {
    const unsigned G = gridDim.x * gridDim.y * gridDim.z;
    unsigned sum, cnt, mine, sp = 0u;
    for (;;) {
        sum = 0u; cnt = 0u; mine = 0u;
#pragma unroll
        for (unsigned j = 0; j < 16; ++j) { const unsigned c = xb_ld(&bar[XB_XCNT(j)]); sum += c; cnt += (c > 0u) ? 1u : 0u; mine = (j == x) ? c : mine; }
        if (sum == G) break;
        __builtin_amdgcn_s_sleep(1);
        if ((++sp & 255u) == 0u) { if (xb_ld(&bar[XB_TMO])) break; if (sp > XB_SPIN_CAP) { atomicAdd(&bar[XB_TMO], 1u); break; } }
    }
    nloc = mine > 0u ? mine : 1u; nx = cnt > 0u ? cnt : 1u;
}
__device__ __forceinline__ void xcd_barrier(unsigned* bar, volatile LAS unsigned* st) {
    asm volatile("s_waitcnt vmcnt(0)" ::: "memory");
    __syncthreads();
    if (threadIdx.x == 0) {
        const unsigned x = xb_xcc_id();
        __builtin_amdgcn_s_waitcnt(0);
        unsigned nloc = st[0], nx = st[1];
        if (nloc == 0u) { xcd_barrier_complete(bar, x, nloc, nx); st[0] = nloc; st[1] = nx; }
        const unsigned old = xb_add(&bar[XB_XSUB(x)], 1u);
        const unsigned gen = old / nloc;
        if (old + 1u == (gen + 1u) * nloc) {
            __builtin_amdgcn_fence(__ATOMIC_RELEASE, "agent");
            asm volatile("s_waitcnt vmcnt(0)" ::: "memory");
            const unsigned og = xb_add(&bar[XB_TOP], 1u);
            const unsigned tg = og / nx;
            if (og + 1u == (tg + 1u) * nx) xb_add(&bar[XB_TOPGEN], 1u);
            else XB_SPIN(xb_ld(&bar[XB_TOPGEN]) == tg, bar);
            __builtin_amdgcn_fence(__ATOMIC_ACQUIRE, "agent");
            xb_add(&bar[XB_XGEN(x)], 1u);
            asm volatile("s_waitcnt vmcnt(0)" ::: "memory");
        } else {
            XB_SPIN(xb_ld(&bar[XB_XGEN(x)]) == gen, bar);
            __builtin_amdgcn_fence(__ATOMIC_ACQUIRE, "agent");
            asm volatile("s_waitcnt vmcnt(0)" ::: "memory");
        }
    }
    __syncthreads();
}

constexpr int PH_PER_LAYER = 12;
#define PH_STOP 24
__global__ void __launch_bounds__(512, 2) hybrid_fwd(Params Pk) {
    LAS unsigned char* lds = (LAS unsigned char*)g_lds;
    cg::grid_group grid = cg::this_grid();
    if (threadIdx.x < 2) ((LAS unsigned*)(lds + LDS_XB))[threadIdx.x] = 0u;
    { const KArg P0 = ka_get(); unsigned* bar0 = (unsigned*)(ka_ws(P0) + WS_BAR); if (threadIdx.x == 0) (void)xb_add(&bar0[XB_XCNT(xb_xcc_id())], 1u); }
    __syncthreads();
    bool first = true;
    const int ph_lo = Pk.ph_lo, ph_hi = Pk.ph_hi;
    for (int ph = ph_lo; ph < ph_hi; ++ph) {
        if (!first) {
            if (ph_lo < 0) {
                asm volatile("s_waitcnt vmcnt(0) lgkmcnt(0)" ::: "memory"); grid.sync(); __builtin_amdgcn_fence(__ATOMIC_ACQUIRE, "agent"); asm volatile("s_waitcnt vmcnt(0)" ::: "memory");
            } else { const KArg Pb = ka_get(); xcd_barrier((unsigned*)(ka_ws(Pb) + WS_BAR), (volatile LAS unsigned*)(lds + LDS_XB)); }
        }
        first = false;
        const KArg P = ka_get();
        unsigned char* ws = ka_ws(P); float* out = ka_out(P); int G = gridDim.x, bx = blockIdx.x;
        asm volatile("" : "+s"(G), "+s"(bx));
        const int vcu = (G % 8 == 0) ? (bx % 8) * (G / 8) + bx / 8 : bx;
        bf16* Z = (bf16*)(ws + WS_Z); bf16* HB = (bf16*)(ws + WS_HB); bf16* HB2 = (bf16*)(ws + WS_HB2); bf16* HID = (bf16*)(ws + WS_HID); bf16* PPb = (bf16*)(ws + WS_PP); bf16* T = (bf16*)out;
        const int L = ph / PH_PER_LAYER, q = ph % PH_PER_LAYER;
        float* RSA = (float*)(ws + WS_RSA); float* RSB = (float*)(ws + WS_RSB);
        pg8::StaticOrder S;
        switch (q) {
                case 0: phase_convert(P, L, lds, vcu, G); break;
        case 1: { pg8::Gemm gm{HB2, (const bf16*)(ws + WS_WGU1), MROWS, 5632, DM, DM, DM}; S.init(MROWS, 5632, G, bx);
                  EpiSwiglu E{HID, RSA}; pg8::gemm_phase<EpiSwiglu, true>(lds, gm, S, E); } break;
        case 2: { pg8::Gemm gm{HID, (const bf16*)(ws + WS_WD1), MROWS, DM, DFFP, DFFP, DFFP}; S.init(MROWS, DM, G, bx);
                  EpiRes<0> E{L == 0 ? ka_in(P, 0) : nullptr, nullptr, HB, RSB, 0.5f, nullptr, nullptr, L == 0 ? nullptr : HB2}; pg8::gemm_phase<EpiRes<0>, true>(lds, gm, S, E); } break;
        case 3: { pg8::Gemm gm{HB, (const bf16*)(ws + WS_WIN), MROWS, 5888, DM, DM, DM}; S.init(MROWS, 5888, G, bx);
                  EpiBf<4> E{Z, ZW, nullptr, 0, nullptr, 0, RSB, (float*)(ws + WS_GIF), (bf16*)(ws + WS_HALO)}; pg8::gemm_phase<EpiBf<4>, true>(lds, gm, S, E); } break;
        case 4: {
            conv_pass(P, L, vcu, G);
            for (int u = vcu; u < 1024; u += G) attn_unit(P, L, u >> 7, (u >> 2) & 31, u & 3, lds);
        } break;
        case 5: {
            for (int u = bx; u < 256; u += G) { const int bh = (u >> 6) * 8 + (u & 7), vs = (u >> 3) & 7; mlstm_unit(P, L, bh >> 2, bh & 3, vs, lds); }
        } break;
        case 6: { phase_fin(P, L, vcu, G);
                  pg8::Gemm gm{HB, (const bf16*)(ws + WS_WIN) + (size_t)5888 * DM, MROWS, 2048, DM, DM, DM}; S.init(MROWS, 2048, G, bx);
                  EpiBf<1> E{Z, ZW, nullptr, 0, nullptr, 0, RSB, nullptr, nullptr}; pg8::gemm_phase<EpiBf<1>, true>(lds, gm, S, E); } break;
        case 7: {
                  { pg8::Gemm gm{Z + ZC_V, (const bf16*)(ws + WS_WA), MROWS, DM, DM, ZW, DM}; S.init(MROWS, DM, G, bx);
                    EpiBf<2> E{T, DM, Z, ZW, nullptr, 0, nullptr, nullptr, nullptr}; pg8::gemm_phase<EpiBf<2>, true>(lds, gm, S, E); }
                  { pg8::Gemm gm{Z + ZC_AQ, (const bf16*)(ws + WS_WB), MROWS, DM, DM, ZW, DM}; S.init(MROWS, DM, G, bx);
                    EpiBf<3> E{Z, ZW, T, DM, Z + 1024, ZW, nullptr, nullptr, nullptr}; pg8::gemm_phase<EpiBf<3>, true>(lds, gm, S, E); } } break;
        case 8: { pg8::Gemm gm{Z, (const bf16*)(ws + WS_WOUT), MROWS, DM, DM, ZW, DM}; S.init(MROWS, DM, G, bx);
                  EpiRes<0> E{nullptr, nullptr, HB, RSA, 1.0f, nullptr, nullptr, HB}; pg8::gemm_phase<EpiRes<0>, true>(lds, gm, S, E); } break;
        case 9: { pg8::Gemm gm{HB, (const bf16*)(ws + WS_WGU2), MROWS, 5632, DM, DM, DM}; S.init(MROWS, 5632, G, bx);
                  EpiSwiglu E{HID, RSA}; pg8::gemm_phase<EpiSwiglu, true>(lds, gm, S, E); } break;
        case 10: { { pg8::Gemm gm{HID, (const bf16*)(ws + WS_WD2), MROWS, DM, DFFP, DFFP, DFFP}; S.init(MROWS, DM, G, bx);
                     EpiRes<0> E{nullptr, nullptr, HB, RSB, 0.5f, nullptr, nullptr, HB}; pg8::gemm_phase<EpiRes<0>, true>(lds, gm, S, E); }
                   { pg8::Gemm gm{(const bf16*)(ws + WS_PBF), (const bf16*)(ws + WS_WP), MROWS, DM, PLE, PLE, PLE}; S.init(MROWS, DM, G, bx);
                     EpiBf<0> E{PPb, DM, nullptr, 0, nullptr, 0, nullptr, nullptr}; pg8::gemm_phase<EpiBf<0>, true>(lds, gm, S, E); } } break;
        case 11: { pg8::Gemm gm{HB, (const bf16*)(ws + WS_WPG), MROWS, DM, DM, DM, DM}; S.init(MROWS, DM, G, bx);
                   EpiRes<1> E{nullptr, L == 1 ? out : nullptr, L == 1 ? nullptr : HB2, RSA, 1.0f, RSB, PPb, HB}; pg8::gemm_phase<EpiRes<1>, true>(lds, gm, S, E); } break;
        }
    }
}

extern "C" void kernel_launch(void* const* d_in, const int* in_sizes, int n_in, void* d_out, int out_size, void* d_ws, size_t ws_size, hipStream_t stream) {
    static int grid = 0;
    if (grid == 0) {
        if (n_in != 26 || out_size != MROWS * DM || ws_size < WS_END) { fprintf(stderr, "kernel_launch: unexpected problem (n_in %d out %d ws %zu)\n", n_in, out_size, ws_size); grid = -1; return; }
        int dev = 0, cus = 0, per_cu = 0;
        hipGetDevice(&dev); hipDeviceGetAttribute(&cus, hipDeviceAttributeMultiprocessorCount, dev);
        hipFuncSetAttribute((const void*)hybrid_fwd, hipFuncAttributeMaxDynamicSharedMemorySize, LDS_BYTES);
        hipOccupancyMaxActiveBlocksPerMultiprocessor(&per_cu, (const void*)hybrid_fwd, 512, LDS_BYTES);
        if (per_cu < 1) { fprintf(stderr, "kernel_launch: occupancy query says %d blocks/CU\n", per_cu); per_cu = 1; }
        (void)hipGetLastError();
        grid = cus;
    }
    if (grid < 0) return;
    if (hipMemsetAsync((char*)d_ws + WS_BAR, 0, 16384, stream) != hipSuccess) { fprintf(stderr, "kernel_launch: memset of barrier words failed\n"); return; }
    Params p{};
    for (int i = 0; i < 26; ++i) p.in[i] = (const float*)d_in[i];
    p.out = (float*)d_out; p.ws = (unsigned char*)d_ws; p.ph_lo = 0; p.ph_hi = PH_STOP;
    void* args[] = {&p};
    hipError_t e = hipLaunchCooperativeKernel((const void*)hybrid_fwd, dim3(grid), dim3(512), args, LDS_BYTES, stream);
    if (e != hipSuccess) fprintf(stderr, "cooperative launch failed: %s (grid %d)\n", hipGetErrorString(e), grid);
}
```

```cpp
#include <hip/hip_runtime.h>
#include <hip/hip_cooperative_groups.h>
#include <cstdio>
#include <cstdint>
namespace cg = cooperative_groups;

#define LAS __attribute__((address_space(3)))
typedef unsigned short bf16;
typedef unsigned v4u __attribute__((ext_vector_type(4)));
typedef unsigned v2u __attribute__((ext_vector_type(2)));
typedef float f32x4 __attribute__((ext_vector_type(4)));
typedef short bf16x8 __attribute__((ext_vector_type(8)));
typedef short s16x4 __attribute__((ext_vector_type(4)));

constexpr int MROWS = 32768, DM = 1024, SEQ = 4096, NB = 8, DFF = 2752, DFFP = 2816, NIN = 7688, PLE = 256;
constexpr int ZW = 5632;
constexpr int ZC_V = 2048, ZC_O = 3072, ZC_AQ = 4096, ZC_AK = 5120, ZC_AV = 5376;
constexpr int NWIN = 7936;
constexpr float EPS = 1e-6f;
constexpr size_t MiB = 1u << 20;
constexpr size_t WS_WGU1 = 0, WS_WD1 = 11 * MiB, WS_WIN = 16 * MiB + 512 * 1024, WS_WA = 32 * MiB, WS_WB = 34 * MiB, WS_WOUT = 36 * MiB, WS_WPG = 38 * MiB,
                 WS_WP = 40 * MiB, WS_WGU2 = 40 * MiB + 512 * 1024, WS_WD2 = 51 * MiB + 512 * 1024;
constexpr size_t WS_ROWSS = 57 * MiB;
constexpr size_t WS_GIF = 59 * MiB;
constexpr size_t WS_Z = 62 * MiB;
constexpr size_t WS_HID = WS_Z, WS_PP = WS_Z + 178 * MiB, WS_HB2 = WS_Z + 242 * MiB;
constexpr size_t WS_HB = 414 * MiB;
constexpr size_t WS_PBF = 478 * MiB;
constexpr size_t WS_HALO = 494 * MiB;
constexpr size_t WS_RSA = 500 * MiB, WS_RSB = 502 * MiB;
constexpr size_t WS_END = 504 * MiB;
constexpr int LDS_BYTES = 147456;

typedef float f32x2_t __attribute__((ext_vector_type(2)));
typedef __bf16 bf16x2_t __attribute__((ext_vector_type(2)));
__device__ __forceinline__ unsigned cvt_pk_bf16(float lo, float hi) { f32x2_t v = {lo, hi}; bf16x2_t b = __builtin_convertvector(v, bf16x2_t); return __builtin_bit_cast(unsigned, b); }
__device__ __forceinline__ float bflo(unsigned w) { return __uint_as_float(w << 16); }
__device__ __forceinline__ float bfhi(unsigned w) { return __uint_as_float(w & 0xffff0000u); }
__device__ __forceinline__ float sigm(float x) { return __builtin_amdgcn_rcpf(1.0f + __expf(-x)); }
__device__ __forceinline__ float wave_sum(float v) {
#pragma unroll
    for (int o = 1; o < 64; o <<= 1) v += __shfl_xor(v, o);
    return v;
}
template <int CTRL, int ROWMASK> __device__ __forceinline__ float dppf(float old, float v) { return __int_as_float(__builtin_amdgcn_update_dpp(__float_as_int(old), __float_as_int(v), CTRL, ROWMASK, 0xf, false)); }
__device__ __forceinline__ float wave_scan_add(float v) {
    v += dppf<0x111, 0xf>(0.f, v); v += dppf<0x112, 0xf>(0.f, v); v += dppf<0x114, 0xf>(0.f, v); v += dppf<0x118, 0xf>(0.f, v);
    v += dppf<0x142, 0xa>(0.f, v); v += dppf<0x143, 0xc>(0.f, v); return v; }
__device__ __forceinline__ float wave_scan_max(float v) {
    const float I = -3.0e38f;
    v = fmaxf(v, dppf<0x111, 0xf>(I, v)); v = fmaxf(v, dppf<0x112, 0xf>(I, v)); v = fmaxf(v, dppf<0x114, 0xf>(I, v)); v = fmaxf(v, dppf<0x118, 0xf>(I, v));
    v = fmaxf(v, dppf<0x142, 0xa>(I, v)); v = fmaxf(v, dppf<0x143, 0xc>(I, v)); return v; }
__device__ __forceinline__ float wave_sum_dpp(float v) { return __int_as_float(__builtin_amdgcn_readlane(__float_as_int(wave_scan_add(v)), 63)); }
#define LDS_WAIT() asm volatile("s_waitcnt lgkmcnt(0)" ::: "memory")
__device__ __forceinline__ int opaque_tid() { int t = threadIdx.x; asm volatile("" : "+v"(t)); return t; }

extern __shared__ __attribute__((aligned(16))) unsigned char g_lds[];
namespace pg8 {
constexpr int BM = 256, BK = 64, HALF = 128, HTB = HALF * BK * 2, STAGE_BYTES = 8 * HTB, NXCD = 8, WGM = 8;
constexpr int RSL_OFF = STAGE_BYTES;
__host__ __device__ __forceinline__ int lds_byte(int r, int c) { const int st = (r >> 4) * 2 + (c >> 5), rr = r & 15, cc = c & 31, ob = rr * 64 + cc * 2; return st * 1024 + (ob ^ (((ob >> 9) & 1) << 5)); }
__host__ __device__ __forceinline__ void stage_rc(int b, int& R, int& C) { const int st = b / 1024, sb = b % 1024, swz = sb ^ (((sb >> 9) & 1) << 5); R = (st >> 1) * 16 + swz / 64; C = (st & 1) * 32 + (swz % 64) / 2; }
__host__ __device__ __forceinline__ int perm32(int rho) { const int n = rho >> 4, i = rho & 15; return 8 * (i >> 2) + 4 * n + (i & 3); }
struct Unit { int pm, pn; };
struct Gemm { const bf16* A; const bf16* Bt; int M, N, K, lda, ldb; };
struct StaticOrder {
    int nM, nN, nwg, G, c;
    __device__ void init(int M, int N, int G_, int c_) { nM = M / BM; nN = N / BM; nwg = nM * nN; G = G_; c = c_; }
    __device__ bool next(int i, Unit& u) const {
        const int L = i * G + c; if (L >= nwg) return false;
        int wgid = L; { const int q = nwg / NXCD, r = nwg % NXCD, xcd = wgid % NXCD, off = wgid / NXCD; wgid = (xcd < r ? xcd * (q + 1) : r * (q + 1) + (xcd - r) * q) + off; }
        const int nig = WGM * nN, gid = wgid / nig, fm = gid * WGM, gsz = (nM - fm) < WGM ? (nM - fm) : WGM;
        u.pm = fm + ((wgid % nig) % gsz); u.pn = (wgid % nig) / gsz; return true;
    }
};
template <class Epi, bool ALIGN_EPI>
__device__ __forceinline__ void gemm_phase(LAS unsigned char* lds, const Gemm g, const StaticOrder& S, const Epi& E) {
    int tid_ = threadIdx.x; asm volatile("" : "+v"(tid_));
    const int tid = tid_, wid = __builtin_amdgcn_readfirstlane(tid >> 6), lane = tid & 63, wr = wid >> 2, wc = wid & 3, fr = lane & 15, fq = lane >> 4;
    const int K = g.K, nt = K / BK;
    unsigned voffA[2], voffB[2];
#pragma unroll
    for (int i = 0; i < 2; ++i) { int R, C; stage_rc(tid * 16 + i * 8192, R, C); const int Rb = Epi::PERM ? ((R & ~31) + perm32(R & 31)) : R;
        voffA[i] = (unsigned)(R * g.lda + C) * 2u; voffB[i] = (unsigned)(Rb * g.ldb + C) * 2u; }
    const size_t kstep = (size_t)(BK * 2);
    const size_t hstepA = (size_t)HALF * g.lda * 2, hstepB = (size_t)HALF * g.ldb * 2;
    const size_t tstepA = 2 * hstepA, tstepB = 2 * hstepB;
    const unsigned ldsw = (unsigned)wid * 1024u;
    const int aoff = lds_byte(wr * 64 + fr, fq * 8), boff = lds_byte(wc * 32 + fr, fq * 8);
#define PG8_SA(b, h) (((b) * 2 + (h)) * HTB)
#define PG8_SB(b, h) ((4 + (b) * 2 + (h)) * HTB)
#define PG8_STAGE(bufoff, gbase, voff) do { _Pragma("unroll") for (int _i = 0; _i < 2; ++_i) \
        __builtin_amdgcn_global_load_lds((const unsigned*)((const char*)(gbase) + (voff)[_i]), (LAS unsigned*)(lds + (bufoff) + ldsw + _i * 8192), 16, 0, 0); } while (0)
#define PG8_LDA(dst, b, h) do { _Pragma("unroll") for (int m = 0; m < 4; ++m) _Pragma("unroll") for (int k = 0; k < 2; ++k) dst[m][k] = *(const LAS bf16x8*)(lds + PG8_SA(b, h) + aoff + m * 2048 + k * 1024); } while (0)
#define PG8_LDB(dst, b, h) do { _Pragma("unroll") for (int n = 0; n < 2; ++n) _Pragma("unroll") for (int k = 0; k < 2; ++k) dst[n][k] = *(const LAS bf16x8*)(lds + PG8_SB(b, h) + boff + n * 2048 + k * 1024); } while (0)
#define PG8_MMA(ai, bj, At, Bt) do { __builtin_amdgcn_s_setprio(1); _Pragma("unroll") for (int m = 0; m < 4; ++m) _Pragma("unroll") for (int n = 0; n < 2; ++n) _Pragma("unroll") for (int k = 0; k < 2; ++k) \
        acc[ai][bj][m][n] = __builtin_amdgcn_mfma_f32_16x16x32_bf16(Bt[n][k], At[m][k], acc[ai][bj][m][n], 0, 0, 0); __builtin_amdgcn_s_setprio(0); } while (0)
#define PG8_WAIT_V(n) asm volatile("s_waitcnt vmcnt(" #n ")" ::: "memory")
#define PG8_WAIT_L(n) asm volatile("s_waitcnt lgkmcnt(" #n ")" ::: "memory")
#define PG8_BAR __builtin_amdgcn_s_barrier()
#define PG8_SCHED __builtin_amdgcn_sched_barrier(0)
    Unit cur, nxt; int ui = 0; int cpm = -1;
    if (!S.next(0, cur)) return;
    f32x4 acc[2][2][4][2];
#pragma unroll
    for (int a = 0; a < 2; ++a)
#pragma unroll
        for (int b = 0; b < 2; ++b)
#pragma unroll
            for (int m = 0; m < 4; ++m)
#pragma unroll
                for (int n = 0; n < 2; ++n) acc[a][b][m][n] = (f32x4){0.f, 0.f, 0.f, 0.f};
    bf16x8 At[4][2], B0[2][2], B1[2][2];
    const char* cA = (const char*)g.A + (size_t)cur.pm * tstepA; const char* cB = (const char*)g.Bt + (size_t)cur.pn * tstepB;
    PG8_STAGE(PG8_SB(0, 0), cB, voffB); PG8_STAGE(PG8_SB(0, 1), cB + hstepB, voffB); PG8_STAGE(PG8_SA(0, 0), cA, voffA); PG8_STAGE(PG8_SA(0, 1), cA + hstepA, voffA);
    if (wr == 1) PG8_BAR;
    PG8_WAIT_V(2); PG8_BAR;
    PG8_STAGE(PG8_SB(1, 0), cB + kstep, voffB); PG8_STAGE(PG8_SA(1, 0), cA + kstep, voffA); PG8_STAGE(PG8_SB(1, 1), cB + hstepB + kstep, voffB);
    PG8_WAIT_V(6); PG8_BAR;
    for (;;) {
        const bool has_next = S.next(ui + 1, nxt);
        const char* nA = has_next ? (const char*)g.A + (size_t)nxt.pm * tstepA : cA; const char* nB = has_next ? (const char*)g.Bt + (size_t)nxt.pn * tstepB : cB;
        for (int t = 0; t < nt; t += 2) {
            const bool last = (t == nt - 2);
            const char* a1 = cA + (size_t)(t + 1) * kstep;
            const char* a2 = last ? nA : cA + (size_t)(t + 2) * kstep; const char* b2 = last ? nB : cB + (size_t)(t + 2) * kstep;
            const char* a3 = a2 + kstep; const char* b3 = b2 + kstep;
            PG8_LDB(B0, 0, 0); PG8_LDB(B1, 0, 1); PG8_SCHED; PG8_LDA(At, 0, 0); PG8_STAGE(PG8_SA(1, 1), a1 + hstepA, voffA);
            PG8_WAIT_V(8); PG8_WAIT_L(0); PG8_BAR; PG8_MMA(0, 0, At, B0); PG8_MMA(0, 1, At, B1); PG8_BAR; PG8_SCHED;
            PG8_LDA(At, 0, 1); PG8_STAGE(PG8_SB(0, 0), b2, voffB); PG8_STAGE(PG8_SB(0, 1), b2 + hstepB, voffB); PG8_STAGE(PG8_SA(0, 0), a2, voffA);
            PG8_WAIT_V(8); PG8_WAIT_L(0); PG8_BAR; PG8_MMA(1, 0, At, B0); PG8_MMA(1, 1, At, B1); PG8_BAR; PG8_SCHED;
            PG8_LDB(B0, 1, 0); PG8_LDB(B1, 1, 1); PG8_SCHED; PG8_LDA(At, 1, 0); PG8_STAGE(PG8_SA(0, 1), a2 + hstepA, voffA);
            PG8_WAIT_V(8); PG8_WAIT_L(0); PG8_BAR; PG8_MMA(0, 0, At, B0); PG8_MMA(0, 1, At, B1); PG8_BAR; PG8_SCHED;
            PG8_LDA(At, 1, 1); PG8_STAGE(PG8_SB(1, 0), b3, voffB); PG8_STAGE(PG8_SB(1, 1), b3 + hstepB, voffB); PG8_STAGE(PG8_SA(1, 0), a3, voffA);
            PG8_WAIT_V(8); PG8_WAIT_L(0); PG8_BAR; PG8_MMA(1, 0, At, B0); PG8_MMA(1, 1, At, B1); PG8_BAR; PG8_SCHED;
        }
        if constexpr (ALIGN_EPI) { if (wr == 0) PG8_BAR; }
        if constexpr (Epi::USES_RS) {
            if (cur.pm != cpm) { cpm = cur.pm; const float* rp = E.rs_src();
#pragma unroll
                for (int j = 0; j < 2; ++j) { const int q = lane + 64 * j; const int row = cur.pm * 256 + (q >> 6) * 128 + wr * 64 + (q & 63);
                    const f32x4* p4 = (const f32x4*)(rp + (size_t)row * 16); const f32x4 t4 = (p4[0] + p4[1]) + (p4[2] + p4[3]);
                    ((LAS float*)(lds + RSL_OFF))[wid * 128 + q] = rsqrtf(((t4[0] + t4[1]) + (t4[2] + t4[3])) * (1.0f / 1024.0f) + 1e-6f); } }
        }
        E(acc, cur, wr, wc, fr, fq);
        if (!has_next) break;
#pragma unroll
        for (int a = 0; a < 2; ++a)
#pragma unroll
            for (int b = 0; b < 2; ++b)
#pragma unroll
                for (int m = 0; m < 4; ++m)
#pragma unroll
                    for (int n = 0; n < 2; ++n) acc[a][b][m][n] = (f32x4){0.f, 0.f, 0.f, 0.f};
        cur = nxt; cA = nA; cB = nB; ++ui;
        if constexpr (ALIGN_EPI) { if (wr == 1) PG8_BAR; }
    }
    PG8_WAIT_V(0);
    if constexpr (!ALIGN_EPI) { if (wr == 0) PG8_BAR; }
    PG8_BAR;
#undef PG8_SA
#undef PG8_SB
#undef PG8_STAGE
#undef PG8_LDA
#undef PG8_LDB
#undef PG8_MMA
#undef PG8_WAIT_V
#undef PG8_WAIT_L
#undef PG8_BAR
#undef PG8_SCHED
}
}

typedef const f32x4 (&AccRef)[2][2][4][2];
struct EpiSwiglu {
    static constexpr bool PERM = true, USES_RS = true;
    __device__ __forceinline__ const float* rs_src() const { return rowss; }
    bf16* O; const float* rowss;
    __device__ __forceinline__ void operator()(AccRef acc, const pg8::Unit& u, int, int, int, int) const {
        const int tid = opaque_tid(), wid = __builtin_amdgcn_readfirstlane(tid >> 6), wr = wid >> 2, wc = wid & 3, fr = tid & 15, fq = (tid & 63) >> 4;
        const int row0 = u.pm * 256 + wr * 64 + fr, col0 = u.pn * 128 + wc * 32 + 8 * fq;
#pragma unroll
        for (int ai = 0; ai < 2; ++ai)
#pragma unroll
            for (int m = 0; m < 4; ++m) {
                const int row = row0 + ai * 128 + m * 16; const float rs = ((const LAS float*)((LAS unsigned char*)g_lds + pg8::RSL_OFF))[wid * 128 + ai * 64 + m * 16 + fr];
                float o[8];
#pragma unroll
                for (int n = 0; n < 2; ++n)
#pragma unroll
                    for (int j = 0; j < 4; ++j) { const float gv = acc[ai][0][m][n][j] * rs, uv = acc[ai][1][m][n][j] * rs; o[n * 4 + j] = gv * sigm(gv) * uv; }
                v4u w; w.x = cvt_pk_bf16(o[0], o[1]); w.y = cvt_pk_bf16(o[2], o[3]); w.z = cvt_pk_bf16(o[4], o[5]); w.w = cvt_pk_bf16(o[6], o[7]);
                *(v4u*)(O + (size_t)row * DFFP + col0) = w; }
    }
};
template <int MODE> struct EpiRes {
    static constexpr bool PERM = true, USES_RS = (MODE == 1);
    __device__ __forceinline__ const float* rs_src() const { return rowss_in; }
    const float* hin; float* hout; bf16* hb; float* rowss_out; float alpha; const float* rowss_in; const bf16* pp; const bf16* hinb;
    __device__ __forceinline__ void operator()(AccRef acc, const pg8::Unit& u, int, int, int, int) const {
        const int tid = opaque_tid(), wid = __builtin_amdgcn_readfirstlane(tid >> 6), wr = wid >> 2, wc = wid & 3, fr = tid & 15, fq = (tid & 63) >> 4;
        const int row0 = u.pm * 256 + wr * 64 + fr, col0 = u.pn * 256 + wc * 32 + 8 * fq;
#pragma unroll
        for (int ai = 0; ai < 2; ++ai)
#pragma unroll
            for (int m = 0; m < 4; ++m) {
                const int row = row0 + ai * 128 + m * 16; float ss = 0.f; float rs = 1.f;
                if (MODE == 1) rs = ((const LAS float*)((LAS unsigned char*)g_lds + pg8::RSL_OFF))[wid * 128 + ai * 64 + m * 16 + fr];
#pragma unroll
                for (int bj = 0; bj < 2; ++bj) {
                    const size_t off = (size_t)row * DM + col0 + bj * 128;
                    f32x4 h0, h1; const f32x4 a0 = acc[ai][bj][m][0], a1 = acc[ai][bj][m][1];
                    if (hin) { h0 = *(const f32x4*)(hin + off); h1 = *(const f32x4*)(hin + off + 4); }
                    else { const v4u hw = *(const v4u*)(hinb + off); h0 = (f32x4){bflo(hw.x), bfhi(hw.x), bflo(hw.y), bfhi(hw.y)}; h1 = (f32x4){bflo(hw.z), bfhi(hw.z), bflo(hw.w), bfhi(hw.w)}; }
                    if (MODE == 0) { h0 = h0 + a0 * alpha; h1 = h1 + a1 * alpha; }
                    else { const v4u pw = *(const v4u*)(pp + off);
                        h0[0] += sigm(a0[0] * rs) * bflo(pw.x); h0[1] += sigm(a0[1] * rs) * bfhi(pw.x); h0[2] += sigm(a0[2] * rs) * bflo(pw.y); h0[3] += sigm(a0[3] * rs) * bfhi(pw.y);
                        h1[0] += sigm(a1[0] * rs) * bflo(pw.z); h1[1] += sigm(a1[1] * rs) * bfhi(pw.z); h1[2] += sigm(a1[2] * rs) * bflo(pw.w); h1[3] += sigm(a1[3] * rs) * bfhi(pw.w); }
                    if (hout) { *(f32x4*)(hout + off) = h0; *(f32x4*)(hout + off + 4) = h1; }
                    if (hb) { v4u w; w.x = cvt_pk_bf16(h0[0], h0[1]); w.y = cvt_pk_bf16(h0[2], h0[3]); w.z = cvt_pk_bf16(h1[0], h1[1]); w.w = cvt_pk_bf16(h1[2], h1[3]); *(v4u*)(hb + off) = w; }
                    ss += ((h0[0] * h0[0] + h0[1] * h0[1]) + (h0[2] * h0[2] + h0[3] * h0[3])) + ((h1[0] * h1[0] + h1[1] * h1[1]) + (h1[2] * h1[2] + h1[3] * h1[3])); }
                ss += __shfl_xor(ss, 16); ss += __shfl_xor(ss, 32);
                if (fq == 0) rowss_out[(size_t)row * 16 + u.pn * 4 + wc] = ss;
                if (m == 3) asm volatile("" ::: "memory"); }
    }
};
template <int MODE> struct EpiBf {
    static constexpr bool PERM = true, USES_RS = (MODE == 1 || MODE == 4);
    __device__ __forceinline__ const float* rs_src() const { return rowss; }
    bf16* O; int ldo; const bf16* a1; int ld1; const bf16* a2; int ld2; const float* rowss; float* gif; bf16* halo;
    __device__ __forceinline__ void operator()(AccRef acc, const pg8::Unit& u, int, int, int, int) const {
        const int tid = opaque_tid(), wid = __builtin_amdgcn_readfirstlane(tid >> 6), wr = wid >> 2, wc = wid & 3, fr = tid & 15, fq = (tid & 63) >> 4;
        const int row0 = u.pm * 256 + wr * 64 + fr, col0 = u.pn * 256 + wc * 32 + 8 * fq;
        if (MODE == 4 && u.pn == 22) {
            if (wc == 0 && fq == 0) {
#pragma unroll
                for (int ai = 0; ai < 2; ++ai)
#pragma unroll
                    for (int m = 0; m < 4; ++m) { const int row = row0 + ai * 128 + m * 16; const float rs = ((const LAS float*)((LAS unsigned char*)g_lds + pg8::RSL_OFF))[wid * 128 + ai * 64 + m * 16 + fr];
                        *(f32x4*)(gif + (size_t)row * 8) = acc[ai][0][m][0] * rs; *(f32x4*)(gif + (size_t)row * 8 + 4) = acc[ai][0][m][1] * rs; }
            }
            return;
        }
        const bool sg = (MODE == 1) || (MODE == 4 && u.pn >= 12 && u.pn < 16);
#pragma unroll
        for (int ai = 0; ai < 2; ++ai)
#pragma unroll
            for (int m = 0; m < 4; ++m) {
                const int row = row0 + ai * 128 + m * 16; float rs = 1.f;
                if (MODE == 1 || MODE == 4) rs = ((const LAS float*)((LAS unsigned char*)g_lds + pg8::RSL_OFF))[wid * 128 + ai * 64 + m * 16 + fr];
#pragma unroll
                for (int bj = 0; bj < 2; ++bj) {
                    const int col = col0 + bj * 128; float o[8];
#pragma unroll
                    for (int n = 0; n < 2; ++n)
#pragma unroll
                        for (int j = 0; j < 4; ++j) o[n * 4 + j] = acc[ai][bj][m][n][j] * rs;
                    if (sg) {
#pragma unroll
                        for (int j = 0; j < 8; ++j) o[j] = sigm(o[j]); }
                    if (MODE == 2 || MODE == 3) {
                        const v4u x = *(const v4u*)(a1 + (size_t)row * ld1 + col);
                        float xf[8] = {bflo(x.x), bfhi(x.x), bflo(x.y), bfhi(x.y), bflo(x.z), bfhi(x.z), bflo(x.w), bfhi(x.w)};
                        if (MODE == 2) {
#pragma unroll
                            for (int j = 0; j < 8; ++j) o[j] *= xf[j]; }
                        else { const v4u y = *(const v4u*)(a2 + (size_t)row * ld2 + col);
                            float yf[8] = {bflo(y.x), bfhi(y.x), bflo(y.y), bfhi(y.y), bflo(y.z), bfhi(y.z), bflo(y.w), bfhi(y.w)};
#pragma unroll
                            for (int j = 0; j < 8; ++j) o[j] = xf[j] + yf[j] * o[j]; }
                    }
                    v4u w; w.x = cvt_pk_bf16(o[0], o[1]); w.y = cvt_pk_bf16(o[2], o[3]); w.z = cvt_pk_bf16(o[4], o[5]); w.w = cvt_pk_bf16(o[6], o[7]);
                    *(v4u*)(O + (size_t)row * ldo + col) = w;
                    if (MODE == 4 && m == 3) { if (u.pn < 8 && fr >= 13) *(v4u*)(halo + ((size_t)(row >> 6) * 3 + (fr - 13)) * 2048 + col) = w; } }
                if ((MODE == 2 || MODE == 3) && (m & 1)) asm volatile("" ::: "memory"); }
    }
};

struct Params { const float* in[26]; float* out; unsigned char* ws; int ph_lo, ph_hi; };
typedef const __attribute__((address_space(4))) unsigned char* KArg;
__device__ __forceinline__ KArg ka_get() { KArg k = (KArg)__builtin_amdgcn_kernarg_segment_ptr(); asm volatile("" : "+s"(k)); return k; }
__device__ __forceinline__ const float* ka_in(KArg k, int i) { return *(const float* const __attribute__((address_space(4)))*)(k + 8 * i); }
__device__ __forceinline__ float* ka_out(KArg k) { return *(float* const __attribute__((address_space(4)))*)(k + 208); }
__device__ __forceinline__ unsigned char* ka_ws(KArg k) { return *(unsigned char* const __attribute__((address_space(4)))*)(k + 216); }
static_assert(sizeof(Params) == 232, "kernarg layout");

template <int KIND>
__device__ __forceinline__ void tr_item(const float* src, const float* src2, int srcN, int Ksrc, const float* gain, bf16* WT, int Kd, int nblk, int item, LAS float* scr, int lane) {
    const int kb = item / nblk, nb = item % nblk, k0 = 64 * kb, n0 = 64 * nb;
    const int n = n0 + (lane & 15) * 4;
    const float* cp = nullptr;
    if (KIND == 0) cp = src + n;
    if (KIND == 1) { const int hid = (n >> 8) * 128 + (n & 127); if (hid < DFF) cp = (((n >> 7) & 1) ? src2 : src) + hid; }
    if (KIND == 2) { if (n < 4096) cp = src + n; else if (n < 5632) cp = src + n + 8; else if (n < 5888) { if (n - 5632 < 8) cp = src + 4096 + (n - 5632); } else cp = src + 5640 + (n - 5888); }
    f32x4 v[16];
#pragma unroll
    for (int i = 0; i < 16; ++i) { const int k = k0 + 4 * i + (lane >> 4);
        v[i] = (cp != nullptr && k < Ksrc) ? *(const f32x4*)(cp + (size_t)k * srcN) : (f32x4){0.f, 0.f, 0.f, 0.f}; }
#pragma unroll
    for (int i = 0; i < 16; ++i) { LAS float* d = scr + (4 * i + (lane >> 4)) * 65 + (lane & 15) * 4; d[0] = v[i][0]; d[1] = v[i][1]; d[2] = v[i][2]; d[3] = v[i][3]; }
    LDS_WAIT(); asm volatile("" ::: "memory");
    const int c = lane & 7;
    float gk[8];
#pragma unroll
    for (int e = 0; e < 8; ++e) gk[e] = 1.0f;
    if (gain) { const f32x4 a = *(const f32x4*)(gain + k0 + 8 * c), b = *(const f32x4*)(gain + k0 + 8 * c + 4); gk[0] = a[0]; gk[1] = a[1]; gk[2] = a[2]; gk[3] = a[3]; gk[4] = b[0]; gk[5] = b[1]; gk[6] = b[2]; gk[7] = b[3]; }
#pragma unroll
    for (int j = 0; j < 8; ++j) { const int nn = (lane >> 3) + 8 * j; const LAS float* sp = scr + (8 * c) * 65 + nn;
        v4u o; o.x = cvt_pk_bf16(sp[0 * 65] * gk[0], sp[1 * 65] * gk[1]); o.y = cvt_pk_bf16(sp[2 * 65] * gk[2], sp[3 * 65] * gk[3]); o.z = cvt_pk_bf16(sp[4 * 65] * gk[4], sp[5 * 65] * gk[5]); o.w = cvt_pk_bf16(sp[6 * 65] * gk[6], sp[7 * 65] * gk[7]);
        *(v4u*)(WT + (size_t)(n0 + nn) * Kd + k0 + 8 * c) = o; }
    LDS_WAIT(); asm volatile("" ::: "memory");
}

__device__ __forceinline__ void phase_convert(KArg P, int L, LAS unsigned char* lds, int vcu, int G) {
    const int tid = opaque_tid(); const int lane = tid & 63, wave = tid >> 6;
    LAS float* scr = (LAS float*)(lds + wave * 16640);
    const int gw = vcu * 8 + wave, NGW = G * 8;
    unsigned char* ws = ka_ws(P);
    constexpr int I_GU = 16 * 88, I_D = 44 * 16, I_IN = 16 * 124, I_SQ = 16 * 16, I_P = 4 * 16;
    const size_t oGU = (size_t)L * DM * DFF, oSQ = (size_t)L * DM * DM;
    int off = 0;
#define CONV_LOOP(ITEMS, CALL) do { for (int it = (gw - off % NGW + NGW) % NGW; it < (ITEMS); it += NGW) { CALL; } off += (ITEMS); } while (0)
    CONV_LOOP(I_GU, tr_item<1>(ka_in(P, 3) + oGU, ka_in(P, 4) + oGU, DFF, DM, ka_in(P, 2) + L * DM, (bf16*)(ws + WS_WGU1), DM, 88, it, scr, lane));
    CONV_LOOP(I_D,  tr_item<0>(ka_in(P, 5) + oGU, nullptr, DM, DFF, nullptr, (bf16*)(ws + WS_WD1), DFFP, 16, it, scr, lane));
    CONV_LOOP(I_IN, tr_item<2>(ka_in(P, 7) + (size_t)L * DM * NIN, nullptr, NIN, DM, ka_in(P, 6) + L * DM, (bf16*)(ws + WS_WIN), DM, 124, it, scr, lane));
    CONV_LOOP(I_SQ, tr_item<0>(ka_in(P, 16) + oSQ, nullptr, DM, DM, nullptr, (bf16*)(ws + WS_WA), DM, 16, it, scr, lane));
    CONV_LOOP(I_SQ, tr_item<0>(ka_in(P, 17) + oSQ, nullptr, DM, DM, nullptr, (bf16*)(ws + WS_WB), DM, 16, it, scr, lane));
    CONV_LOOP(I_SQ, tr_item<0>(ka_in(P, 18) + oSQ, nullptr, DM, DM, nullptr, (bf16*)(ws + WS_WOUT), DM, 16, it, scr, lane));
    CONV_LOOP(I_GU, tr_item<1>(ka_in(P, 20) + oGU, ka_in(P, 21) + oGU, DFF, DM, ka_in(P, 19) + L * DM, (bf16*)(ws + WS_WGU2), DM, 88, it, scr, lane));
    CONV_LOOP(I_D,  tr_item<0>(ka_in(P, 22) + oGU, nullptr, DM, DFF, nullptr, (bf16*)(ws + WS_WD2), DFFP, 16, it, scr, lane));
    CONV_LOOP(I_SQ, tr_item<0>(ka_in(P, 24) + oSQ, nullptr, DM, DM, ka_in(P, 23) + L * DM, (bf16*)(ws + WS_WPG), DM, 16, it, scr, lane));
    CONV_LOOP(I_P,  tr_item<0>(ka_in(P, 25) + (size_t)L * PLE * DM, nullptr, DM, PLE, nullptr, (bf16*)(ws + WS_WP), PLE, 16, it, scr, lane));
#undef CONV_LOOP
    const float* pl = ka_in(P, 1) + (size_t)L * MROWS * PLE; bf16* pbf = (bf16*)(ws + WS_PBF);
    for (int m0 = gw; m0 < MROWS; m0 += 4 * NGW) { f32x4 v[4];
#pragma unroll
        for (int k = 0; k < 4; ++k) { const int m = (m0 + k * NGW < MROWS) ? m0 + k * NGW : m0; v[k] = *(const f32x4*)(pl + (size_t)m * PLE + lane * 4); }
#pragma unroll
        for (int k = 0; k < 4; ++k) { const int m = m0 + k * NGW; if (m < MROWS) { v2u w; w.x = cvt_pk_bf16(v[k][0], v[k][1]); w.y = cvt_pk_bf16(v[k][2], v[k][3]); *(v2u*)(pbf + (size_t)m * PLE + lane * 4) = w; } } }
    if (L == 0) {
        float* rowss = (float*)(ws + WS_RSA); bf16* hb2 = (bf16*)(ws + WS_HB2); const float* x = ka_in(P, 0);
        for (int m0 = gw; m0 < MROWS; m0 += 2 * NGW) { f32x4 v[2][4];
#pragma unroll
            for (int k = 0; k < 2; ++k) { const int m = (m0 + k * NGW < MROWS) ? m0 + k * NGW : m0;
#pragma unroll
                for (int j = 0; j < 4; ++j) v[k][j] = *(const f32x4*)(x + (size_t)m * DM + j * 256 + lane * 4); }
#pragma unroll
            for (int k = 0; k < 2; ++k) { const int m = m0 + k * NGW; if (m >= MROWS) continue; float ss = 0.f;
#pragma unroll
                for (int j = 0; j < 4; ++j) { const f32x4 t = v[k][j];
                    v2u w; w.x = cvt_pk_bf16(t[0], t[1]); w.y = cvt_pk_bf16(t[2], t[3]); *(v2u*)(hb2 + (size_t)m * DM + j * 256 + lane * 4) = w;
                    ss += (t[0] * t[0] + t[1] * t[1]) + (t[2] * t[2] + t[3] * t[3]); }
                ss = wave_sum_dpp(ss); if (lane < 16) rowss[(size_t)m * 16 + lane] = (lane == 0) ? ss : 0.f; } }
    }
}

__device__ __forceinline__ void conv_pass(KArg P, int L, int vcu, int G) {
    const int tid = opaque_tid();
    bf16* Z = (bf16*)(ka_ws(P) + WS_Z); const bf16* halo = (const bf16*)(ka_ws(P) + WS_HALO);
    const float* cwp = ka_in(P, 8) + (size_t)L * 4 * 2048; const float* cbp = ka_in(P, 9) + (size_t)L * 2048;
    for (int rg = vcu * 2 + (tid >> 8); rg < 512; rg += 2 * G) {
        const int col = (tid & 255) * 8;
        float cw[4][8], cb[8];
#pragma unroll
        for (int j = 0; j < 4; ++j) { const f32x4 a = *(const f32x4*)(cwp + j * 2048 + col), b = *(const f32x4*)(cwp + j * 2048 + col + 4);
            cw[j][0] = a[0]; cw[j][1] = a[1]; cw[j][2] = a[2]; cw[j][3] = a[3]; cw[j][4] = b[0]; cw[j][5] = b[1]; cw[j][6] = b[2]; cw[j][7] = b[3]; }
        { const f32x4 a = *(const f32x4*)(cbp + col), b = *(const f32x4*)(cbp + col + 4); cb[0] = a[0]; cb[1] = a[1]; cb[2] = a[2]; cb[3] = a[3]; cb[4] = b[0]; cb[5] = b[1]; cb[6] = b[2]; cb[7] = b[3]; }
        v4u w0 = (v4u){0u, 0u, 0u, 0u}, w1 = w0, w2 = w0;
        if ((rg & 63) != 0) { const bf16* hp = halo + (size_t)(rg - 1) * 3 * 2048 + col; w0 = *(const v4u*)hp; w1 = *(const v4u*)(hp + 2048); w2 = *(const v4u*)(hp + 4096); }
        const float sc = (col < 1024) ? 0.0625f : 1.0f;
        bf16* zp = Z + (size_t)rg * 64 * ZW + col;
        for (int i0 = 0; i0 < 64; i0 += 8) {
            v4u x[8];
#pragma unroll
            for (int r = 0; r < 8; ++r) x[r] = *(const v4u*)(zp + (size_t)(i0 + r) * ZW);
#pragma unroll
            for (int r = 0; r < 8; ++r) {
                const v4u x3 = x[r]; float o[8];
#define CONV_E(e, W0, W1, W2, W3) o[e] = cb[e] + cw[0][e] * (W0) + cw[1][e] * (W1) + cw[2][e] * (W2) + cw[3][e] * (W3)
                CONV_E(0, bflo(w0.x), bflo(w1.x), bflo(w2.x), bflo(x3.x)); CONV_E(1, bfhi(w0.x), bfhi(w1.x), bfhi(w2.x), bfhi(x3.x));
                CONV_E(2, bflo(w0.y), bflo(w1.y), bflo(w2.y), bflo(x3.y)); CONV_E(3, bfhi(w0.y), bfhi(w1.y), bfhi(w2.y), bfhi(x3.y));
                CONV_E(4, bflo(w0.z), bflo(w1.z), bflo(w2.z), bflo(x3.z)); CONV_E(5, bfhi(w0.z), bfhi(w1.z), bfhi(w2.z), bfhi(x3.z));
                CONV_E(6, bflo(w0.w), bflo(w1.w), bflo(w2.w), bflo(x3.w)); CONV_E(7, bfhi(w0.w), bfhi(w1.w), bfhi(w2.w), bfhi(x3.w));
#undef CONV_E
#pragma unroll
                for (int e = 0; e < 8; ++e) o[e] = o[e] * sigm(o[e]) * sc;
                *(v4u*)(zp + (size_t)(i0 + r) * ZW) = (v4u){cvt_pk_bf16(o[0], o[1]), cvt_pk_bf16(o[2], o[3]), cvt_pk_bf16(o[4], o[5]), cvt_pk_bf16(o[6], o[7])};
                w0 = w1; w1 = w2; w2 = x3; }
        }
    }
}

constexpr int ML_QS = 0, ML_KS = 33792, ML_KT = 67584, ML_VT = 104448, ML_VWT = 109056, ML_CB = 113664, ML_PS = 130560, ML_FL = 139776;
constexpr int FL_A = 0, FL_MX = 64, FL_WIN = 128, FL_FLOOR = 192, FL_WST = 256, FL_SC = 320, FL_WSTB = 328, FL_GSZ = 360;
constexpr int FL_QN = 720;
constexpr int ML_NB = ML_FL + 784 * 4;
#define MFMA16(a, b, c) __builtin_amdgcn_mfma_f32_16x16x32_bf16((a), (b), (c), 0, 0, 0)

__device__ __forceinline__ void mlstm_unit(KArg P, int L, int b, int h, int vs, LAS unsigned char* lds) {
    const int tid = opaque_tid(), lane = tid & 63, w = __builtin_amdgcn_readfirstlane(tid >> 6), c = lane & 15, g = lane >> 4;
    bf16* Z = (bf16*)(ka_ws(P) + WS_Z); const float* gif = (const float*)(ka_ws(P) + WS_GIF);
    LAS float* FL = (LAS float*)(lds + ML_FL);
    const int cgp = lane, isk = cgp >> 5;
    const int zcol = (isk ? 1024 : 0) + h * 256 + (cgp & 31) * 8;
    const float bi = ka_in(P, 10)[L * 4 + h], bfg = ka_in(P, 11)[L * 4 + h];
    const size_t rowbase = (size_t)b * SEQ;
    for (int i = tid; i < 32 * 264 / 2; i += 512) ((LAS unsigned*)(lds + ML_CB))[i] = 0u;
    if (tid < 128) ((LAS unsigned*)(lds + ML_NB))[tid] = 0u;
    f32x4 Cn[2] = {(f32x4){0.f, 0.f, 0.f, 0.f}, (f32x4){0.f, 0.f, 0.f, 0.f}};
    f32x4 Cacc[2][2];
#pragma unroll
    for (int a = 0; a < 2; ++a)
#pragma unroll
        for (int d = 0; d < 2; ++d) Cacc[a][d] = (f32x4){0.f, 0.f, 0.f, 0.f};
    float m_st = 0.f;
    v4u raw[8]; v4u vraw = (v4u){0u, 0u, 0u, 0u}; float zi = 0.f, zf = 0.f;
    auto prefetch = [&](int ch) {
        const int t0 = ch * 64;
#pragma unroll
        for (int r = 0; r < 8; ++r) raw[r] = *(const v4u*)(Z + (rowbase + t0 + w * 8 + r) * ZW + zcol);
        if (tid < 256) vraw = *(const v4u*)(Z + (rowbase + t0 + (tid >> 2)) * ZW + ZC_V + h * 256 + vs * 32 + (tid & 3) * 8);
        if (tid >= 448) { zi = gif[(rowbase + t0 + lane) * 8 + h]; zf = gif[(rowbase + t0 + lane) * 8 + 4 + h]; }
    };
    auto gates = [&](LAS float* gb) {
        const float ig = zi + bi; const float xf = zf + bfg; const float lf = fminf(xf, 0.f) - __logf(1.0f + __expf(-fabsf(xf)));
        const float bsum = wave_scan_add(lf);
        const float a = ig - bsum; const float pm = wave_scan_max(a);
        const float Mx = fmaxf(m_st, pm);
        const float M63 = __int_as_float(__builtin_amdgcn_readlane(__float_as_int(Mx), 63)), blast = __int_as_float(__builtin_amdgcn_readlane(__float_as_int(bsum), 63));
        gb[FL_A + lane] = a; gb[FL_MX + lane] = Mx; gb[FL_WIN + lane] = __expf(m_st - Mx); gb[FL_FLOOR + lane] = __expf(-(bsum + Mx)); { const float wst = __expf(a - M63); gb[FL_WST + lane] = wst; ((LAS bf16*)(gb + FL_WSTB))[lane] = (bf16)(cvt_pk_bf16(wst, 0.f) & 0xffffu); }
        if (lane == 0) gb[FL_SC] = __expf(m_st - M63);
        m_st = blast + M63;
    };
    auto stage_qk = [&]() {
#pragma unroll
        for (int r = 0; r < 8; ++r) *(LAS v4u*)(lds + (isk ? ML_KS : ML_QS) + (w * 8 + r) * 528 + (cgp & 31) * 16) = raw[r];
    };
    auto stage_kt_v = [&](LAS float* gbn) {
        if (isk) {
#pragma unroll
            for (int e = 0; e < 8; ++e) {
                v4u t;
#define PKW(r) ((e >> 1) == 0 ? raw[r].x : (e >> 1) == 1 ? raw[r].y : (e >> 1) == 2 ? raw[r].z : raw[r].w)
                if (e & 1) { t.x = (PKW(0) >> 16) | (PKW(1) & 0xffff0000u); t.y = (PKW(2) >> 16) | (PKW(3) & 0xffff0000u); t.z = (PKW(4) >> 16) | (PKW(5) & 0xffff0000u); t.w = (PKW(6) >> 16) | (PKW(7) & 0xffff0000u); }
                else { t.x = (PKW(0) & 0xffffu) | (PKW(1) << 16); t.y = (PKW(2) & 0xffffu) | (PKW(3) << 16); t.z = (PKW(4) & 0xffffu) | (PKW(5) << 16); t.w = (PKW(6) & 0xffffu) | (PKW(7) << 16); }
#undef PKW
                *(LAS v4u*)(lds + ML_KT + ((cgp & 31) * 8 + e) * 144 + w * 16) = t; }
        }
        if (tid < 256) { const int s = tid >> 2, part = tid & 3; const float ws_ = gbn[FL_WST + s];
            const unsigned xs[4] = {vraw.x, vraw.y, vraw.z, vraw.w};
#pragma unroll
            for (int e = 0; e < 8; ++e) { const unsigned wd = xs[e >> 1]; const float v = (e & 1) ? bfhi(wd) : bflo(wd);
                *(LAS bf16*)(lds + ML_VT + (part * 8 + e) * 144 + s * 2) = (bf16)((e & 1) ? (wd >> 16) : (wd & 0xffffu));
                *(LAS bf16*)(lds + ML_VWT + (part * 8 + e) * 144 + s * 2) = (bf16)(cvt_pk_bf16(v * ws_, 0.f) & 0xffffu); } }
    };
    prefetch(0);
    if (w == 7) gates(FL);
    __syncthreads();
    stage_qk(); stage_kt_v(FL);
    __syncthreads();
    const int ttile = w >> 1, par = w & 1;
    for (int ch = 0; ch < 64; ++ch) {
        const int t0 = ch * 64;
        LAS float* GB = FL + (ch & 1) * FL_GSZ;
        if (ch + 1 < 64) prefetch(ch + 1);
        f32x4 accS0 = (f32x4){0.f, 0.f, 0.f, 0.f}, accS1 = accS0, accI = accS0, accN = accS0;
        const bf16x8 zero8 = (bf16x8){0, 0, 0, 0, 0, 0, 0, 0};
        {
            const LAS unsigned char* qp = lds + ML_QS + (ttile * 16 + c) * 528 + g * 16;
            const LAS unsigned char* k0p = lds + ML_KS + ((par * 2 + 0) * 16 + c) * 528 + g * 16;
            const LAS unsigned char* k1p = lds + ML_KS + ((par * 2 + 1) * 16 + c) * 528 + g * 16;
            const LAS unsigned char* cp = lds + ML_CB + (par * 16 + c) * 528 + g * 16;
#pragma unroll 2
            for (int kk = 0; kk < 8; ++kk) {
                const bf16x8 a = *(const LAS bf16x8*)(qp + kk * 64);
                const bf16x8 b0 = *(const LAS bf16x8*)(k0p + kk * 64), b1 = *(const LAS bf16x8*)(k1p + kk * 64), bc = *(const LAS bf16x8*)(cp + kk * 64);
                accS0 = MFMA16(a, b0, accS0); accS1 = MFMA16(a, b1, accS1); accI = MFMA16(a, bc, accI);
                { const bf16x8 bn = *(const LAS bf16x8*)(lds + ML_NB + kk * 64 + g * 16); accN = MFMA16(a, bn, accN); } }
#pragma unroll
            for (int r = 0; r < 4; ++r) { const int t = ttile * 16 + 4 * g + r; const float Mt = GB[FL_MX + t];
                const int s0 = (par * 2) * 16 + c, s1 = s0 + 16;
                const float w0 = (s0 <= t) ? __expf(GB[FL_A + s0] - Mt) : 0.f, w1 = (s1 <= t) ? __expf(GB[FL_A + s1] - Mt) : 0.f;
                *(LAS bf16*)(lds + ML_PS + t * 144 + s0 * 2) = (bf16)(cvt_pk_bf16(accS0[r] * w0, 0.f) & 0xffffu);
                *(LAS bf16*)(lds + ML_PS + t * 144 + s1 * 2) = (bf16)(cvt_pk_bf16(accS1[r] * w1, 0.f) & 0xffffu); }
        }
        __syncthreads();
        {
            f32x4 accP = (f32x4){0.f, 0.f, 0.f, 0.f}, accR = accP;
            const bf16x8 ones8 = (bf16x8){0x3f80, 0x3f80, 0x3f80, 0x3f80, 0x3f80, 0x3f80, 0x3f80, 0x3f80};
#pragma unroll
            for (int ks = 0; ks < 2; ++ks) {
                const bf16x8 a = *(const LAS bf16x8*)(lds + ML_PS + (ttile * 16 + c) * 144 + ks * 64 + g * 16);
                const bf16x8 bv = *(const LAS bf16x8*)(lds + ML_VT + (par * 16 + c) * 144 + ks * 64 + g * 16);
                accP = MFMA16(a, bv, accP); accR = MFMA16(a, ones8, accR); }
#pragma unroll
            for (int r = 0; r < 4; ++r) { const int t = ttile * 16 + 4 * g + r; const float wi = GB[FL_WIN + t];
                const float num = accP[r] + wi * accI[r]; const float den = accR[r] + wi * accN[r];
                const float hv = num * __builtin_amdgcn_rcpf(fmaxf(fabsf(den), GB[FL_FLOOR + t]));
                Z[(rowbase + t0 + t) * ZW + ZC_V + h * 256 + vs * 32 + par * 16 + c] = (bf16)(cvt_pk_bf16(hv, 0.f) & 0xffffu); }
            const float decay = GB[FL_SC];
            const LAS unsigned char* wsb = (const LAS unsigned char*)(GB + FL_WSTB);
#pragma unroll
            for (int kt = 0; kt < 2; ++kt) {
                bf16x8 bk[2];
#pragma unroll
                for (int ks = 0; ks < 2; ++ks) bk[ks] = *(const LAS bf16x8*)(lds + ML_KT + ((2 * w + kt) * 16 + c) * 144 + ks * 64 + g * 16);
#pragma unroll
                for (int vt = 0; vt < 2; ++vt) {
                    f32x4 cc = Cacc[kt][vt] * decay;
#pragma unroll
                    for (int ks = 0; ks < 2; ++ks) { const bf16x8 a = *(const LAS bf16x8*)(lds + ML_VWT + (vt * 16 + c) * 144 + ks * 64 + g * 16); cc = MFMA16(a, bk[ks], cc); }
                    Cacc[kt][vt] = cc;
#pragma unroll
                    for (int r = 0; r < 4; ++r) *(LAS bf16*)(lds + ML_CB + (vt * 16 + 4 * g + r) * 528 + ((2 * w + kt) * 16 + c) * 2) = (bf16)(cvt_pk_bf16(cc[r], 0.f) & 0xffffu);
                }
                f32x4 cn = Cn[kt] * decay;
#pragma unroll
                for (int ks = 0; ks < 2; ++ks) { const bf16x8 an = *(const LAS bf16x8*)(wsb + ks * 64 + g * 16); cn = MFMA16(an, bk[ks], cn); }
                Cn[kt] = cn;
                if (g == 0) *(LAS bf16*)(lds + ML_NB + ((2 * w + kt) * 16 + c) * 2) = (bf16)(cvt_pk_bf16(cn[0], 0.f) & 0xffffu);
            }
            if (w == 7 && ch + 1 < 64) gates(FL + ((ch + 1) & 1) * FL_GSZ);
            if (ch + 1 < 64) stage_qk();
        }
        __syncthreads();
        if (ch + 1 < 64) stage_kt_v(FL + ((ch + 1) & 1) * FL_GSZ);
    }
    __syncthreads();
}

constexpr int AT_K = 0, AT_VT = 36864;
__device__ __forceinline__ void attn_unit(KArg P, int L, int b, int nb, int kvh, LAS unsigned char* lds) {
    const int tid = opaque_tid(), lane = tid & 63, w = __builtin_amdgcn_readfirstlane(tid >> 6), c = lane & 15, g = lane >> 4;
    bf16* Z = (bf16*)(ka_ws(P) + WS_Z);
    const float* gq = ka_in(P, 13) + L * 64; const float* gk = ka_in(P, 14) + L * 64; const float* sinks = ka_in(P, 15) + L * 16;
    const size_t rowbase = (size_t)b * SEQ;
#pragma unroll
    for (int r = 0; r < 4; ++r) { const int item = tid + 512 * r, key = item >> 3, part = item & 7; const int t = nb * 128 - 128 + key;
        v4u kx = (v4u){0u, 0u, 0u, 0u}, vx = kx;
        if (t >= 0) { kx = *(const v4u*)(Z + (rowbase + t) * ZW + ZC_AK + kvh * 64 + part * 8); vx = *(const v4u*)(Z + (rowbase + t) * ZW + ZC_AV + kvh * 64 + part * 8); }
        float kf[8] = {bflo(kx.x), bfhi(kx.x), bflo(kx.y), bfhi(kx.y), bflo(kx.z), bfhi(kx.z), bflo(kx.w), bfhi(kx.w)};
        float ss = 0.f;
#pragma unroll
        for (int e = 0; e < 8; ++e) ss += kf[e] * kf[e];
        ss += __shfl_xor(ss, 1); ss += __shfl_xor(ss, 2); ss += __shfl_xor(ss, 4);
        const float rk = rsqrtf(ss * (1.0f / 64.0f) + EPS);
#pragma unroll
        for (int e = 0; e < 8; ++e) kf[e] = kf[e] * rk * gk[part * 8 + e];
        *(LAS v4u*)(lds + AT_K + key * 144 + part * 16) = (v4u){cvt_pk_bf16(kf[0], kf[1]), cvt_pk_bf16(kf[2], kf[3]), cvt_pk_bf16(kf[4], kf[5]), cvt_pk_bf16(kf[6], kf[7])};
        const unsigned xs[4] = {vx.x, vx.y, vx.z, vx.w};
#pragma unroll
        for (int e = 0; e < 8; ++e) { const unsigned wd = xs[e >> 1]; *(LAS bf16*)(lds + AT_VT + (part * 8 + e) * 528 + key * 2) = (bf16)((e & 1) ? (wd >> 16) : (wd & 0xffffu)); }
    }
    __syncthreads();
    const int tile0 = w & ~1;
    const int qi = 16 * w + c;
    for (int hg = 0; hg < 4; ++hg) {
        const int head = kvh * 4 + hg; const float sink = sinks[head];
        bf16* qrow = Z + (rowbase + nb * 128 + qi) * ZW + ZC_AQ + head * 64;
        bf16x8 qf[2];
        { const v4u x0 = *(const v4u*)(qrow + g * 8), x1 = *(const v4u*)(qrow + 32 + g * 8);
          float f[16] = {bflo(x0.x), bfhi(x0.x), bflo(x0.y), bfhi(x0.y), bflo(x0.z), bfhi(x0.z), bflo(x0.w), bfhi(x0.w), bflo(x1.x), bfhi(x1.x), bflo(x1.y), bfhi(x1.y), bflo(x1.z), bfhi(x1.z), bflo(x1.w), bfhi(x1.w)};
          float ss = 0.f;
#pragma unroll
          for (int e = 0; e < 16; ++e) ss += f[e] * f[e];
          ss += __shfl_xor(ss, 16); ss += __shfl_xor(ss, 32);
          const float rq = rsqrtf(ss * (1.0f / 64.0f) + EPS) * 0.125f;
#pragma unroll
          for (int e = 0; e < 8; ++e) { f[e] *= rq * gq[g * 8 + e]; f[8 + e] *= rq * gq[32 + g * 8 + e]; }
          v4u p0 = (v4u){cvt_pk_bf16(f[0], f[1]), cvt_pk_bf16(f[2], f[3]), cvt_pk_bf16(f[4], f[5]), cvt_pk_bf16(f[6], f[7])};
          v4u p1 = (v4u){cvt_pk_bf16(f[8], f[9]), cvt_pk_bf16(f[10], f[11]), cvt_pk_bf16(f[12], f[13]), cvt_pk_bf16(f[14], f[15])};
          qf[0] = __builtin_bit_cast(bf16x8, p0); qf[1] = __builtin_bit_cast(bf16x8, p1); }
        const int odd = w & 1;
        f32x4 sc[10]; float mx = sink;
#pragma unroll
        for (int tt = 0; tt < 10; ++tt) {
            f32x4 a = (f32x4){-1e30f, -1e30f, -1e30f, -1e30f};
            const bool empty = odd ? (tt == 0) : (tt == 9);
            if (!empty) {
                a = (f32x4){0.f, 0.f, 0.f, 0.f};
#pragma unroll
                for (int ks = 0; ks < 2; ++ks) { const bf16x8 kfr = *(const LAS bf16x8*)(lds + AT_K + ((tile0 + tt) * 16 + c) * 144 + ks * 64 + g * 16); a = MFMA16(kfr, qf[ks], a); }
                const bool partial = odd ? (tt == 1 || tt == 9) : (tt == 0 || tt == 8);
                if (partial || nb == 0) {
#pragma unroll
                    for (int r = 0; r < 4; ++r) { const int kj = (tile0 + tt) * 16 + 4 * g + r; const bool valid = (kj >= qi + 1) && (kj <= qi + 128) && (nb > 0 || kj >= 128);
                        a[r] = valid ? a[r] : -1e30f; } }
#pragma unroll
                for (int r = 0; r < 4; ++r) mx = fmaxf(mx, a[r]);
            }
            sc[tt] = a; }
        mx = fmaxf(mx, __shfl_xor(mx, 16)); mx = fmaxf(mx, __shfl_xor(mx, 32));
        float sum = 0.f;
#pragma unroll
        for (int tt = 0; tt < 10; ++tt)
#pragma unroll
            for (int r = 0; r < 4; ++r) { const float p = (sc[tt][r] > -1e29f) ? __expf(sc[tt][r] - mx) : 0.f; sc[tt][r] = p; sum += p; }
        sum += __shfl_xor(sum, 16); sum += __shfl_xor(sum, 32);
        const float inv = 1.0f / (sum + __expf(sink - mx));
        f32x4 oacc[4];
#pragma unroll
        for (int dt = 0; dt < 4; ++dt) oacc[dt] = (f32x4){0.f, 0.f, 0.f, 0.f};
#pragma unroll
        for (int u = 0; u < 5; ++u) {
            v4u pb = (v4u){cvt_pk_bf16(sc[2 * u][0], sc[2 * u][1]), cvt_pk_bf16(sc[2 * u][2], sc[2 * u][3]), cvt_pk_bf16(sc[2 * u + 1][0], sc[2 * u + 1][1]), cvt_pk_bf16(sc[2 * u + 1][2], sc[2 * u + 1][3])};
            const bf16x8 pfr = __builtin_bit_cast(bf16x8, pb);
#pragma unroll
            for (int dt = 0; dt < 4; ++dt) {
                const LAS unsigned char* vp = lds + AT_VT + (dt * 16 + c) * 528 + ((tile0 + 2 * u) * 16 + 4 * g) * 2;
                const v2u lo = *(const LAS v2u*)vp, hi = *(const LAS v2u*)(vp + 32);
                const v4u av = (v4u){lo.x, lo.y, hi.x, hi.y};
                oacc[dt] = MFMA16(__builtin_bit_cast(bf16x8, av), pfr, oacc[dt]); } }
#pragma unroll
        for (int dt = 0; dt < 4; ++dt) { const f32x4 o = oacc[dt] * inv; v2u wv; wv.x = cvt_pk_bf16(o[0], o[1]); wv.y = cvt_pk_bf16(o[2], o[3]);
            *(v2u*)(qrow + dt * 16 + 4 * g) = wv; }
    }
    __syncthreads();
}

__device__ __forceinline__ void phase_fin(KArg P, int L, int vcu, int G) {
    const int tid = opaque_tid(); const int lane = tid & 63, wave = tid >> 6; const int gw = vcu * 8 + wave, NGW = G * 8;
    bf16* Z = (bf16*)(ka_ws(P) + WS_Z); const float* gn = ka_in(P, 12) + L * DM;
    for (int base = gw; base < MROWS * 4; base += 8 * NGW) {
        v2u hv[8], ov[8];
#pragma unroll
        for (int k = 0; k < 8; ++k) { int pair = base + k * NGW; if (pair >= MROWS * 4) pair = gw; const int row = pair >> 2, h = pair & 3;
            hv[k] = *(const v2u*)(Z + (size_t)row * ZW + ZC_V + h * 256 + lane * 4); ov[k] = *(const v2u*)(Z + (size_t)row * ZW + ZC_O + h * 256 + lane * 4); }
#pragma unroll
        for (int k = 0; k < 8; ++k) { const int pair = base + k * NGW; if (pair >= MROWS * 4) continue; const int row = pair >> 2, h = pair & 3;
            const f32x4 gv = *(const f32x4*)(gn + h * 256 + lane * 4);
            const float x0 = bflo(hv[k].x), x1 = bfhi(hv[k].x), x2 = bflo(hv[k].y), x3 = bfhi(hv[k].y);
            const float ss = wave_sum_dpp((x0 * x0 + x1 * x1) + (x2 * x2 + x3 * x3));
            const float r = rsqrtf(ss * (1.0f / 256.0f) + EPS);
            v2u o; o.x = cvt_pk_bf16(bflo(ov[k].x) * x0 * r * gv[0], bfhi(ov[k].x) * x1 * r * gv[1]); o.y = cvt_pk_bf16(bflo(ov[k].y) * x2 * r * gv[2], bfhi(ov[k].y) * x3 * r * gv[3]);
            *(v2u*)(Z + (size_t)row * ZW + ZC_V + h * 256 + lane * 4) = o; } }
}


#define XB_TMO      128
#define XB_XCNT(j)  (256  + 64 * (j))
#define XB_XSUB(j)  (1280 + 64 * (j))
#define XB_XGEN(j)  (2304 + 64 * (j))
#define XB_TOP      3328
#define XB_TOPGEN   3392
#define XCD_BAR_WORDS 3456
#define XB_SPIN_CAP (1u << 24)
constexpr size_t WS_BAR = 60 * MiB;
constexpr int LDS_XB = 147400;
__device__ __forceinline__ unsigned xb_ld(unsigned* p)              { return __hip_atomic_load(p, __ATOMIC_RELAXED, __HIP_MEMORY_SCOPE_AGENT); }
__device__ __forceinline__ unsigned xb_add(unsigned* p, unsigned v) { return __hip_atomic_fetch_add(p, v, __ATOMIC_RELAXED, __HIP_MEMORY_SCOPE_AGENT); }
__device__ __forceinline__ unsigned xb_xcc_id() { return (unsigned)__builtin_amdgcn_s_getreg((3 << 11) | 20) & 0xFu; }
#define XB_SPIN(cond, bar) do { unsigned _sp = 0; while (cond) { __builtin_amdgcn_s_sleep(1); \
    if ((++_sp & 255u) == 0u) { if (xb_ld(&(bar)[XB_TMO])) break; if (_sp > XB_SPIN_CAP) { atomicAdd(&(bar)[XB_TMO], 1u); break; } } } } while (0)
__device__ __forceinline__ void xcd_barrier_complete(unsigned* bar, unsigned x, unsigned& nloc, unsigned& nx) {
    const unsigned G = gridDim.x * gridDim.y * gridDim.z;
    unsigned sum, cnt, mine, sp = 0u;
    for (;;) {
        sum = 0u; cnt = 0u; mine = 0u;
#pragma unroll
        for (unsigned j = 0; j < 16; ++j) { const unsigned c = xb_ld(&bar[XB_XCNT(j)]); sum += c; cnt += (c > 0u) ? 1u : 0u; mine = (j == x) ? c : mine; }
        if (sum == G) break;
        __builtin_amdgcn_s_sleep(1);
        if ((++sp & 255u) == 0u) { if (xb_ld(&bar[XB_TMO])) break; if (sp > XB_SPIN_CAP) { atomicAdd(&bar[XB_TMO], 1u); break; } }
    }
    nloc = mine > 0u ? mine : 1u; nx = cnt > 0u ? cnt : 1u;
}
__device__ __forceinline__ void xcd_barrier(unsigned* bar, volatile LAS unsigned* st) {
    asm volatile("s_waitcnt vmcnt(0)" ::: "memory");
    __syncthreads();
    if (threadIdx.x == 0) {
        const unsigned x = xb_xcc_id();
        __builtin_amdgcn_s_waitcnt(0);
        unsigned nloc = st[0], nx = st[1];
        if (nloc == 0u) { xcd_barrier_complete(bar, x, nloc, nx); st[0] = nloc; st[1] = nx; }
        const unsigned old = xb_add(&bar[XB_XSUB(x)], 1u);
        const unsigned gen = old / nloc;
        if (old + 1u == (gen + 1u) * nloc) {
            __builtin_amdgcn_fence(__ATOMIC_RELEASE, "agent");
            asm volatile("s_waitcnt vmcnt(0)" ::: "memory");
            const unsigned og = xb_add(&bar[XB_TOP], 1u);
            const unsigned tg = og / nx;
            if (og + 1u == (tg + 1u) * nx) xb_add(&bar[XB_TOPGEN], 1u);
            else XB_SPIN(xb_ld(&bar[XB_TOPGEN]) == tg, bar);
            __builtin_amdgcn_fence(__ATOMIC_ACQUIRE, "agent");
            xb_add(&bar[XB_XGEN(x)], 1u);
            asm volatile("s_waitcnt vmcnt(0)" ::: "memory");
        } else {
            XB_SPIN(xb_ld(&bar[XB_XGEN(x)]) == gen, bar);
            __builtin_amdgcn_fence(__ATOMIC_ACQUIRE, "agent");
            asm volatile("s_waitcnt vmcnt(0)" ::: "memory");
        }
    }
    __syncthreads();
}

constexpr int PH_PER_LAYER = 12;
#define PH_STOP 24
__global__ void __launch_bounds__(512, 2) hybrid_fwd(Params Pk) {
    LAS unsigned char* lds = (LAS unsigned char*)g_lds;
    cg::grid_group grid = cg::this_grid();
    if (threadIdx.x < 2) ((LAS unsigned*)(lds + LDS_XB))[threadIdx.x] = 0u;
    { const KArg P0 = ka_get(); unsigned* bar0 = (unsigned*)(ka_ws(P0) + WS_BAR); if (threadIdx.x == 0) (void)xb_add(&bar0[XB_XCNT(xb_xcc_id())], 1u); }
    __syncthreads();
    bool first = true;
    const int ph_lo = Pk.ph_lo, ph_hi = Pk.ph_hi;
    for (int ph = ph_lo; ph < ph_hi; ++ph) {
        if (!first) {
            if (ph_lo < 0) {
                asm volatile("s_waitcnt vmcnt(0) lgkmcnt(0)" ::: "memory"); grid.sync(); __builtin_amdgcn_fence(__ATOMIC_ACQUIRE, "agent"); asm volatile("s_waitcnt vmcnt(0)" ::: "memory");
            } else { const KArg Pb = ka_get(); xcd_barrier((unsigned*)(ka_ws(Pb) + WS_BAR), (volatile LAS unsigned*)(lds + LDS_XB)); }
        }
        first = false;
        const KArg P = ka_get();
        unsigned char* ws = ka_ws(P); float* out = ka_out(P); int G = gridDim.x, bx = blockIdx.x;
        asm volatile("" : "+s"(G), "+s"(bx));
        const int vcu = (G % 8 == 0) ? (bx % 8) * (G / 8) + bx / 8 : bx;
        bf16* Z = (bf16*)(ws + WS_Z); bf16* HB = (bf16*)(ws + WS_HB); bf16* HB2 = (bf16*)(ws + WS_HB2); bf16* HID = (bf16*)(ws + WS_HID); bf16* PPb = (bf16*)(ws + WS_PP); bf16* T = (bf16*)out;
        const int L = ph / PH_PER_LAYER, q = ph % PH_PER_LAYER;
        float* RSA = (float*)(ws + WS_RSA); float* RSB = (float*)(ws + WS_RSB);
        pg8::StaticOrder S;
        switch (q) {
                case 0: phase_convert(P, L, lds, vcu, G); break;
        case 1: { pg8::Gemm gm{HB2, (const bf16*)(ws + WS_WGU1), MROWS, 5632, DM, DM, DM}; S.init(MROWS, 5632, G, bx);
                  EpiSwiglu E{HID, RSA}; pg8::gemm_phase<EpiSwiglu, true>(lds, gm, S, E); } break;
        case 2: { pg8::Gemm gm{HID, (const bf16*)(ws + WS_WD1), MROWS, DM, DFFP, DFFP, DFFP}; S.init(MROWS, DM, G, bx);
                  EpiRes<0> E{L == 0 ? ka_in(P, 0) : nullptr, nullptr, HB, RSB, 0.5f, nullptr, nullptr, L == 0 ? nullptr : HB2}; pg8::gemm_phase<EpiRes<0>, true>(lds, gm, S, E); } break;
        case 3: { pg8::Gemm gm{HB, (const bf16*)(ws + WS_WIN), MROWS, 5888, DM, DM, DM}; S.init(MROWS, 5888, G, bx);
                  EpiBf<4> E{Z, ZW, nullptr, 0, nullptr, 0, RSB, (float*)(ws + WS_GIF), (bf16*)(ws + WS_HALO)}; pg8::gemm_phase<EpiBf<4>, true>(lds, gm, S, E); } break;
        case 4: {
            conv_pass(P, L, vcu, G);
            for (int u = vcu; u < 1024; u += G) attn_unit(P, L, u >> 7, (u >> 2) & 31, u & 3, lds);
        } break;
        case 5: {
            for (int u = bx; u < 256; u += G) { const int bh = (u >> 6) * 8 + (u & 7), vs = (u >> 3) & 7; mlstm_unit(P, L, bh >> 2, bh & 3, vs, lds); }
        } break;
        case 6: { phase_fin(P, L, vcu, G);
                  pg8::Gemm gm{HB, (const bf16*)(ws + WS_WIN) + (size_t)5888 * DM, MROWS, 2048, DM, DM, DM}; S.init(MROWS, 2048, G, bx);
                  EpiBf<1> E{Z, ZW, nullptr, 0, nullptr, 0, RSB, nullptr, nullptr}; pg8::gemm_phase<EpiBf<1>, true>(lds, gm, S, E); } break;
        case 7: {
                  { pg8::Gemm gm{Z + ZC_V, (const bf16*)(ws + WS_WA), MROWS, DM, DM, ZW, DM}; S.init(MROWS, DM, G, bx);
                    EpiBf<2> E{T, DM, Z, ZW, nullptr, 0, nullptr, nullptr, nullptr}; pg8::gemm_phase<EpiBf<2>, true>(lds, gm, S, E); }
                  { pg8::Gemm gm{Z + ZC_AQ, (const bf16*)(ws + WS_WB), MROWS, DM, DM, ZW, DM}; S.init(MROWS, DM, G, bx);
                    EpiBf<3> E{Z, ZW, T, DM, Z + 1024, ZW, nullptr, nullptr, nullptr}; pg8::gemm_phase<EpiBf<3>, true>(lds, gm, S, E); } } break;
        case 8: { pg8::Gemm gm{Z, (const bf16*)(ws + WS_WOUT), MROWS, DM, DM, ZW, DM}; S.init(MROWS, DM, G, bx);
                  EpiRes<0> E{nullptr, nullptr, HB, RSA, 1.0f, nullptr, nullptr, HB}; pg8::gemm_phase<EpiRes<0>, true>(lds, gm, S, E); } break;
        case 9: { pg8::Gemm gm{HB, (const bf16*)(ws + WS_WGU2), MROWS, 5632, DM, DM, DM}; S.init(MROWS, 5632, G, bx);
                  EpiSwiglu E{HID, RSA}; pg8::gemm_phase<EpiSwiglu, true>(lds, gm, S, E); } break;
        case 10: { { pg8::Gemm gm{HID, (const bf16*)(ws + WS_WD2), MROWS, DM, DFFP, DFFP, DFFP}; S.init(MROWS, DM, G, bx);
                     EpiRes<0> E{nullptr, nullptr, HB, RSB, 0.5f, nullptr, nullptr, HB}; pg8::gemm_phase<EpiRes<0>, true>(lds, gm, S, E); }
                   { pg8::Gemm gm{(const bf16*)(ws + WS_PBF), (const bf16*)(ws + WS_WP), MROWS, DM, PLE, PLE, PLE}; S.init(MROWS, DM, G, bx);
                     EpiBf<0> E{PPb, DM, nullptr, 0, nullptr, 0, nullptr, nullptr}; pg8::gemm_phase<EpiBf<0>, true>(lds, gm, S, E); } } break;
        case 11: { pg8::Gemm gm{HB, (const bf16*)(ws + WS_WPG), MROWS, DM, DM, DM, DM}; S.init(MROWS, DM, G, bx);
                   EpiRes<1> E{nullptr, L == 1 ? out : nullptr, L == 1 ? nullptr : HB2, RSA, 1.0f, RSB, PPb, HB}; pg8::gemm_phase<EpiRes<1>, true>(lds, gm, S, E); } break;
        }
    }
}

extern "C" void kernel_launch(void* const* d_in, const int* in_sizes, int n_in, void* d_out, int out_size, void* d_ws, size_t ws_size, hipStream_t stream) {
    static int grid = 0;
    if (grid == 0) {
        if (n_in != 26 || out_size != MROWS * DM || ws_size < WS_END) { fprintf(stderr, "kernel_launch: unexpected problem (n_in %d out %d ws %zu)\n", n_in, out_size, ws_size); grid = -1; return; }
        int dev = 0, cus = 0, per_cu = 0;
        hipGetDevice(&dev); hipDeviceGetAttribute(&cus, hipDeviceAttributeMultiprocessorCount, dev);
        hipFuncSetAttribute((const void*)hybrid_fwd, hipFuncAttributeMaxDynamicSharedMemorySize, LDS_BYTES);
        hipOccupancyMaxActiveBlocksPerMultiprocessor(&per_cu, (const void*)hybrid_fwd, 512, LDS_BYTES);
        if (per_cu < 1) { fprintf(stderr, "kernel_launch: occupancy query says %d blocks/CU\n", per_cu); per_cu = 1; }
        (void)hipGetLastError();
        grid = cus;
    }
    if (grid < 0) return;
    if (hipMemsetAsync((char*)d_ws + WS_BAR, 0, 16384, stream) != hipSuccess) { fprintf(stderr, "kernel_launch: memset of barrier words failed\n"); return; }
    Params p{};
    for (int i = 0; i < 26; ++i) p.in[i] = (const float*)d_in[i];
    p.out = (float*)d_out; p.ws = (unsigned char*)d_ws; p.ph_lo = 0; p.ph_hi = PH_STOP;
    void* args[] = {&p};
    hipError_t e = hipLaunchCooperativeKernel((const void*)hybrid_fwd, dim3(grid), dim3(512), args, LDS_BYTES, stream);
    if (e != hipSuccess) fprintf(stderr, "cooperative launch failed: %s (grid %d)\n", hipGetErrorString(e), grid);
}
```

```cpp
#include <hip/hip_runtime.h>
#include <hip/hip_cooperative_groups.h>
#include <cstdio>
#include <cstdint>
namespace cg = cooperative_groups;

#define LAS __attribute__((address_space(3)))
typedef unsigned short bf16;
typedef unsigned v4u __attribute__((ext_vector_type(4)));
typedef unsigned v2u __attribute__((ext_vector_type(2)));
typedef float f32x4 __attribute__((ext_vector_type(4)));
typedef short bf16x8 __attribute__((ext_vector_type(8)));
typedef short s16x4 __attribute__((ext_vector_type(4)));

constexpr int MROWS = 32768, DM = 1024, SEQ = 4096, NB = 8, DFF = 2752, DFFP = 2816, NIN = 7688, PLE = 256;
constexpr int ZW = 5632;
constexpr int ZC_V = 2048, ZC_O = 3072, ZC_AQ = 4096, ZC_AK = 5120, ZC_AV = 5376;
constexpr int NWIN = 7936;
constexpr float EPS = 1e-6f;
constexpr size_t MiB = 1u << 20;
constexpr size_t WS_WGU1 = 0, WS_WD1 = 11 * MiB, WS_WIN = 16 * MiB + 512 * 1024, WS_WA = 32 * MiB, WS_WB = 34 * MiB, WS_WOUT = 36 * MiB, WS_WPG = 38 * MiB,
                 WS_WP = 40 * MiB, WS_WGU2 = 40 * MiB + 512 * 1024, WS_WD2 = 51 * MiB + 512 * 1024;
constexpr size_t WS_ROWSS = 57 * MiB;
constexpr size_t WS_GIF = 59 * MiB;
constexpr size_t WS_Z = 62 * MiB;
constexpr size_t WS_HID = WS_Z, WS_PP = WS_Z + 178 * MiB, WS_HB2 = WS_Z + 242 * MiB;
constexpr size_t WS_HB = 414 * MiB;
constexpr size_t WS_PBF = 478 * MiB;
constexpr size_t WS_HALO = 494 * MiB;
constexpr size_t WS_RSA = 500 * MiB, WS_RSB = 502 * MiB;
constexpr size_t WS_END = 504 * MiB;
constexpr int LDS_BYTES = 147456;

typedef float f32x2_t __attribute__((ext_vector_type(2)));
typedef __bf16 bf16x2_t __attribute__((ext_vector_type(2)));
__device__ __forceinline__ unsigned cvt_pk_bf16(float lo, float hi) { f32x2_t v = {lo, hi}; bf16x2_t b = __builtin_convertvector(v, bf16x2_t); return __builtin_bit_cast(unsigned, b); }
__device__ __forceinline__ float bflo(unsigned w) { return __uint_as_float(w << 16); }
__device__ __forceinline__ float bfhi(unsigned w) { return __uint_as_float(w & 0xffff0000u); }
__device__ __forceinline__ float sigm(float x) { return __builtin_amdgcn_rcpf(1.0f + __expf(-x)); }
__device__ __forceinline__ float wave_sum(float v) {
#pragma unroll
    for (int o = 1; o < 64; o <<= 1) v += __shfl_xor(v, o);
    return v;
}
template <int CTRL, int ROWMASK> __device__ __forceinline__ float dppf(float old, float v) { return __int_as_float(__builtin_amdgcn_update_dpp(__float_as_int(old), __float_as_int(v), CTRL, ROWMASK, 0xf, false)); }
__device__ __forceinline__ float wave_scan_add(float v) {
    v += dppf<0x111, 0xf>(0.f, v); v += dppf<0x112, 0xf>(0.f, v); v += dppf<0x114, 0xf>(0.f, v); v += dppf<0x118, 0xf>(0.f, v);
    v += dppf<0x142, 0xa>(0.f, v); v += dppf<0x143, 0xc>(0.f, v); return v; }
__device__ __forceinline__ float wave_scan_max(float v) {
    const float I = -3.0e38f;
    v = fmaxf(v, dppf<0x111, 0xf>(I, v)); v = fmaxf(v, dppf<0x112, 0xf>(I, v)); v = fmaxf(v, dppf<0x114, 0xf>(I, v)); v = fmaxf(v, dppf<0x118, 0xf>(I, v));
    v = fmaxf(v, dppf<0x142, 0xa>(I, v)); v = fmaxf(v, dppf<0x143, 0xc>(I, v)); return v; }
__device__ __forceinline__ float wave_sum_dpp(float v) { return __int_as_float(__builtin_amdgcn_readlane(__float_as_int(wave_scan_add(v)), 63)); }
#define LDS_WAIT() asm volatile("s_waitcnt lgkmcnt(0)" ::: "memory")
__device__ __forceinline__ int opaque_tid() { int t = threadIdx.x; asm volatile("" : "+v"(t)); return t; }

extern __shared__ __attribute__((aligned(16))) unsigned char g_lds[];
namespace pg8 {
constexpr int BM = 256, BK = 64, HALF = 128, HTB = HALF * BK * 2, STAGE_BYTES = 8 * HTB, NXCD = 8, WGM = 8;
constexpr int RSL_OFF = STAGE_BYTES;
__host__ __device__ __forceinline__ int lds_byte(int r, int c) { const int st = (r >> 4) * 2 + (c >> 5), rr = r & 15, cc = c & 31, ob = rr * 64 + cc * 2; return st * 1024 + (ob ^ (((ob >> 9) & 1) << 5)); }
__host__ __device__ __forceinline__ void stage_rc(int b, int& R, int& C) { const int st = b / 1024, sb = b % 1024, swz = sb ^ (((sb >> 9) & 1) << 5); R = (st >> 1) * 16 + swz / 64; C = (st & 1) * 32 + (swz % 64) / 2; }
__host__ __device__ __forceinline__ int perm32(int rho) { const int n = rho >> 4, i = rho & 15; return 8 * (i >> 2) + 4 * n + (i & 3); }
struct Unit { int pm, pn; };
struct Gemm { const bf16* A; const bf16* Bt; int M, N, K, lda, ldb; };
struct StaticOrder {
    int nM, nN, nwg, G, c;
    __device__ void init(int M, int N, int G_, int c_) { nM = M / BM; nN = N / BM; nwg = nM * nN; G = G_; c = c_; }
    __device__ bool next(int i, Unit& u) const {
        const int L = i * G + c; if (L >= nwg) return false;
        int wgid = L; { const int q = nwg / NXCD, r = nwg % NXCD, xcd = wgid % NXCD, off = wgid / NXCD; wgid = (xcd < r ? xcd * (q + 1) : r * (q + 1) + (xcd - r) * q) + off; }
        const int nig = WGM * nN, gid = wgid / nig, fm = gid * WGM, gsz = (nM - fm) < WGM ? (nM - fm) : WGM;
        u.pm = fm + ((wgid % nig) % gsz); u.pn = (wgid % nig) / gsz; return true;
    }
};
template <class Epi, bool ALIGN_EPI>
__device__ __forceinline__ void gemm_phase(LAS unsigned char* lds, const Gemm g, const StaticOrder& S, const Epi& E) {
    int tid_ = threadIdx.x; asm volatile("" : "+v"(tid_));
    const int tid = tid_, wid = __builtin_amdgcn_readfirstlane(tid >> 6), lane = tid & 63, wr = wid >> 2, wc = wid & 3, fr = lane & 15, fq = lane >> 4;
    const int K = g.K, nt = K / BK;
    unsigned voffA[2], voffB[2];
#pragma unroll
    for (int i = 0; i < 2; ++i) { int R, C; stage_rc(tid * 16 + i * 8192, R, C); const int Rb = Epi::PERM ? ((R & ~31) + perm32(R & 31)) : R;
        voffA[i] = (unsigned)(R * g.lda + C) * 2u; voffB[i] = (unsigned)(Rb * g.ldb + C) * 2u; }
    const size_t kstep = (size_t)(BK * 2);
    const size_t hstepA = (size_t)HALF * g.lda * 2, hstepB = (size_t)HALF * g.ldb * 2;
    const size_t tstepA = 2 * hstepA, tstepB = 2 * hstepB;
    const unsigned ldsw = (unsigned)wid * 1024u;
    const int aoff = lds_byte(wr * 64 + fr, fq * 8), boff = lds_byte(wc * 32 + fr, fq * 8);
#define PG8_SA(b, h) (((b) * 2 + (h)) * HTB)
#define PG8_SB(b, h) ((4 + (b) * 2 + (h)) * HTB)
#define PG8_STAGE(bufoff, gbase, voff) do { _Pragma("unroll") for (int _i = 0; _i < 2; ++_i) \
        __builtin_amdgcn_global_load_lds((const unsigned*)((const char*)(gbase) + (voff)[_i]), (LAS unsigned*)(lds + (bufoff) + ldsw + _i * 8192), 16, 0, 0); } while (0)
#define PG8_LDA(dst, b, h) do { _Pragma("unroll") for (int m = 0; m < 4; ++m) _Pragma("unroll") for (int k = 0; k < 2; ++k) dst[m][k] = *(const LAS bf16x8*)(lds + PG8_SA(b, h) + aoff + m * 2048 + k * 1024); } while (0)
#define PG8_LDB(dst, b, h) do { _Pragma("unroll") for (int n = 0; n < 2; ++n) _Pragma("unroll") for (int k = 0; k < 2; ++k) dst[n][k] = *(const LAS bf16x8*)(lds + PG8_SB(b, h) + boff + n * 2048 + k * 1024); } while (0)
#define PG8_MMA(ai, bj, At, Bt) do { __builtin_amdgcn_s_setprio(1); _Pragma("unroll") for (int m = 0; m < 4; ++m) _Pragma("unroll") for (int n = 0; n < 2; ++n) _Pragma("unroll") for (int k = 0; k < 2; ++k) \
        acc[ai][bj][m][n] = __builtin_amdgcn_mfma_f32_16x16x32_bf16(Bt[n][k], At[m][k], acc[ai][bj][m][n], 0, 0, 0); __builtin_amdgcn_s_setprio(0); } while (0)
#define PG8_WAIT_V(n) asm volatile("s_waitcnt vmcnt(" #n ")" ::: "memory")
#define PG8_WAIT_L(n) asm volatile("s_waitcnt lgkmcnt(" #n ")" ::: "memory")
#define PG8_BAR __builtin_amdgcn_s_barrier()
#define PG8_SCHED __builtin_amdgcn_sched_barrier(0)
    Unit cur, nxt; int ui = 0; int cpm = -1;
    if (!S.next(0, cur)) return;
    f32x4 acc[2][2][4][2];
#pragma unroll
    for (int a = 0; a < 2; ++a)
#pragma unroll
        for (int b = 0; b < 2; ++b)
#pragma unroll
            for (int m = 0; m < 4; ++m)
#pragma unroll
                for (int n = 0; n < 2; ++n) acc[a][b][m][n] = (f32x4){0.f, 0.f, 0.f, 0.f};
    bf16x8 At[4][2], B0[2][2], B1[2][2];
    const char* cA = (const char*)g.A + (size_t)cur.pm * tstepA; const char* cB = (const char*)g.Bt + (size_t)cur.pn * tstepB;
    PG8_STAGE(PG8_SB(0, 0), cB, voffB); PG8_STAGE(PG8_SB(0, 1), cB + hstepB, voffB); PG8_STAGE(PG8_SA(0, 0), cA, voffA); PG8_STAGE(PG8_SA(0, 1), cA + hstepA, voffA);
    if (wr == 1) PG8_BAR;
    PG8_WAIT_V(2); PG8_BAR;
    PG8_STAGE(PG8_SB(1, 0), cB + kstep, voffB); PG8_STAGE(PG8_SA(1, 0), cA + kstep, voffA); PG8_STAGE(PG8_SB(1, 1), cB + hstepB + kstep, voffB);
    PG8_WAIT_V(6); PG8_BAR;
    for (;;) {
        const bool has_next = S.next(ui + 1, nxt);
        const char* nA = has_next ? (const char*)g.A + (size_t)nxt.pm * tstepA : cA; const char* nB = has_next ? (const char*)g.Bt + (size_t)nxt.pn * tstepB : cB;
        for (int t = 0; t < nt; t += 2) {
            const bool last = (t == nt - 2);
            const char* a1 = cA + (size_t)(t + 1) * kstep;
            const char* a2 = last ? nA : cA + (size_t)(t + 2) * kstep; const char* b2 = last ? nB : cB + (size_t)(t + 2) * kstep;
            const char* a3 = a2 + kstep; const char* b3 = b2 + kstep;
            PG8_LDB(B0, 0, 0); PG8_LDB(B1, 0, 1); PG8_SCHED; PG8_LDA(At, 0, 0); PG8_STAGE(PG8_SA(1, 1), a1 + hstepA, voffA);
            PG8_WAIT_V(8); PG8_WAIT_L(0); PG8_BAR; PG8_MMA(0, 0, At, B0); PG8_MMA(0, 1, At, B1); PG8_BAR; PG8_SCHED;
            PG8_LDA(At, 0, 1); PG8_STAGE(PG8_SB(0, 0), b2, voffB); PG8_STAGE(PG8_SB(0, 1), b2 + hstepB, voffB); PG8_STAGE(PG8_SA(0, 0), a2, voffA);
            PG8_WAIT_V(8); PG8_WAIT_L(0); PG8_BAR; PG8_MMA(1, 0, At, B0); PG8_MMA(1, 1, At, B1); PG8_BAR; PG8_SCHED;
            PG8_LDB(B0, 1, 0); PG8_LDB(B1, 1, 1); PG8_SCHED; PG8_LDA(At, 1, 0); PG8_STAGE(PG8_SA(0, 1), a2 + hstepA, voffA);
            PG8_WAIT_V(8); PG8_WAIT_L(0); PG8_BAR; PG8_MMA(0, 0, At, B0); PG8_MMA(0, 1, At, B1); PG8_BAR; PG8_SCHED;
            PG8_LDA(At, 1, 1); PG8_STAGE(PG8_SB(1, 0), b3, voffB); PG8_STAGE(PG8_SB(1, 1), b3 + hstepB, voffB); PG8_STAGE(PG8_SA(1, 0), a3, voffA);
            PG8_WAIT_V(8); PG8_WAIT_L(0); PG8_BAR; PG8_MMA(1, 0, At, B0); PG8_MMA(1, 1, At, B1); PG8_BAR; PG8_SCHED;
        }
        if constexpr (ALIGN_EPI) { if (wr == 0) PG8_BAR; }
        if constexpr (Epi::USES_RS) {
            if (cur.pm != cpm) { cpm = cur.pm; const float* rp = E.rs_src();
#pragma unroll
                for (int j = 0; j < 2; ++j) { const int q = lane + 64 * j; const int row = cur.pm * 256 + (q >> 6) * 128 + wr * 64 + (q & 63);
                    const f32x4* p4 = (const f32x4*)(rp + (size_t)row * 16); const f32x4 t4 = (p4[0] + p4[1]) + (p4[2] + p4[3]);
                    ((LAS float*)(lds + RSL_OFF))[wid * 128 + q] = rsqrtf(((t4[0] + t4[1]) + (t4[2] + t4[3])) * (1.0f / 1024.0f) + 1e-6f); } }
        }
        E(acc, cur, wr, wc, fr, fq);
        if (!has_next) break;
#pragma unroll
        for (int a = 0; a < 2; ++a)
#pragma unroll
            for (int b = 0; b < 2; ++b)
#pragma unroll
                for (int m = 0; m < 4; ++m)
#pragma unroll
                    for (int n = 0; n < 2; ++n) acc[a][b][m][n] = (f32x4){0.f, 0.f, 0.f, 0.f};
        cur = nxt; cA = nA; cB = nB; ++ui;
        if constexpr (ALIGN_EPI) { if (wr == 1) PG8_BAR; }
    }
    PG8_WAIT_V(0);
    if constexpr (!ALIGN_EPI) { if (wr == 0) PG8_BAR; }
    PG8_BAR;
#undef PG8_SA
#undef PG8_SB
#undef PG8_STAGE
#undef PG8_LDA
#undef PG8_LDB
#undef PG8_MMA
#undef PG8_WAIT_V
#undef PG8_WAIT_L
#undef PG8_BAR
#undef PG8_SCHED
}
}

typedef const f32x4 (&AccRef)[2][2][4][2];
struct EpiSwiglu {
    static constexpr bool PERM = true, USES_RS = true;
    __device__ __forceinline__ const float* rs_src() const { return rowss; }
    bf16* O; const float* rowss;
    __device__ __forceinline__ void operator()(AccRef acc, const pg8::Unit& u, int, int, int, int) const {
        const int tid = opaque_tid(), wid = __builtin_amdgcn_readfirstlane(tid >> 6), wr = wid >> 2, wc = wid & 3, fr = tid & 15, fq = (tid & 63) >> 4;
        const int row0 = u.pm * 256 + wr * 64 + fr, col0 = u.pn * 128 + wc * 32 + 8 * fq;
#pragma unroll
        for (int ai = 0; ai < 2; ++ai)
#pragma unroll
            for (int m = 0; m < 4; ++m) {
                const int row = row0 + ai * 128 + m * 16; const float rs = ((const LAS float*)((LAS unsigned char*)g_lds + pg8::RSL_OFF))[wid * 128 + ai * 64 + m * 16 + fr];
                float o[8];
#pragma unroll
                for (int n = 0; n < 2; ++n)
#pragma unroll
                    for (int j = 0; j < 4; ++j) { const float gv = acc[ai][0][m][n][j] * rs, uv = acc[ai][1][m][n][j] * rs; o[n * 4 + j] = gv * sigm(gv) * uv; }
                v4u w; w.x = cvt_pk_bf16(o[0], o[1]); w.y = cvt_pk_bf16(o[2], o[3]); w.z = cvt_pk_bf16(o[4], o[5]); w.w = cvt_pk_bf16(o[6], o[7]);
                *(v4u*)(O + (size_t)row * DFFP + col0) = w; }
    }
};
template <int MODE> struct EpiRes {
    static constexpr bool PERM = true, USES_RS = (MODE == 1);
    __device__ __forceinline__ const float* rs_src() const { return rowss_in; }
    const float* hin; float* hout; bf16* hb; float* rowss_out; float alpha; const float* rowss_in; const bf16* pp; const bf16* hinb;
    __device__ __forceinline__ void operator()(AccRef acc, const pg8::Unit& u, int, int, int, int) const {
        const int tid = opaque_tid(), wid = __builtin_amdgcn_readfirstlane(tid >> 6), wr = wid >> 2, wc = wid & 3, fr = tid & 15, fq = (tid & 63) >> 4;
        const int row0 = u.pm * 256 + wr * 64 + fr, col0 = u.pn * 256 + wc * 32 + 8 * fq;
#pragma unroll
        for (int ai = 0; ai < 2; ++ai)
#pragma unroll
            for (int m = 0; m < 4; ++m) {
                const int row = row0 + ai * 128 + m * 16; float ss = 0.f; float rs = 1.f;
                if (MODE == 1) rs = ((const LAS float*)((LAS unsigned char*)g_lds + pg8::RSL_OFF))[wid * 128 + ai * 64 + m * 16 + fr];
#pragma unroll
                for (int bj = 0; bj < 2; ++bj) {
                    const size_t off = (size_t)row * DM + col0 + bj * 128;
                    f32x4 h0, h1; const f32x4 a0 = acc[ai][bj][m][0], a1 = acc[ai][bj][m][1];
                    if (hin) { h0 = *(const f32x4*)(hin + off); h1 = *(const f32x4*)(hin + off + 4); }
                    else { const v4u hw = *(const v4u*)(hinb + off); h0 = (f32x4){bflo(hw.x), bfhi(hw.x), bflo(hw.y), bfhi(hw.y)}; h1 = (f32x4){bflo(hw.z), bfhi(hw.z), bflo(hw.w), bfhi(hw.w)}; }
                    if (MODE == 0) { h0 = h0 + a0 * alpha; h1 = h1 + a1 * alpha; }
                    else { const v4u pw = *(const v4u*)(pp + off);
                        h0[0] += sigm(a0[0] * rs) * bflo(pw.x); h0[1] += sigm(a0[1] * rs) * bfhi(pw.x); h0[2] += sigm(a0[2] * rs) * bflo(pw.y); h0[3] += sigm(a0[3] * rs) * bfhi(pw.y);
                        h1[0] += sigm(a1[0] * rs) * bflo(pw.z); h1[1] += sigm(a1[1] * rs) * bfhi(pw.z); h1[2] += sigm(a1[2] * rs) * bflo(pw.w); h1[3] += sigm(a1[3] * rs) * bfhi(pw.w); }
                    if (hout) { *(f32x4*)(hout + off) = h0; *(f32x4*)(hout + off + 4) = h1; }
                    if (hb) { v4u w; w.x = cvt_pk_bf16(h0[0], h0[1]); w.y = cvt_pk_bf16(h0[2], h0[3]); w.z = cvt_pk_bf16(h1[0], h1[1]); w.w = cvt_pk_bf16(h1[2], h1[3]); *(v4u*)(hb + off) = w; }
                    ss += ((h0[0] * h0[0] + h0[1] * h0[1]) + (h0[2] * h0[2] + h0[3] * h0[3])) + ((h1[0] * h1[0] + h1[1] * h1[1]) + (h1[2] * h1[2] + h1[3] * h1[3])); }
                ss += __shfl_xor(ss, 16); ss += __shfl_xor(ss, 32);
                if (fq == 0) rowss_out[(size_t)row * 16 + u.pn * 4 + wc] = ss;
                if (m == 3) asm volatile("" ::: "memory"); }
    }
};
template <int MODE> struct EpiBf {
    static constexpr bool PERM = true, USES_RS = (MODE == 1 || MODE == 4);
    __device__ __forceinline__ const float* rs_src() const { return rowss; }
    bf16* O; int ldo; const bf16* a1; int ld1; const bf16* a2; int ld2; const float* rowss; float* gif; bf16* halo;
    __device__ __forceinline__ void operator()(AccRef acc, const pg8::Unit& u, int, int, int, int) const {
        const int tid = opaque_tid(), wid = __builtin_amdgcn_readfirstlane(tid >> 6), wr = wid >> 2, wc = wid & 3, fr = tid & 15, fq = (tid & 63) >> 4;
        const int row0 = u.pm * 256 + wr * 64 + fr, col0 = u.pn * 256 + wc * 32 + 8 * fq;
        if (MODE == 4 && u.pn == 22) {
            if (wc == 0 && fq == 0) {
#pragma unroll
                for (int ai = 0; ai < 2; ++ai)
#pragma unroll
                    for (int m = 0; m < 4; ++m) { const int row = row0 + ai * 128 + m * 16; const float rs = ((const LAS float*)((LAS unsigned char*)g_lds + pg8::RSL_OFF))[wid * 128 + ai * 64 + m * 16 + fr];
                        *(f32x4*)(gif + (size_t)row * 8) = acc[ai][0][m][0] * rs; *(f32x4*)(gif + (size_t)row * 8 + 4) = acc[ai][0][m][1] * rs; }
            }
            return;
        }
        const bool sg = (MODE == 1) || (MODE == 4 && u.pn >= 12 && u.pn < 16);
#pragma unroll
        for (int ai = 0; ai < 2; ++ai)
#pragma unroll
            for (int m = 0; m < 4; ++m) {
                const int row = row0 + ai * 128 + m * 16; float rs = 1.f;
                if (MODE == 1 || MODE == 4) rs = ((const LAS float*)((LAS unsigned char*)g_lds + pg8::RSL_OFF))[wid * 128 + ai * 64 + m * 16 + fr];
#pragma unroll
                for (int bj = 0; bj < 2; ++bj) {
                    const int col = col0 + bj * 128; float o[8];
#pragma unroll
                    for (int n = 0; n < 2; ++n)
#pragma unroll
                        for (int j = 0; j < 4; ++j) o[n * 4 + j] = acc[ai][bj][m][n][j] * rs;
                    if (sg) {
#pragma unroll
                        for (int j = 0; j < 8; ++j) o[j] = sigm(o[j]); }
                    if (MODE == 2 || MODE == 3) {
                        const v4u x = *(const v4u*)(a1 + (size_t)row * ld1 + col);
                        float xf[8] = {bflo(x.x), bfhi(x.x), bflo(x.y), bfhi(x.y), bflo(x.z), bfhi(x.z), bflo(x.w), bfhi(x.w)};
                        if (MODE == 2) {
#pragma unroll
                            for (int j = 0; j < 8; ++j) o[j] *= xf[j]; }
                        else { const v4u y = *(const v4u*)(a2 + (size_t)row * ld2 + col);
                            float yf[8] = {bflo(y.x), bfhi(y.x), bflo(y.y), bfhi(y.y), bflo(y.z), bfhi(y.z), bflo(y.w), bfhi(y.w)};
#pragma unroll
                            for (int j = 0; j < 8; ++j) o[j] = xf[j] + yf[j] * o[j]; }
                    }
                    v4u w; w.x = cvt_pk_bf16(o[0], o[1]); w.y = cvt_pk_bf16(o[2], o[3]); w.z = cvt_pk_bf16(o[4], o[5]); w.w = cvt_pk_bf16(o[6], o[7]);
                    *(v4u*)(O + (size_t)row * ldo + col) = w;
                    if (MODE == 4 && m == 3) { if (u.pn < 8 && fr >= 13) *(v4u*)(halo + ((size_t)(row >> 6) * 3 + (fr - 13)) * 2048 + col) = w; } }
                if ((MODE == 2 || MODE == 3) && (m & 1)) asm volatile("" ::: "memory"); }
    }
};

struct Params { const float* in[26]; float* out; unsigned char* ws; int ph_lo, ph_hi; };
typedef const __attribute__((address_space(4))) unsigned char* KArg;
__device__ __forceinline__ KArg ka_get() { KArg k = (KArg)__builtin_amdgcn_kernarg_segment_ptr(); asm volatile("" : "+s"(k)); return k; }
__device__ __forceinline__ const float* ka_in(KArg k, int i) { return *(const float* const __attribute__((address_space(4)))*)(k + 8 * i); }
__device__ __forceinline__ float* ka_out(KArg k) { return *(float* const __attribute__((address_space(4)))*)(k + 208); }
__device__ __forceinline__ unsigned char* ka_ws(KArg k) { return *(unsigned char* const __attribute__((address_space(4)))*)(k + 216); }
static_assert(sizeof(Params) == 232, "kernarg layout");

template <int KIND>
__device__ __forceinline__ void tr_item(const float* src, const float* src2, int srcN, int Ksrc, const float* gain, bf16* WT, int Kd, int nblk, int item, LAS float* scr, int lane) {
    const int kb = item / nblk, nb = item % nblk, k0 = 64 * kb, n0 = 64 * nb;
    const int n = n0 + (lane & 15) * 4;
    const float* cp = nullptr;
    if (KIND == 0) cp = src + n;
    if (KIND == 1) { const int hid = (n >> 8) * 128 + (n & 127); if (hid < DFF) cp = (((n >> 7) & 1) ? src2 : src) + hid; }
    if (KIND == 2) { if (n < 4096) cp = src + n; else if (n < 5632) cp = src + n + 8; else if (n < 5888) { if (n - 5632 < 8) cp = src + 4096 + (n - 5632); } else cp = src + 5640 + (n - 5888); }
    f32x4 v[16];
#pragma unroll
    for (int i = 0; i < 16; ++i) { const int k = k0 + 4 * i + (lane >> 4);
        v[i] = (cp != nullptr && k < Ksrc) ? *(const f32x4*)(cp + (size_t)k * srcN) : (f32x4){0.f, 0.f, 0.f, 0.f}; }
#pragma unroll
    for (int i = 0; i < 16; ++i) { LAS float* d = scr + (4 * i + (lane >> 4)) * 65 + (lane & 15) * 4; d[0] = v[i][0]; d[1] = v[i][1]; d[2] = v[i][2]; d[3] = v[i][3]; }
    LDS_WAIT(); asm volatile("" ::: "memory");
    const int c = lane & 7;
    float gk[8];
#pragma unroll
    for (int e = 0; e < 8; ++e) gk[e] = 1.0f;
    if (gain) { const f32x4 a = *(const f32x4*)(gain + k0 + 8 * c), b = *(const f32x4*)(gain + k0 + 8 * c + 4); gk[0] = a[0]; gk[1] = a[1]; gk[2] = a[2]; gk[3] = a[3]; gk[4] = b[0]; gk[5] = b[1]; gk[6] = b[2]; gk[7] = b[3]; }
#pragma unroll
    for (int j = 0; j < 8; ++j) { const int nn = (lane >> 3) + 8 * j; const LAS float* sp = scr + (8 * c) * 65 + nn;
        v4u o; o.x = cvt_pk_bf16(sp[0 * 65] * gk[0], sp[1 * 65] * gk[1]); o.y = cvt_pk_bf16(sp[2 * 65] * gk[2], sp[3 * 65] * gk[3]); o.z = cvt_pk_bf16(sp[4 * 65] * gk[4], sp[5 * 65] * gk[5]); o.w = cvt_pk_bf16(sp[6 * 65] * gk[6], sp[7 * 65] * gk[7]);
        *(v4u*)(WT + (size_t)(n0 + nn) * Kd + k0 + 8 * c) = o; }
    LDS_WAIT(); asm volatile("" ::: "memory");
}

__device__ __forceinline__ void phase_convert(KArg P, int L, LAS unsigned char* lds, int vcu, int G) {
    const int tid = opaque_tid(); const int lane = tid & 63, wave = tid >> 6;
    LAS float* scr = (LAS float*)(lds + wave * 16640);
    const int gw = vcu * 8 + wave, NGW = G * 8;
    unsigned char* ws = ka_ws(P);
    constexpr int I_GU = 16 * 88, I_D = 44 * 16, I_IN = 16 * 124, I_SQ = 16 * 16, I_P = 4 * 16;
    const size_t oGU = (size_t)L * DM * DFF, oSQ = (size_t)L * DM * DM;
    int off = 0;
#define CONV_LOOP(ITEMS, CALL) do { for (int it = (gw - off % NGW + NGW) % NGW; it < (ITEMS); it += NGW) { CALL; } off += (ITEMS); } while (0)
    CONV_LOOP(I_GU, tr_item<1>(ka_in(P, 3) + oGU, ka_in(P, 4) + oGU, DFF, DM, ka_in(P, 2) + L * DM, (bf16*)(ws + WS_WGU1), DM, 88, it, scr, lane));
    CONV_LOOP(I_D,  tr_item<0>(ka_in(P, 5) + oGU, nullptr, DM, DFF, nullptr, (bf16*)(ws + WS_WD1), DFFP, 16, it, scr, lane));
    CONV_LOOP(I_IN, tr_item<2>(ka_in(P, 7) + (size_t)L * DM * NIN, nullptr, NIN, DM, ka_in(P, 6) + L * DM, (bf16*)(ws + WS_WIN), DM, 124, it, scr, lane));
    CONV_LOOP(I_SQ, tr_item<0>(ka_in(P, 16) + oSQ, nullptr, DM, DM, nullptr, (bf16*)(ws + WS_WA), DM, 16, it, scr, lane));
    CONV_LOOP(I_SQ, tr_item<0>(ka_in(P, 17) + oSQ, nullptr, DM, DM, nullptr, (bf16*)(ws + WS_WB), DM, 16, it, scr, lane));
    CONV_LOOP(I_SQ, tr_item<0>(ka_in(P, 18) + oSQ, nullptr, DM, DM, nullptr, (bf16*)(ws + WS_WOUT), DM, 16, it, scr, lane));
    CONV_LOOP(I_GU, tr_item<1>(ka_in(P, 20) + oGU, ka_in(P, 21) + oGU, DFF, DM, ka_in(P, 19) + L * DM, (bf16*)(ws + WS_WGU2), DM, 88, it, scr, lane));
    CONV_LOOP(I_D,  tr_item<0>(ka_in(P, 22) + oGU, nullptr, DM, DFF, nullptr, (bf16*)(ws + WS_WD2), DFFP, 16, it, scr, lane));
    CONV_LOOP(I_SQ, tr_item<0>(ka_in(P, 24) + oSQ, nullptr, DM, DM, ka_in(P, 23) + L * DM, (bf16*)(ws + WS_WPG), DM, 16, it, scr, lane));
    CONV_LOOP(I_P,  tr_item<0>(ka_in(P, 25) + (size_t)L * PLE * DM, nullptr, DM, PLE, nullptr, (bf16*)(ws + WS_WP), PLE, 16, it, scr, lane));
#undef CONV_LOOP
    const float* pl = ka_in(P, 1) + (size_t)L * MROWS * PLE; bf16* pbf = (bf16*)(ws + WS_PBF);
    for (int m0 = gw; m0 < MROWS; m0 += 4 * NGW) { f32x4 v[4];
#pragma unroll
        for (int k = 0; k < 4; ++k) { const int m = (m0 + k * NGW < MROWS) ? m0 + k * NGW : m0; v[k] = *(const f32x4*)(pl + (size_t)m * PLE + lane * 4); }
#pragma unroll
        for (int k = 0; k < 4; ++k) { const int m = m0 + k * NGW; if (m < MROWS) { v2u w; w.x = cvt_pk_bf16(v[k][0], v[k][1]); w.y = cvt_pk_bf16(v[k][2], v[k][3]); *(v2u*)(pbf + (size_t)m * PLE + lane * 4) = w; } } }
    if (L == 0) {
        float* rowss = (float*)(ws + WS_RSA); bf16* hb2 = (bf16*)(ws + WS_HB2); const float* x = ka_in(P, 0);
        for (int m0 = gw; m0 < MROWS; m0 += 2 * NGW) { f32x4 v[2][4];
#pragma unroll
            for (int k = 0; k < 2; ++k) { const int m = (m0 + k * NGW < MROWS) ? m0 + k * NGW : m0;
#pragma unroll
                for (int j = 0; j < 4; ++j) v[k][j] = *(const f32x4*)(x + (size_t)m * DM + j * 256 + lane * 4); }
#pragma unroll
            for (int k = 0; k < 2; ++k) { const int m = m0 + k * NGW; if (m >= MROWS) continue; float ss = 0.f;
#pragma unroll
                for (int j = 0; j < 4; ++j) { const f32x4 t = v[k][j];
                    v2u w; w.x = cvt_pk_bf16(t[0], t[1]); w.y = cvt_pk_bf16(t[2], t[3]); *(v2u*)(hb2 + (size_t)m * DM + j * 256 + lane * 4) = w;
                    ss += (t[0] * t[0] + t[1] * t[1]) + (t[2] * t[2] + t[3] * t[3]); }
                ss = wave_sum_dpp(ss); if (lane < 16) rowss[(size_t)m * 16 + lane] = (lane == 0) ? ss : 0.f; } }
    }
}

__device__ __forceinline__ void conv_pass(KArg P, int L, int vcu, int G) {
    const int tid = opaque_tid();
    bf16* Z = (bf16*)(ka_ws(P) + WS_Z); const bf16* halo = (const bf16*)(ka_ws(P) + WS_HALO);
    const float* cwp = ka_in(P, 8) + (size_t)L * 4 * 2048; const float* cbp = ka_in(P, 9) + (size_t)L * 2048;
    for (int rg = vcu * 2 + (tid >> 8); rg < 512; rg += 2 * G) {
        const int col = (tid & 255) * 8;
        float cw[4][8], cb[8];
#pragma unroll
        for (int j = 0; j < 4; ++j) { const f32x4 a = *(const f32x4*)(cwp + j * 2048 + col), b = *(const f32x4*)(cwp + j * 2048 + col + 4);
            cw[j][0] = a[0]; cw[j][1] = a[1]; cw[j][2] = a[2]; cw[j][3] = a[3]; cw[j][4] = b[0]; cw[j][5] = b[1]; cw[j][6] = b[2]; cw[j][7] = b[3]; }
        { const f32x4 a = *(const f32x4*)(cbp + col), b = *(const f32x4*)(cbp + col + 4); cb[0] = a[0]; cb[1] = a[1]; cb[2] = a[2]; cb[3] = a[3]; cb[4] = b[0]; cb[5] = b[1]; cb[6] = b[2]; cb[7] = b[3]; }
        v4u w0 = (v4u){0u, 0u, 0u, 0u}, w1 = w0, w2 = w0;
        if ((rg & 63) != 0) { const bf16* hp = halo + (size_t)(rg - 1) * 3 * 2048 + col; w0 = *(const v4u*)hp; w1 = *(const v4u*)(hp + 2048); w2 = *(const v4u*)(hp + 4096); }
        const float sc = (col < 1024) ? 0.0625f : 1.0f;
        bf16* zp = Z + (size_t)rg * 64 * ZW + col;
        for (int i0 = 0; i0 < 64; i0 += 8) {
            v4u x[8];
#pragma unroll
            for (int r = 0; r < 8; ++r) x[r] = *(const v4u*)(zp + (size_t)(i0 + r) * ZW);
#pragma unroll
            for (int r = 0; r < 8; ++r) {
                const v4u x3 = x[r]; float o[8];
#define CONV_E(e, W0, W1, W2, W3) o[e] = cb[e] + cw[0][e] * (W0) + cw[1][e] * (W1) + cw[2][e] * (W2) + cw[3][e] * (W3)
                CONV_E(0, bflo(w0.x), bflo(w1.x), bflo(w2.x), bflo(x3.x)); CONV_E(1, bfhi(w0.x), bfhi(w1.x), bfhi(w2.x), bfhi(x3.x));
                CONV_E(2, bflo(w0.y), bflo(w1.y), bflo(w2.y), bflo(x3.y)); CONV_E(3, bfhi(w0.y), bfhi(w1.y), bfhi(w2.y), bfhi(x3.y));
                CONV_E(4, bflo(w0.z), bflo(w1.z), bflo(w2.z), bflo(x3.z)); CONV_E(5, bfhi(w0.z), bfhi(w1.z), bfhi(w2.z), bfhi(x3.z));
                CONV_E(6, bflo(w0.w), bflo(w1.w), bflo(w2.w), bflo(x3.w)); CONV_E(7, bfhi(w0.w), bfhi(w1.w), bfhi(w2.w), bfhi(x3.w));
#undef CONV_E
#pragma unroll
                for (int e = 0; e < 8; ++e) o[e] = o[e] * sigm(o[e]) * sc;
                *(v4u*)(zp + (size_t)(i0 + r) * ZW) = (v4u){cvt_pk_bf16(o[0], o[1]), cvt_pk_bf16(o[2], o[3]), cvt_pk_bf16(o[4], o[5]), cvt_pk_bf16(o[6], o[7])};
                w0 = w1; w1 = w2; w2 = x3; }
        }
    }
}

constexpr int ML_QS = 0, ML_KS = 33792, ML_KT = 67584, ML_VT = 104448, ML_VWT = 109056, ML_CB = 113664, ML_PS = 130560, ML_FL = 139776;
constexpr int FL_A = 0, FL_MX = 64, FL_WIN = 128, FL_FLOOR = 192, FL_WST = 256, FL_SC = 320, FL_WSTB = 328, FL_GSZ = 360;
constexpr int FL_QN = 720;
constexpr int ML_NB = ML_FL + 784 * 4;
#define MFMA16(a, b, c) __builtin_amdgcn_mfma_f32_16x16x32_bf16((a), (b), (c), 0, 0, 0)

__device__ __forceinline__ void mlstm_unit(KArg P, int L, int b, int h, int vs, LAS unsigned char* lds) {
    const int tid = opaque_tid(), lane = tid & 63, w = __builtin_amdgcn_readfirstlane(tid >> 6), c = lane & 15, g = lane >> 4;
    bf16* Z = (bf16*)(ka_ws(P) + WS_Z); const float* gif = (const float*)(ka_ws(P) + WS_GIF);
    LAS float* FL = (LAS float*)(lds + ML_FL);
    const int cgp = lane, isk = cgp >> 5;
    const int zcol = (isk ? 1024 : 0) + h * 256 + (cgp & 31) * 8;
    const float bi = ka_in(P, 10)[L * 4 + h], bfg = ka_in(P, 11)[L * 4 + h];
    const size_t rowbase = (size_t)b * SEQ;
    for (int i = tid; i < 32 * 264 / 2; i += 512) ((LAS unsigned*)(lds + ML_CB))[i] = 0u;
    if (tid < 128) ((LAS unsigned*)(lds + ML_NB))[tid] = 0u;
    f32x4 Cn[2] = {(f32x4){0.f, 0.f, 0.f, 0.f}, (f32x4){0.f, 0.f, 0.f, 0.f}};
    f32x4 Cacc[2][2];
#pragma unroll
    for (int a = 0; a < 2; ++a)
#pragma unroll
        for (int d = 0; d < 2; ++d) Cacc[a][d] = (f32x4){0.f, 0.f, 0.f, 0.f};
    float m_st = 0.f;
    v4u raw[8]; v4u vraw = (v4u){0u, 0u, 0u, 0u}; float zi = 0.f, zf = 0.f;
    auto prefetch = [&](int ch) {
        const int t0 = ch * 64;
#pragma unroll
        for (int r = 0; r < 8; ++r) raw[r] = *(const v4u*)(Z + (rowbase + t0 + w * 8 + r) * ZW + zcol);
        if (tid < 256) vraw = *(const v4u*)(Z + (rowbase + t0 + (tid >> 2)) * ZW + ZC_V + h * 256 + vs * 32 + (tid & 3) * 8);
        if (tid >= 448) { zi = gif[(rowbase + t0 + lane) * 8 + h]; zf = gif[(rowbase + t0 + lane) * 8 + 4 + h]; }
    };
    auto gates = [&](LAS float* gb) {
        const float ig = zi + bi; const float xf = zf + bfg; const float lf = fminf(xf, 0.f) - __logf(1.0f + __expf(-fabsf(xf)));
        const float bsum = wave_scan_add(lf);
        const float a = ig - bsum; const float pm = wave_scan_max(a);
        const float Mx = fmaxf(m_st, pm);
        const float M63 = __int_as_float(__builtin_amdgcn_readlane(__float_as_int(Mx), 63)), blast = __int_as_float(__builtin_amdgcn_readlane(__float_as_int(bsum), 63));
        gb[FL_A + lane] = a; gb[FL_MX + lane] = Mx; gb[FL_WIN + lane] = __expf(m_st - Mx); gb[FL_FLOOR + lane] = __expf(-(bsum + Mx)); { const float wst = __expf(a - M63); gb[FL_WST + lane] = wst; ((LAS bf16*)(gb + FL_WSTB))[lane] = (bf16)(cvt_pk_bf16(wst, 0.f) & 0xffffu); }
        if (lane == 0) gb[FL_SC] = __expf(m_st - M63);
        m_st = blast + M63;
    };
    auto stage_qk = [&]() {
#pragma unroll
        for (int r = 0; r < 8; ++r) *(LAS v4u*)(lds + (isk ? ML_KS : ML_QS) + (w * 8 + r) * 528 + (cgp & 31) * 16) = raw[r];
    };
    auto stage_kt_v = [&](LAS float* gbn) {
        if (isk) {
#pragma unroll
            for (int e = 0; e < 8; ++e) {
                v4u t;
#define PKW(r) ((e >> 1) == 0 ? raw[r].x : (e >> 1) == 1 ? raw[r].y : (e >> 1) == 2 ? raw[r].z : raw[r].w)
                if (e & 1) { t.x = (PKW(0) >> 16) | (PKW(1) & 0xffff0000u); t.y = (PKW(2) >> 16) | (PKW(3) & 0xffff0000u); t.z = (PKW(4) >> 16) | (PKW(5) & 0xffff0000u); t.w = (PKW(6) >> 16) | (PKW(7) & 0xffff0000u); }
                else { t.x = (PKW(0) & 0xffffu) | (PKW(1) << 16); t.y = (PKW(2) & 0xffffu) | (PKW(3) << 16); t.z = (PKW(4) & 0xffffu) | (PKW(5) << 16); t.w = (PKW(6) & 0xffffu) | (PKW(7) << 16); }
#undef PKW
                *(LAS v4u*)(lds + ML_KT + ((cgp & 31) * 8 + e) * 144 + w * 16) = t; }
        }
        if (tid < 256) { const int s = tid >> 2, part = tid & 3; const float ws_ = gbn[FL_WST + s];
            const unsigned xs[4] = {vraw.x, vraw.y, vraw.z, vraw.w};
#pragma unroll
            for (int e = 0; e < 8; ++e) { const unsigned wd = xs[e >> 1]; const float v = (e & 1) ? bfhi(wd) : bflo(wd);
                *(LAS bf16*)(lds + ML_VT + (part * 8 + e) * 144 + s * 2) = (bf16)((e & 1) ? (wd >> 16) : (wd & 0xffffu));
                *(LAS bf16*)(lds + ML_VWT + (part * 8 + e) * 144 + s * 2) = (bf16)(cvt_pk_bf16(v * ws_, 0.f) & 0xffffu); } }
    };
    prefetch(0);
    if (w == 7) gates(FL);
    __syncthreads();
    stage_qk(); stage_kt_v(FL);
    __syncthreads();
    const int ttile = w >> 1, par = w & 1;
    for (int ch = 0; ch < 64; ++ch) {
        const int t0 = ch * 64;
        LAS float* GB = FL + (ch & 1) * FL_GSZ;
        if (ch + 1 < 64) prefetch(ch + 1);
        f32x4 accS0 = (f32x4){0.f, 0.f, 0.f, 0.f}, accS1 = accS0, accI = accS0, accN = accS0;
        const bf16x8 zero8 = (bf16x8){0, 0, 0, 0, 0, 0, 0, 0};
        {
            const LAS unsigned char* qp = lds + ML_QS + (ttile * 16 + c) * 528 + g * 16;
            const LAS unsigned char* k0p = lds + ML_KS + ((par * 2 + 0) * 16 + c) * 528 + g * 16;
            const LAS unsigned char* k1p = lds + ML_KS + ((par * 2 + 1) * 16 + c) * 528 + g * 16;
            const LAS unsigned char* cp = lds + ML_CB + (par * 16 + c) * 528 + g * 16;
#pragma unroll 2
            for (int kk = 0; kk < 8; ++kk) {
                const bf16x8 a = *(const LAS bf16x8*)(qp + kk * 64);
                const bf16x8 b0 = *(const LAS bf16x8*)(k0p + kk * 64), b1 = *(const LAS bf16x8*)(k1p + kk * 64), bc = *(const LAS bf16x8*)(cp + kk * 64);
                accS0 = MFMA16(a, b0, accS0); accS1 = MFMA16(a, b1, accS1); accI = MFMA16(a, bc, accI);
                { const bf16x8 bn = *(const LAS bf16x8*)(lds + ML_NB + kk * 64 + g * 16); accN = MFMA16(a, bn, accN); } }
#pragma unroll
            for (int r = 0; r < 4; ++r) { const int t = ttile * 16 + 4 * g + r; const float Mt = GB[FL_MX + t];
                const int s0 = (par * 2) * 16 + c, s1 = s0 + 16;
                const float w0 = (s0 <= t) ? __expf(GB[FL_A + s0] - Mt) : 0.f, w1 = (s1 <= t) ? __expf(GB[FL_A + s1] - Mt) : 0.f;
                *(LAS bf16*)(lds + ML_PS + t * 144 + s0 * 2) = (bf16)(cvt_pk_bf16(accS0[r] * w0, 0.f) & 0xffffu);
                *(LAS bf16*)(lds + ML_PS + t * 144 + s1 * 2) = (bf16)(cvt_pk_bf16(accS1[r] * w1, 0.f) & 0xffffu); }
        }
        __syncthreads();
        {
            f32x4 accP = (f32x4){0.f, 0.f, 0.f, 0.f}, accR = accP;
            const bf16x8 ones8 = (bf16x8){0x3f80, 0x3f80, 0x3f80, 0x3f80, 0x3f80, 0x3f80, 0x3f80, 0x3f80};
#pragma unroll
            for (int ks = 0; ks < 2; ++ks) {
                const bf16x8 a = *(const LAS bf16x8*)(lds + ML_PS + (ttile * 16 + c) * 144 + ks * 64 + g * 16);
                const bf16x8 bv = *(const LAS bf16x8*)(lds + ML_VT + (par * 16 + c) * 144 + ks * 64 + g * 16);
                accP = MFMA16(a, bv, accP); accR = MFMA16(a, ones8, accR); }
#pragma unroll
            for (int r = 0; r < 4; ++r) { const int t = ttile * 16 + 4 * g + r; const float wi = GB[FL_WIN + t];
                const float num = accP[r] + wi * accI[r]; const float den = accR[r] + wi * accN[r];
                const float hv = num * __builtin_amdgcn_rcpf(fmaxf(fabsf(den), GB[FL_FLOOR + t]));
                Z[(rowbase + t0 + t) * ZW + ZC_V + h * 256 + vs * 32 + par * 16 + c] = (bf16)(cvt_pk_bf16(hv, 0.f) & 0xffffu); }
            const float decay = GB[FL_SC];
            const LAS unsigned char* wsb = (const LAS unsigned char*)(GB + FL_WSTB);
#pragma unroll
            for (int kt = 0; kt < 2; ++kt) {
                bf16x8 bk[2];
#pragma unroll
                for (int ks = 0; ks < 2; ++ks) bk[ks] = *(const LAS bf16x8*)(lds + ML_KT + ((2 * w + kt) * 16 + c) * 144 + ks * 64 + g * 16);
#pragma unroll
                for (int vt = 0; vt < 2; ++vt) {
                    f32x4 cc = Cacc[kt][vt] * decay;
#pragma unroll
                    for (int ks = 0; ks < 2; ++ks) { const bf16x8 a = *(const LAS bf16x8*)(lds + ML_VWT + (vt * 16 + c) * 144 + ks * 64 + g * 16); cc = MFMA16(a, bk[ks], cc); }
                    Cacc[kt][vt] = cc;
#pragma unroll
                    for (int r = 0; r < 4; ++r) *(LAS bf16*)(lds + ML_CB + (vt * 16 + 4 * g + r) * 528 + ((2 * w + kt) * 16 + c) * 2) = (bf16)(cvt_pk_bf16(cc[r], 0.f) & 0xffffu);
                }
                f32x4 cn = Cn[kt] * decay;
#pragma unroll
                for (int ks = 0; ks < 2; ++ks) { const bf16x8 an = *(const LAS bf16x8*)(wsb + ks * 64 + g * 16); cn = MFMA16(an, bk[ks], cn); }
                Cn[kt] = cn;
                if (g == 0) *(LAS bf16*)(lds + ML_NB + ((2 * w + kt) * 16 + c) * 2) = (bf16)(cvt_pk_bf16(cn[0], 0.f) & 0xffffu);
            }
            if (w == 7 && ch + 1 < 64) gates(FL + ((ch + 1) & 1) * FL_GSZ);
            if (ch + 1 < 64) stage_qk();
        }
        __syncthreads();
        if (ch + 1 < 64) stage_kt_v(FL + ((ch + 1) & 1) * FL_GSZ);
    }
    __syncthreads();
}

constexpr int AT_K = 0, AT_VT = 36864;
__device__ __forceinline__ void attn_unit(KArg P, int L, int b, int nb, int kvh, LAS unsigned char* lds) {
    const int tid = opaque_tid(), lane = tid & 63, w = __builtin_amdgcn_readfirstlane(tid >> 6), c = lane & 15, g = lane >> 4;
    bf16* Z = (bf16*)(ka_ws(P) + WS_Z);
    const float* gq = ka_in(P, 13) + L * 64; const float* gk = ka_in(P, 14) + L * 64; const float* sinks = ka_in(P, 15) + L * 16;
    const size_t rowbase = (size_t)b * SEQ;
#pragma unroll
    for (int r = 0; r < 4; ++r) { const int item = tid + 512 * r, key = item >> 3, part = item & 7; const int t = nb * 128 - 128 + key;
        v4u kx = (v4u){0u, 0u, 0u, 0u}, vx = kx;
        if (t >= 0) { kx = *(const v4u*)(Z + (rowbase + t) * ZW + ZC_AK + kvh * 64 + part * 8); vx = *(const v4u*)(Z + (rowbase + t) * ZW + ZC_AV + kvh * 64 + part * 8); }
        float kf[8] = {bflo(kx.x), bfhi(kx.x), bflo(kx.y), bfhi(kx.y), bflo(kx.z), bfhi(kx.z), bflo(kx.w), bfhi(kx.w)};
        float ss = 0.f;
#pragma unroll
        for (int e = 0; e < 8; ++e) ss += kf[e] * kf[e];
        ss += __shfl_xor(ss, 1); ss += __shfl_xor(ss, 2); ss += __shfl_xor(ss, 4);
        const float rk = rsqrtf(ss * (1.0f / 64.0f) + EPS);
#pragma unroll
        for (int e = 0; e < 8; ++e) kf[e] = kf[e] * rk * gk[part * 8 + e];
        *(LAS v4u*)(lds + AT_K + key * 144 + part * 16) = (v4u){cvt_pk_bf16(kf[0], kf[1]), cvt_pk_bf16(kf[2], kf[3]), cvt_pk_bf16(kf[4], kf[5]), cvt_pk_bf16(kf[6], kf[7])};
        const unsigned xs[4] = {vx.x, vx.y, vx.z, vx.w};
#pragma unroll
        for (int e = 0; e < 8; ++e) { const unsigned wd = xs[e >> 1]; *(LAS bf16*)(lds + AT_VT + (part * 8 + e) * 528 + (key ^ (part << 2)) * 2) = (bf16)((e & 1) ? (wd >> 16) : (wd & 0xffffu)); }
    }
    __syncthreads();
    const int tile0 = w & ~1;
    const int qi = 16 * w + c;
    for (int hg = 0; hg < 4; ++hg) {
        const int head = kvh * 4 + hg; const float sink = sinks[head];
        bf16* qrow = Z + (rowbase + nb * 128 + qi) * ZW + ZC_AQ + head * 64;
        bf16x8 qf[2];
        { const v4u x0 = *(const v4u*)(qrow + g * 8), x1 = *(const v4u*)(qrow + 32 + g * 8);
          float f[16] = {bflo(x0.x), bfhi(x0.x), bflo(x0.y), bfhi(x0.y), bflo(x0.z), bfhi(x0.z), bflo(x0.w), bfhi(x0.w), bflo(x1.x), bfhi(x1.x), bflo(x1.y), bfhi(x1.y), bflo(x1.z), bfhi(x1.z), bflo(x1.w), bfhi(x1.w)};
          float ss = 0.f;
#pragma unroll
          for (int e = 0; e < 16; ++e) ss += f[e] * f[e];
          ss += __shfl_xor(ss, 16); ss += __shfl_xor(ss, 32);
          const float rq = rsqrtf(ss * (1.0f / 64.0f) + EPS) * 0.125f;
#pragma unroll
          for (int e = 0; e < 8; ++e) { f[e] *= rq * gq[g * 8 + e]; f[8 + e] *= rq * gq[32 + g * 8 + e]; }
          v4u p0 = (v4u){cvt_pk_bf16(f[0], f[1]), cvt_pk_bf16(f[2], f[3]), cvt_pk_bf16(f[4], f[5]), cvt_pk_bf16(f[6], f[7])};
          v4u p1 = (v4u){cvt_pk_bf16(f[8], f[9]), cvt_pk_bf16(f[10], f[11]), cvt_pk_bf16(f[12], f[13]), cvt_pk_bf16(f[14], f[15])};
          qf[0] = __builtin_bit_cast(bf16x8, p0); qf[1] = __builtin_bit_cast(bf16x8, p1); }
        const int odd = w & 1;
        f32x4 sc[10]; float mx = sink;
#pragma unroll
        for (int tt = 0; tt < 10; ++tt) {
            f32x4 a = (f32x4){-1e30f, -1e30f, -1e30f, -1e30f};
            const bool empty = odd ? (tt == 0) : (tt == 9);
            if (!empty) {
                a = (f32x4){0.f, 0.f, 0.f, 0.f};
#pragma unroll
                for (int ks = 0; ks < 2; ++ks) { const bf16x8 kfr = *(const LAS bf16x8*)(lds + AT_K + ((tile0 + tt) * 16 + c) * 144 + ks * 64 + g * 16); a = MFMA16(kfr, qf[ks], a); }
                const bool partial = odd ? (tt == 1 || tt == 9) : (tt == 0 || tt == 8);
                if (partial || nb == 0) {
#pragma unroll
                    for (int r = 0; r < 4; ++r) { const int kj = (tile0 + tt) * 16 + 4 * g + r; const bool valid = (kj >= qi + 1) && (kj <= qi + 128) && (nb > 0 || kj >= 128);
                        a[r] = valid ? a[r] : -1e30f; } }
#pragma unroll
                for (int r = 0; r < 4; ++r) mx = fmaxf(mx, a[r]);
            }
            sc[tt] = a; }
        mx = fmaxf(mx, __shfl_xor(mx, 16)); mx = fmaxf(mx, __shfl_xor(mx, 32));
        float sum = 0.f;
#pragma unroll
        for (int tt = 0; tt < 10; ++tt)
#pragma unroll
            for (int r = 0; r < 4; ++r) { const float p = (sc[tt][r] > -1e29f) ? __expf(sc[tt][r] - mx) : 0.f; sc[tt][r] = p; sum += p; }
        sum += __shfl_xor(sum, 16); sum += __shfl_xor(sum, 32);
        const float inv = 1.0f / (sum + __expf(sink - mx));
        f32x4 oacc[4];
#pragma unroll
        for (int dt = 0; dt < 4; ++dt) oacc[dt] = (f32x4){0.f, 0.f, 0.f, 0.f};
#pragma unroll
        for (int u = 0; u < 5; ++u) {
            v4u pb = (v4u){cvt_pk_bf16(sc[2 * u][0], sc[2 * u][1]), cvt_pk_bf16(sc[2 * u][2], sc[2 * u][3]), cvt_pk_bf16(sc[2 * u + 1][0], sc[2 * u + 1][1]), cvt_pk_bf16(sc[2 * u + 1][2], sc[2 * u + 1][3])};
            const bf16x8 pfr = __builtin_bit_cast(bf16x8, pb);
#pragma unroll
            for (int dt = 0; dt < 4; ++dt) {
                const int sw = (dt * 2 + (c >> 3)) & 7;
                const LAS unsigned char* vr = lds + AT_VT + (dt * 16 + c) * 528;
                const v2u lo = *(const LAS v2u*)(vr + ((((tile0 + 2 * u) * 4 + g) ^ sw) * 8)), hi = *(const LAS v2u*)(vr + ((((tile0 + 2 * u + 1) * 4 + g) ^ sw) * 8));
                const v4u av = (v4u){lo.x, lo.y, hi.x, hi.y};
                oacc[dt] = MFMA16(__builtin_bit_cast(bf16x8, av), pfr, oacc[dt]); } }
#pragma unroll
        for (int dt = 0; dt < 4; ++dt) { const f32x4 o = oacc[dt] * inv; v2u wv; wv.x = cvt_pk_bf16(o[0], o[1]); wv.y = cvt_pk_bf16(o[2], o[3]);
            *(v2u*)(qrow + dt * 16 + 4 * g) = wv; }
    }
    __syncthreads();
}

__device__ __forceinline__ void phase_fin(KArg P, int L, int vcu, int G) {
    const int tid = opaque_tid(); const int lane = tid & 63, wave = tid >> 6; const int gw = vcu * 8 + wave, NGW = G * 8;
    bf16* Z = (bf16*)(ka_ws(P) + WS_Z); const float* gn = ka_in(P, 12) + L * DM;
    for (int base = gw; base < MROWS * 4; base += 8 * NGW) {
        v2u hv[8], ov[8];
#pragma unroll
        for (int k = 0; k < 8; ++k) { int pair = base + k * NGW; if (pair >= MROWS * 4) pair = gw; const int row = pair >> 2, h = pair & 3;
            hv[k] = *(const v2u*)(Z + (size_t)row * ZW + ZC_V + h * 256 + lane * 4); ov[k] = *(const v2u*)(Z + (size_t)row * ZW + ZC_O + h * 256 + lane * 4); }
#pragma unroll
        for (int k = 0; k < 8; ++k) { const int pair = base + k * NGW; if (pair >= MROWS * 4) continue; const int row = pair >> 2, h = pair & 3;
            const f32x4 gv = *(const f32x4*)(gn + h * 256 + lane * 4);
            const float x0 = bflo(hv[k].x), x1 = bfhi(hv[k].x), x2 = bflo(hv[k].y), x3 = bfhi(hv[k].y);
            const float ss = wave_sum_dpp((x0 * x0 + x1 * x1) + (x2 * x2 + x3 * x3));
            const float r = rsqrtf(ss * (1.0f / 256.0f) + EPS);
            v2u o; o.x = cvt_pk_bf16(bflo(ov[k].x) * x0 * r * gv[0], bfhi(ov[k].x) * x1 * r * gv[1]); o.y = cvt_pk_bf16(bflo(ov[k].y) * x2 * r * gv[2], bfhi(ov[k].y) * x3 * r * gv[3]);
            *(v2u*)(Z + (size_t)row * ZW + ZC_V + h * 256 + lane * 4) = o; } }
}


#define XB_TMO      128
#define XB_XCNT(j)  (256  + 64 * (j))
#define XB_XSUB(j)  (1280 + 64 * (j))
#define XB_XGEN(j)  (2304 + 64 * (j))
#define XB_TOP      3328
#define XB_TOPGEN   3392
#define XCD_BAR_WORDS 3456
#define XB_SPIN_CAP (1u << 24)
constexpr size_t WS_BAR = 60 * MiB;
constexpr int LDS_XB = 147400;
__device__ __forceinline__ unsigned xb_ld(unsigned* p)              { return __hip_atomic_load(p, __ATOMIC_RELAXED, __HIP_MEMORY_SCOPE_AGENT); }
__device__ __forceinline__ unsigned xb_add(unsigned* p, unsigned v) { return __hip_atomic_fetch_add(p, v, __ATOMIC_RELAXED, __HIP_MEMORY_SCOPE_AGENT); }
__device__ __forceinline__ unsigned xb_xcc_id() { return (unsigned)__builtin_amdgcn_s_getreg((3 << 11) | 20) & 0xFu; }
#define XB_SPIN(cond, bar) do { unsigned _sp = 0; while (cond) { __builtin_amdgcn_s_sleep(1); \
    if ((++_sp & 255u) == 0u) { if (xb_ld(&(bar)[XB_TMO])) break; if (_sp > XB_SPIN_CAP) { atomicAdd(&(bar)[XB_TMO], 1u); break; } } } } while (0)
__device__ __forceinline__ void xcd_barrier_complete(unsigned* bar, unsigned x, unsigned& nloc, unsigned& nx) {
    const unsigned G = gridDim.x * gridDim.y * gridDim.z;
    unsigned sum, cnt, mine, sp = 0u;
    for (;;) {
        sum = 0u; cnt = 0u; mine = 0u;
#pragma unroll
        for (unsigned j = 0; j < 16; ++j) { const unsigned c = xb_ld(&bar[XB_XCNT(j)]); sum += c; cnt += (c > 0u) ? 1u : 0u; mine = (j == x) ? c : mine; }
        if (sum == G) break;
        __builtin_amdgcn_s_sleep(1);
        if ((++sp & 255u) == 0u) { if (xb_ld(&bar[XB_TMO])) break; if (sp > XB_SPIN_CAP) { atomicAdd(&bar[XB_TMO], 1u); break; } }
    }
    nloc = mine > 0u ? mine : 1u; nx = cnt > 0u ? cnt : 1u;
}
__device__ __forceinline__ void xcd_barrier(unsigned* bar, volatile LAS unsigned* st) {
    asm volatile("s_waitcnt vmcnt(0)" ::: "memory");
    __syncthreads();
    if (threadIdx.x == 0) {
        const unsigned x = xb_xcc_id();
        __builtin_amdgcn_s_waitcnt(0);
        unsigned nloc = st[0], nx = st[1];
        if (nloc == 0u) { xcd_barrier_complete(bar, x, nloc, nx); st[0] = nloc; st[1] = nx; }
        const unsigned old = xb_add(&bar[XB_XSUB(x)], 1u);
        const unsigned gen = old / nloc;
        if (old + 1u == (gen + 1u) * nloc) {
            __builtin_amdgcn_fence(__ATOMIC_RELEASE, "agent");
            asm volatile("s_waitcnt vmcnt(0)" ::: "memory");
            const unsigned og = xb_add(&bar[XB_TOP], 1u);
            const unsigned tg = og / nx;
            if (og + 1u == (tg + 1u) * nx) xb_add(&bar[XB_TOPGEN], 1u);
            else XB_SPIN(xb_ld(&bar[XB_TOPGEN]) == tg, bar);
            __builtin_amdgcn_fence(__ATOMIC_ACQUIRE, "agent");
            xb_add(&bar[XB_XGEN(x)], 1u);
            asm volatile("s_waitcnt vmcnt(0)" ::: "memory");
        } else {
            XB_SPIN(xb_ld(&bar[XB_XGEN(x)]) == gen, bar);
            __builtin_amdgcn_fence(__ATOMIC_ACQUIRE, "agent");
            asm volatile("s_waitcnt vmcnt(0)" ::: "memory");
        }
    }
    __syncthreads();
}

constexpr int PH_PER_LAYER = 12;
#define PH_STOP 24
__global__ void __launch_bounds__(512, 2) hybrid_fwd(Params Pk) {
    LAS unsigned char* lds = (LAS unsigned char*)g_lds;
    cg::grid_group grid = cg::this_grid();
    if (threadIdx.x < 2) ((LAS unsigned*)(lds + LDS_XB))[threadIdx.x] = 0u;
    { const KArg P0 = ka_get(); unsigned* bar0 = (unsigned*)(ka_ws(P0) + WS_BAR); if (threadIdx.x == 0) (void)xb_add(&bar0[XB_XCNT(xb_xcc_id())], 1u); }
    __syncthreads();
    bool first = true;
    const int ph_lo = Pk.ph_lo, ph_hi = Pk.ph_hi;
    for (int ph = ph_lo; ph < ph_hi; ++ph) {
        if (!first) {
            if (ph_lo < 0) {
                asm volatile("s_waitcnt vmcnt(0) lgkmcnt(0)" ::: "memory"); grid.sync(); __builtin_amdgcn_fence(__ATOMIC_ACQUIRE, "agent"); asm volatile("s_waitcnt vmcnt(0)" ::: "memory");
            } else { const KArg Pb = ka_get(); xcd_barrier((unsigned*)(ka_ws(Pb) + WS_BAR), (volatile LAS unsigned*)(lds + LDS_XB)); }
        }
        first = false;
        const KArg P = ka_get();
        unsigned char* ws = ka_ws(P); float* out = ka_out(P); int G = gridDim.x, bx = blockIdx.x;
        asm volatile("" : "+s"(G), "+s"(bx));
        const int vcu = (G % 8 == 0) ? (bx % 8) * (G / 8) + bx / 8 : bx;
        bf16* Z = (bf16*)(ws + WS_Z); bf16* HB = (bf16*)(ws + WS_HB); bf16* HB2 = (bf16*)(ws + WS_HB2); bf16* HID = (bf16*)(ws + WS_HID); bf16* PPb = (bf16*)(ws + WS_PP); bf16* T = (bf16*)out;
        const int L = ph / PH_PER_LAYER, q = ph % PH_PER_LAYER;
        float* RSA = (float*)(ws + WS_RSA); float* RSB = (float*)(ws + WS_RSB);
        pg8::StaticOrder S;
        switch (q) {
                case 0: phase_convert(P, L, lds, vcu, G); break;
        case 1: { pg8::Gemm gm{HB2, (const bf16*)(ws + WS_WGU1), MROWS, 5632, DM, DM, DM}; S.init(MROWS, 5632, G, bx);
                  EpiSwiglu E{HID, RSA}; pg8::gemm_phase<EpiSwiglu, true>(lds, gm, S, E); } break;
        case 2: { pg8::Gemm gm{HID, (const bf16*)(ws + WS_WD1), MROWS, DM, DFFP, DFFP, DFFP}; S.init(MROWS, DM, G, bx);
                  EpiRes<0> E{L == 0 ? ka_in(P, 0) : nullptr, nullptr, HB, RSB, 0.5f, nullptr, nullptr, L == 0 ? nullptr : HB2}; pg8::gemm_phase<EpiRes<0>, true>(lds, gm, S, E); } break;
        case 3: { pg8::Gemm gm{HB, (const bf16*)(ws + WS_WIN), MROWS, 5888, DM, DM, DM}; S.init(MROWS, 5888, G, bx);
                  EpiBf<4> E{Z, ZW, nullptr, 0, nullptr, 0, RSB, (float*)(ws + WS_GIF), (bf16*)(ws + WS_HALO)}; pg8::gemm_phase<EpiBf<4>, true>(lds, gm, S, E); } break;
        case 4: {
            conv_pass(P, L, vcu, G);
            for (int u = vcu; u < 1024; u += G) attn_unit(P, L, u >> 7, (u >> 2) & 31, u & 3, lds);
        } break;
        case 5: {
            for (int u = bx; u < 256; u += G) { const int bh = (u >> 6) * 8 + (u & 7), vs = (u >> 3) & 7; mlstm_unit(P, L, bh >> 2, bh & 3, vs, lds); }
        } break;
        case 6: { phase_fin(P, L, vcu, G);
                  pg8::Gemm gm{HB, (const bf16*)(ws + WS_WIN) + (size_t)5888 * DM, MROWS, 2048, DM, DM, DM}; S.init(MROWS, 2048, G, bx);
                  EpiBf<1> E{Z, ZW, nullptr, 0, nullptr, 0, RSB, nullptr, nullptr}; pg8::gemm_phase<EpiBf<1>, true>(lds, gm, S, E); } break;
        case 7: {
                  { pg8::Gemm gm{Z + ZC_V, (const bf16*)(ws + WS_WA), MROWS, DM, DM, ZW, DM}; S.init(MROWS, DM, G, bx);
                    EpiBf<2> E{T, DM, Z, ZW, nullptr, 0, nullptr, nullptr, nullptr}; pg8::gemm_phase<EpiBf<2>, true>(lds, gm, S, E); }
                  { pg8::Gemm gm{Z + ZC_AQ, (const bf16*)(ws + WS_WB), MROWS, DM, DM, ZW, DM}; S.init(MROWS, DM, G, bx);
                    EpiBf<3> E{Z, ZW, T, DM, Z + 1024, ZW, nullptr, nullptr, nullptr}; pg8::gemm_phase<EpiBf<3>, true>(lds, gm, S, E); } } break;
        case 8: { pg8::Gemm gm{Z, (const bf16*)(ws + WS_WOUT), MROWS, DM, DM, ZW, DM}; S.init(MROWS, DM, G, bx);
                  EpiRes<0> E{nullptr, nullptr, HB, RSA, 1.0f, nullptr, nullptr, HB}; pg8::gemm_phase<EpiRes<0>, true>(lds, gm, S, E); } break;
        case 9: { pg8::Gemm gm{HB, (const bf16*)(ws + WS_WGU2), MROWS, 5632, DM, DM, DM}; S.init(MROWS, 5632, G, bx);
                  EpiSwiglu E{HID, RSA}; pg8::gemm_phase<EpiSwiglu, true>(lds, gm, S, E); } break;
        case 10: { { pg8::Gemm gm{HID, (const bf16*)(ws + WS_WD2), MROWS, DM, DFFP, DFFP, DFFP}; S.init(MROWS, DM, G, bx);
                     EpiRes<0> E{nullptr, nullptr, HB, RSB, 0.5f, nullptr, nullptr, HB}; pg8::gemm_phase<EpiRes<0>, true>(lds, gm, S, E); }
                   { pg8::Gemm gm{(const bf16*)(ws + WS_PBF), (const bf16*)(ws + WS_WP), MROWS, DM, PLE, PLE, PLE}; S.init(MROWS, DM, G, bx);
                     EpiBf<0> E{PPb, DM, nullptr, 0, nullptr, 0, nullptr, nullptr}; pg8::gemm_phase<EpiBf<0>, true>(lds, gm, S, E); } } break;
        case 11: { pg8::Gemm gm{HB, (const bf16*)(ws + WS_WPG), MROWS, DM, DM, DM, DM}; S.init(MROWS, DM, G, bx);
                   EpiRes<1> E{nullptr, L == 1 ? out : nullptr, L == 1 ? nullptr : HB2, RSA, 1.0f, RSB, PPb, HB}; pg8::gemm_phase<EpiRes<1>, true>(lds, gm, S, E); } break;
        }
    }
}

extern "C" void kernel_launch(void* const* d_in, const int* in_sizes, int n_in, void* d_out, int out_size, void* d_ws, size_t ws_size, hipStream_t stream) {
    static int grid = 0;
    if (grid == 0) {
        if (n_in != 26 || out_size != MROWS * DM || ws_size < WS_END) { fprintf(stderr, "kernel_launch: unexpected problem (n_in %d out %d ws %zu)\n", n_in, out_size, ws_size); grid = -1; return; }
        int dev = 0, cus = 0, per_cu = 0;
        hipGetDevice(&dev); hipDeviceGetAttribute(&cus, hipDeviceAttributeMultiprocessorCount, dev);
        hipFuncSetAttribute((const void*)hybrid_fwd, hipFuncAttributeMaxDynamicSharedMemorySize, LDS_BYTES);
        hipOccupancyMaxActiveBlocksPerMultiprocessor(&per_cu, (const void*)hybrid_fwd, 512, LDS_BYTES);
        if (per_cu < 1) { fprintf(stderr, "kernel_launch: occupancy query says %d blocks/CU\n", per_cu); per_cu = 1; }
        (void)hipGetLastError();
        grid = cus;
    }
    if (grid < 0) return;
    if (hipMemsetAsync((char*)d_ws + WS_BAR, 0, 16384, stream) != hipSuccess) { fprintf(stderr, "kernel_launch: memset of barrier words failed\n"); return; }
    Params p{};
    for (int i = 0; i < 26; ++i) p.in[i] = (const float*)d_in[i];
    p.out = (float*)d_out; p.ws = (unsigned char*)d_ws; p.ph_lo = 0; p.ph_hi = PH_STOP;
    void* args[] = {&p};
    hipError_t e = hipLaunchCooperativeKernel((const void*)hybrid_fwd, dim3(grid), dim3(512), args, LDS_BYTES, stream);
    if (e != hipSuccess) fprintf(stderr, "cooperative launch failed: %s (grid %d)\n", hipGetErrorString(e), grid);
}
```

```cpp
#include <hip/hip_runtime.h>
#include <hip/hip_cooperative_groups.h>
#include <cstdio>
#include <cstdint>
namespace cg = cooperative_groups;

#define LAS __attribute__((address_space(3)))
typedef unsigned short bf16;
typedef unsigned v4u __attribute__((ext_vector_type(4)));
typedef unsigned v2u __attribute__((ext_vector_type(2)));
typedef float f32x4 __attribute__((ext_vector_type(4)));
typedef short bf16x8 __attribute__((ext_vector_type(8)));
typedef short s16x4 __attribute__((ext_vector_type(4)));

constexpr int MROWS = 32768, DM = 1024, SEQ = 4096, NB = 8, DFF = 2752, DFFP = 2816, NIN = 7688, PLE = 256;
constexpr int ZW = 5632;
constexpr int ZC_V = 2048, ZC_O = 3072, ZC_AQ = 4096, ZC_AK = 5120, ZC_AV = 5376;
constexpr int NWIN = 7936;
constexpr float EPS = 1e-6f;
constexpr size_t MiB = 1u << 20;
constexpr size_t WS_WGU1 = 0, WS_WD1 = 11 * MiB, WS_WIN = 16 * MiB + 512 * 1024, WS_WA = 32 * MiB, WS_WB = 34 * MiB, WS_WOUT = 36 * MiB, WS_WPG = 38 * MiB,
                 WS_WP = 40 * MiB, WS_WGU2 = 40 * MiB + 512 * 1024, WS_WD2 = 51 * MiB + 512 * 1024;
constexpr size_t WS_ROWSS = 57 * MiB;
constexpr size_t WS_GIF = 59 * MiB;
constexpr size_t WS_Z = 62 * MiB;
constexpr size_t WS_HID = WS_Z, WS_PP = WS_Z + 178 * MiB, WS_HB2 = WS_Z + 242 * MiB;
constexpr size_t WS_HB = 414 * MiB;
constexpr size_t WS_PBF = 478 * MiB;
constexpr size_t WS_HALO = 494 * MiB;
constexpr size_t WS_RSA = 500 * MiB, WS_RSB = 502 * MiB;
constexpr size_t WS_END = 504 * MiB;
constexpr int LDS_BYTES = 147456;

typedef float f32x2_t __attribute__((ext_vector_type(2)));
typedef __bf16 bf16x2_t __attribute__((ext_vector_type(2)));
__device__ __forceinline__ unsigned cvt_pk_bf16(float lo, float hi) { f32x2_t v = {lo, hi}; bf16x2_t b = __builtin_convertvector(v, bf16x2_t); return __builtin_bit_cast(unsigned, b); }
__device__ __forceinline__ float bflo(unsigned w) { return __uint_as_float(w << 16); }
__device__ __forceinline__ float bfhi(unsigned w) { return __uint_as_float(w & 0xffff0000u); }
__device__ __forceinline__ float sigm(float x) { return __builtin_amdgcn_rcpf(1.0f + __expf(-x)); }
__device__ __forceinline__ float wave_sum(float v) {
#pragma unroll
    for (int o = 1; o < 64; o <<= 1) v += __shfl_xor(v, o);
    return v;
}
template <int CTRL, int ROWMASK> __device__ __forceinline__ float dppf(float old, float v) { return __int_as_float(__builtin_amdgcn_update_dpp(__float_as_int(old), __float_as_int(v), CTRL, ROWMASK, 0xf, false)); }
__device__ __forceinline__ float wave_scan_add(float v) {
    v += dppf<0x111, 0xf>(0.f, v); v += dppf<0x112, 0xf>(0.f, v); v += dppf<0x114, 0xf>(0.f, v); v += dppf<0x118, 0xf>(0.f, v);
    v += dppf<0x142, 0xa>(0.f, v); v += dppf<0x143, 0xc>(0.f, v); return v; }
__device__ __forceinline__ float wave_scan_max(float v) {
    const float I = -3.0e38f;
    v = fmaxf(v, dppf<0x111, 0xf>(I, v)); v = fmaxf(v, dppf<0x112, 0xf>(I, v)); v = fmaxf(v, dppf<0x114, 0xf>(I, v)); v = fmaxf(v, dppf<0x118, 0xf>(I, v));
    v = fmaxf(v, dppf<0x142, 0xa>(I, v)); v = fmaxf(v, dppf<0x143, 0xc>(I, v)); return v; }
__device__ __forceinline__ float wave_sum_dpp(float v) { return __int_as_float(__builtin_amdgcn_readlane(__float_as_int(wave_scan_add(v)), 63)); }
#define LDS_WAIT() asm volatile("s_waitcnt lgkmcnt(0)" ::: "memory")
__device__ __forceinline__ int opaque_tid() { int t = threadIdx.x; asm volatile("" : "+v"(t)); return t; }

extern __shared__ __attribute__((aligned(16))) unsigned char g_lds[];
namespace pg8 {
constexpr int BM = 256, BK = 64, HALF = 128, HTB = HALF * BK * 2, STAGE_BYTES = 8 * HTB, NXCD = 8, WGM = 8;
constexpr int RSL_OFF = STAGE_BYTES;
__host__ __device__ __forceinline__ int lds_byte(int r, int c) { const int st = (r >> 4) * 2 + (c >> 5), rr = r & 15, cc = c & 31, ob = rr * 64 + cc * 2; return st * 1024 + (ob ^ (((ob >> 9) & 1) << 5)); }
__host__ __device__ __forceinline__ void stage_rc(int b, int& R, int& C) { const int st = b / 1024, sb = b % 1024, swz = sb ^ (((sb >> 9) & 1) << 5); R = (st >> 1) * 16 + swz / 64; C = (st & 1) * 32 + (swz % 64) / 2; }
__host__ __device__ __forceinline__ int perm32(int rho) { const int n = rho >> 4, i = rho & 15; return 8 * (i >> 2) + 4 * n + (i & 3); }
struct Unit { int pm, pn; };
struct Gemm { const bf16* A; const bf16* Bt; int M, N, K, lda, ldb; };
struct StaticOrder {
    int nM, nN, nwg, G, c;
    __device__ void init(int M, int N, int G_, int c_) { nM = M / BM; nN = N / BM; nwg = nM * nN; G = G_; c = c_; }
    __device__ bool next(int i, Unit& u) const {
        const int L = i * G + c; if (L >= nwg) return false;
        int wgid = L; { const int q = nwg / NXCD, r = nwg % NXCD, xcd = wgid % NXCD, off = wgid / NXCD; wgid = (xcd < r ? xcd * (q + 1) : r * (q + 1) + (xcd - r) * q) + off; }
        const int nig = WGM * nN, gid = wgid / nig, fm = gid * WGM, gsz = (nM - fm) < WGM ? (nM - fm) : WGM;
        u.pm = fm + ((wgid % nig) % gsz); u.pn = (wgid % nig) / gsz; return true;
    }
};
template <class Epi, bool ALIGN_EPI>
__device__ __forceinline__ void gemm_phase(LAS unsigned char* lds, const Gemm g, const StaticOrder& S, const Epi& E) {
    int tid_ = threadIdx.x; asm volatile("" : "+v"(tid_));
    const int tid = tid_, wid = __builtin_amdgcn_readfirstlane(tid >> 6), lane = tid & 63, wr = wid >> 2, wc = wid & 3, fr = lane & 15, fq = lane >> 4;
    const int K = g.K, nt = K / BK;
    unsigned voffA[2], voffB[2];
#pragma unroll
    for (int i = 0; i < 2; ++i) { int R, C; stage_rc(tid * 16 + i * 8192, R, C); const int Rb = Epi::PERM ? ((R & ~31) + perm32(R & 31)) : R;
        voffA[i] = (unsigned)(R * g.lda + C) * 2u; voffB[i] = (unsigned)(Rb * g.ldb + C) * 2u; }
    const size_t kstep = (size_t)(BK * 2);
    const size_t hstepA = (size_t)HALF * g.lda * 2, hstepB = (size_t)HALF * g.ldb * 2;
    const size_t tstepA = 2 * hstepA, tstepB = 2 * hstepB;
    const unsigned ldsw = (unsigned)wid * 1024u;
    const int aoff = lds_byte(wr * 64 + fr, fq * 8), boff = lds_byte(wc * 32 + fr, fq * 8);
#define PG8_SA(b, h) (((b) * 2 + (h)) * HTB)
#define PG8_SB(b, h) ((4 + (b) * 2 + (h)) * HTB)
#define PG8_STAGE(bufoff, gbase, voff) do { _Pragma("unroll") for (int _i = 0; _i < 2; ++_i) \
        __builtin_amdgcn_global_load_lds((const unsigned*)((const char*)(gbase) + (voff)[_i]), (LAS unsigned*)(lds + (bufoff) + ldsw + _i * 8192), 16, 0, 0); } while (0)
#define PG8_LDA(dst, b, h) do { _Pragma("unroll") for (int m = 0; m < 4; ++m) _Pragma("unroll") for (int k = 0; k < 2; ++k) dst[m][k] = *(const LAS bf16x8*)(lds + PG8_SA(b, h) + aoff + m * 2048 + k * 1024); } while (0)
#define PG8_LDB(dst, b, h) do { _Pragma("unroll") for (int n = 0; n < 2; ++n) _Pragma("unroll") for (int k = 0; k < 2; ++k) dst[n][k] = *(const LAS bf16x8*)(lds + PG8_SB(b, h) + boff + n * 2048 + k * 1024); } while (0)
#define PG8_MMA(ai, bj, At, Bt) do { __builtin_amdgcn_s_setprio(1); _Pragma("unroll") for (int m = 0; m < 4; ++m) _Pragma("unroll") for (int n = 0; n < 2; ++n) _Pragma("unroll") for (int k = 0; k < 2; ++k) \
        acc[ai][bj][m][n] = __builtin_amdgcn_mfma_f32_16x16x32_bf16(Bt[n][k], At[m][k], acc[ai][bj][m][n], 0, 0, 0); __builtin_amdgcn_s_setprio(0); } while (0)
#define PG8_WAIT_V(n) asm volatile("s_waitcnt vmcnt(" #n ")" ::: "memory")
#define PG8_WAIT_L(n) asm volatile("s_waitcnt lgkmcnt(" #n ")" ::: "memory")
#define PG8_BAR __builtin_amdgcn_s_barrier()
#define PG8_SCHED __builtin_amdgcn_sched_barrier(0)
    Unit cur, nxt; int ui = 0; int cpm = -1;
    if (!S.next(0, cur)) return;
    f32x4 acc[2][2][4][2];
#pragma unroll
    for (int a = 0; a < 2; ++a)
#pragma unroll
        for (int b = 0; b < 2; ++b)
#pragma unroll
            for (int m = 0; m < 4; ++m)
#pragma unroll
                for (int n = 0; n < 2; ++n) acc[a][b][m][n] = (f32x4){0.f, 0.f, 0.f, 0.f};
    bf16x8 At[4][2], B0[2][2], B1[2][2];
    const char* cA = (const char*)g.A + (size_t)cur.pm * tstepA; const char* cB = (const char*)g.Bt + (size_t)cur.pn * tstepB;
    PG8_STAGE(PG8_SB(0, 0), cB, voffB); PG8_STAGE(PG8_SB(0, 1), cB + hstepB, voffB); PG8_STAGE(PG8_SA(0, 0), cA, voffA); PG8_STAGE(PG8_SA(0, 1), cA + hstepA, voffA);
    if (wr == 1) PG8_BAR;
    PG8_WAIT_V(2); PG8_BAR;
    PG8_STAGE(PG8_SB(1, 0), cB + kstep, voffB); PG8_STAGE(PG8_SA(1, 0), cA + kstep, voffA); PG8_STAGE(PG8_SB(1, 1), cB + hstepB + kstep, voffB);
    PG8_WAIT_V(6); PG8_BAR;
    for (;;) {
        const bool has_next = S.next(ui + 1, nxt);
        const char* nA = has_next ? (const char*)g.A + (size_t)nxt.pm * tstepA : cA; const char* nB = has_next ? (const char*)g.Bt + (size_t)nxt.pn * tstepB : cB;
        for (int t = 0; t < nt; t += 2) {
            const bool last = (t == nt - 2);
            const char* a1 = cA + (size_t)(t + 1) * kstep;
            const char* a2 = last ? nA : cA + (size_t)(t + 2) * kstep; const char* b2 = last ? nB : cB + (size_t)(t + 2) * kstep;
            const char* a3 = a2 + kstep; const char* b3 = b2 + kstep;
            PG8_LDB(B0, 0, 0); PG8_LDB(B1, 0, 1); PG8_SCHED; PG8_LDA(At, 0, 0); PG8_STAGE(PG8_SA(1, 1), a1 + hstepA, voffA);
            PG8_WAIT_V(8); PG8_WAIT_L(0); PG8_BAR; PG8_MMA(0, 0, At, B0); PG8_MMA(0, 1, At, B1); PG8_BAR; PG8_SCHED;
            PG8_LDA(At, 0, 1); PG8_STAGE(PG8_SB(0, 0), b2, voffB); PG8_STAGE(PG8_SB(0, 1), b2 + hstepB, voffB); PG8_STAGE(PG8_SA(0, 0), a2, voffA);
            PG8_WAIT_V(8); PG8_WAIT_L(0); PG8_BAR; PG8_MMA(1, 0, At, B0); PG8_MMA(1, 1, At, B1); PG8_BAR; PG8_SCHED;
            PG8_LDB(B0, 1, 0); PG8_LDB(B1, 1, 1); PG8_SCHED; PG8_LDA(At, 1, 0); PG8_STAGE(PG8_SA(0, 1), a2 + hstepA, voffA);
            PG8_WAIT_V(8); PG8_WAIT_L(0); PG8_BAR; PG8_MMA(0, 0, At, B0); PG8_MMA(0, 1, At, B1); PG8_BAR; PG8_SCHED;
            PG8_LDA(At, 1, 1); PG8_STAGE(PG8_SB(1, 0), b3, voffB); PG8_STAGE(PG8_SB(1, 1), b3 + hstepB, voffB); PG8_STAGE(PG8_SA(1, 0), a3, voffA);
            PG8_WAIT_V(8); PG8_WAIT_L(0); PG8_BAR; PG8_MMA(1, 0, At, B0); PG8_MMA(1, 1, At, B1); PG8_BAR; PG8_SCHED;
        }
        if constexpr (ALIGN_EPI) { if (wr == 0) PG8_BAR; }
        if constexpr (Epi::USES_RS) {
            if (cur.pm != cpm) { cpm = cur.pm; const float* rp = E.rs_src();
#pragma unroll
                for (int j = 0; j < 2; ++j) { const int q = lane + 64 * j; const int row = cur.pm * 256 + (q >> 6) * 128 + wr * 64 + (q & 63);
                    const f32x4* p4 = (const f32x4*)(rp + (size_t)row * 16); const f32x4 t4 = (p4[0] + p4[1]) + (p4[2] + p4[3]);
                    ((LAS float*)(lds + RSL_OFF))[wid * 128 + q] = rsqrtf(((t4[0] + t4[1]) + (t4[2] + t4[3])) * (1.0f / 1024.0f) + 1e-6f); } }
        }
        E(acc, cur, wr, wc, fr, fq);
        if (!has_next) break;
#pragma unroll
        for (int a = 0; a < 2; ++a)
#pragma unroll
            for (int b = 0; b < 2; ++b)
#pragma unroll
                for (int m = 0; m < 4; ++m)
#pragma unroll
                    for (int n = 0; n < 2; ++n) acc[a][b][m][n] = (f32x4){0.f, 0.f, 0.f, 0.f};
        cur = nxt; cA = nA; cB = nB; ++ui;
        if constexpr (ALIGN_EPI) { if (wr == 1) PG8_BAR; }
    }
    PG8_WAIT_V(0);
    if constexpr (!ALIGN_EPI) { if (wr == 0) PG8_BAR; }
    PG8_BAR;
#undef PG8_SA
#undef PG8_SB
#undef PG8_STAGE
#undef PG8_LDA
#undef PG8_LDB
#undef PG8_MMA
#undef PG8_WAIT_V
#undef PG8_WAIT_L
#undef PG8_BAR
#undef PG8_SCHED
}
}

typedef const f32x4 (&AccRef)[2][2][4][2];
struct EpiSwiglu {
    static constexpr bool PERM = true, USES_RS = true;
    __device__ __forceinline__ const float* rs_src() const { return rowss; }
    bf16* O; const float* rowss;
    __device__ __forceinline__ void operator()(AccRef acc, const pg8::Unit& u, int, int, int, int) const {
        const int tid = opaque_tid(), wid = __builtin_amdgcn_readfirstlane(tid >> 6), wr = wid >> 2, wc = wid & 3, fr = tid & 15, fq = (tid & 63) >> 4;
        const int row0 = u.pm * 256 + wr * 64 + fr, col0 = u.pn * 128 + wc * 32 + 8 * fq;
#pragma unroll
        for (int ai = 0; ai < 2; ++ai)
#pragma unroll
            for (int m = 0; m < 4; ++m) {
                const int row = row0 + ai * 128 + m * 16; const float rs = ((const LAS float*)((LAS unsigned char*)g_lds + pg8::RSL_OFF))[wid * 128 + ai * 64 + m * 16 + fr];
                float o[8];
#pragma unroll
                for (int n = 0; n < 2; ++n)
#pragma unroll
                    for (int j = 0; j < 4; ++j) { const float gv = acc[ai][0][m][n][j] * rs, uv = acc[ai][1][m][n][j] * rs; o[n * 4 + j] = gv * sigm(gv) * uv; }
                v4u w; w.x = cvt_pk_bf16(o[0], o[1]); w.y = cvt_pk_bf16(o[2], o[3]); w.z = cvt_pk_bf16(o[4], o[5]); w.w = cvt_pk_bf16(o[6], o[7]);
                *(v4u*)(O + (size_t)row * DFFP + col0) = w; }
    }
};
template <int MODE> struct EpiRes {
    static constexpr bool PERM = true, USES_RS = (MODE == 1);
    __device__ __forceinline__ const float* rs_src() const { return rowss_in; }
    const float* hin; float* hout; bf16* hb; float* rowss_out; float alpha; const float* rowss_in; const bf16* pp; const bf16* hinb;
    __device__ __forceinline__ void operator()(AccRef acc, const pg8::Unit& u, int, int, int, int) const {
        const int tid = opaque_tid(), wid = __builtin_amdgcn_readfirstlane(tid >> 6), wr = wid >> 2, wc = wid & 3, fr = tid & 15, fq = (tid & 63) >> 4;
        const int row0 = u.pm * 256 + wr * 64 + fr, col0 = u.pn * 256 + wc * 32 + 8 * fq;
#pragma unroll
        for (int ai = 0; ai < 2; ++ai)
#pragma unroll
            for (int m = 0; m < 4; ++m) {
                const int row = row0 + ai * 128 + m * 16; float ss = 0.f; float rs = 1.f;
                if (MODE == 1) rs = ((const LAS float*)((LAS unsigned char*)g_lds + pg8::RSL_OFF))[wid * 128 + ai * 64 + m * 16 + fr];
#pragma unroll
                for (int bj = 0; bj < 2; ++bj) {
                    const size_t off = (size_t)row * DM + col0 + bj * 128;
                    f32x4 h0, h1; const f32x4 a0 = acc[ai][bj][m][0], a1 = acc[ai][bj][m][1];
                    if (hin) { h0 = *(const f32x4*)(hin + off); h1 = *(const f32x4*)(hin + off + 4); }
                    else { const v4u hw = *(const v4u*)(hinb + off); h0 = (f32x4){bflo(hw.x), bfhi(hw.x), bflo(hw.y), bfhi(hw.y)}; h1 = (f32x4){bflo(hw.z), bfhi(hw.z), bflo(hw.w), bfhi(hw.w)}; }
                    if (MODE == 0) { h0 = h0 + a0 * alpha; h1 = h1 + a1 * alpha; }
                    else { const v4u pw = *(const v4u*)(pp + off);
                        h0[0] += sigm(a0[0] * rs) * bflo(pw.x); h0[1] += sigm(a0[1] * rs) * bfhi(pw.x); h0[2] += sigm(a0[2] * rs) * bflo(pw.y); h0[3] += sigm(a0[3] * rs) * bfhi(pw.y);
                        h1[0] += sigm(a1[0] * rs) * bflo(pw.z); h1[1] += sigm(a1[1] * rs) * bfhi(pw.z); h1[2] += sigm(a1[2] * rs) * bflo(pw.w); h1[3] += sigm(a1[3] * rs) * bfhi(pw.w); }
                    if (hout) { *(f32x4*)(hout + off) = h0; *(f32x4*)(hout + off + 4) = h1; }
                    if (hb) { v4u w; w.x = cvt_pk_bf16(h0[0], h0[1]); w.y = cvt_pk_bf16(h0[2], h0[3]); w.z = cvt_pk_bf16(h1[0], h1[1]); w.w = cvt_pk_bf16(h1[2], h1[3]); *(v4u*)(hb + off) = w; }
                    ss += ((h0[0] * h0[0] + h0[1] * h0[1]) + (h0[2] * h0[2] + h0[3] * h0[3])) + ((h1[0] * h1[0] + h1[1] * h1[1]) + (h1[2] * h1[2] + h1[3] * h1[3])); }
                ss += __shfl_xor(ss, 16); ss += __shfl_xor(ss, 32);
                if (fq == 0) rowss_out[(size_t)row * 16 + u.pn * 4 + wc] = ss;
                if (m == 3) asm volatile("" ::: "memory"); }
    }
};
template <int MODE> struct EpiBf {
    static constexpr bool PERM = true, USES_RS = (MODE == 1 || MODE == 4);
    __device__ __forceinline__ const float* rs_src() const { return rowss; }
    bf16* O; int ldo; const bf16* a1; int ld1; const bf16* a2; int ld2; const float* rowss; float* gif; bf16* halo;
    __device__ __forceinline__ void operator()(AccRef acc, const pg8::Unit& u, int, int, int, int) const {
        const int tid = opaque_tid(), wid = __builtin_amdgcn_readfirstlane(tid >> 6), wr = wid >> 2, wc = wid & 3, fr = tid & 15, fq = (tid & 63) >> 4;
        const int row0 = u.pm * 256 + wr * 64 + fr, col0 = u.pn * 256 + wc * 32 + 8 * fq;
        if (MODE == 4 && u.pn == 22) {
            if (wc == 0 && fq == 0) {
#pragma unroll
                for (int ai = 0; ai < 2; ++ai)
#pragma unroll
                    for (int m = 0; m < 4; ++m) { const int row = row0 + ai * 128 + m * 16; const float rs = ((const LAS float*)((LAS unsigned char*)g_lds + pg8::RSL_OFF))[wid * 128 + ai * 64 + m * 16 + fr];
                        *(f32x4*)(gif + (size_t)row * 8) = acc[ai][0][m][0] * rs; *(f32x4*)(gif + (size_t)row * 8 + 4) = acc[ai][0][m][1] * rs; }
            }
            return;
        }
        const bool sg = (MODE == 1) || (MODE == 4 && u.pn >= 12 && u.pn < 16);
#pragma unroll
        for (int ai = 0; ai < 2; ++ai)
#pragma unroll
            for (int m = 0; m < 4; ++m) {
                const int row = row0 + ai * 128 + m * 16; float rs = 1.f;
                if (MODE == 1 || MODE == 4) rs = ((const LAS float*)((LAS unsigned char*)g_lds + pg8::RSL_OFF))[wid * 128 + ai * 64 + m * 16 + fr];
#pragma unroll
                for (int bj = 0; bj < 2; ++bj) {
                    const int col = col0 + bj * 128; float o[8];
#pragma unroll
                    for (int n = 0; n < 2; ++n)
#pragma unroll
                        for (int j = 0; j < 4; ++j) o[n * 4 + j] = acc[ai][bj][m][n][j] * rs;
                    if (sg) {
#pragma unroll
                        for (int j = 0; j < 8; ++j) o[j] = sigm(o[j]); }
                    if (MODE == 2 || MODE == 3) {
                        const v4u x = *(const v4u*)(a1 + (size_t)row * ld1 + col);
                        float xf[8] = {bflo(x.x), bfhi(x.x), bflo(x.y), bfhi(x.y), bflo(x.z), bfhi(x.z), bflo(x.w), bfhi(x.w)};
                        if (MODE == 2) {
#pragma unroll
                            for (int j = 0; j < 8; ++j) o[j] *= xf[j]; }
                        else { const v4u y = *(const v4u*)(a2 + (size_t)row * ld2 + col);
                            float yf[8] = {bflo(y.x), bfhi(y.x), bflo(y.y), bfhi(y.y), bflo(y.z), bfhi(y.z), bflo(y.w), bfhi(y.w)};
#pragma unroll
                            for (int j = 0; j < 8; ++j) o[j] = xf[j] + yf[j] * o[j]; }
                    }
                    v4u w; w.x = cvt_pk_bf16(o[0], o[1]); w.y = cvt_pk_bf16(o[2], o[3]); w.z = cvt_pk_bf16(o[4], o[5]); w.w = cvt_pk_bf16(o[6], o[7]);
                    *(v4u*)(O + (size_t)row * ldo + col) = w;
                    if (MODE == 4 && m == 3) { if (u.pn < 8 && fr >= 13) *(v4u*)(halo + ((size_t)(row >> 6) * 3 + (fr - 13)) * 2048 + col) = w; } }
                if ((MODE == 2 || MODE == 3) && (m & 1)) asm volatile("" ::: "memory"); }
    }
};

struct Params { const float* in[26]; float* out; unsigned char* ws; int ph_lo, ph_hi; };
typedef const __attribute__((address_space(4))) unsigned char* KArg;
__device__ __forceinline__ KArg ka_get() { KArg k = (KArg)__builtin_amdgcn_kernarg_segment_ptr(); asm volatile("" : "+s"(k)); return k; }
__device__ __forceinline__ const float* ka_in(KArg k, int i) { return *(const float* const __attribute__((address_space(4)))*)(k + 8 * i); }
__device__ __forceinline__ float* ka_out(KArg k) { return *(float* const __attribute__((address_space(4)))*)(k + 208); }
__device__ __forceinline__ unsigned char* ka_ws(KArg k) { return *(unsigned char* const __attribute__((address_space(4)))*)(k + 216); }
static_assert(sizeof(Params) == 232, "kernarg layout");

template <int KIND>
__device__ __forceinline__ void tr_item(const float* src, const float* src2, int srcN, int Ksrc, const float* gain, bf16* WT, int Kd, int nblk, int item, LAS float* scr, int lane) {
    const int kb = item / nblk, nb = item % nblk, k0 = 64 * kb, n0 = 64 * nb;
    const int n = n0 + (lane & 15) * 4;
    const float* cp = nullptr;
    if (KIND == 0) cp = src + n;
    if (KIND == 1) { const int hid = (n >> 8) * 128 + (n & 127); if (hid < DFF) cp = (((n >> 7) & 1) ? src2 : src) + hid; }
    if (KIND == 2) { if (n < 4096) cp = src + n; else if (n < 5632) cp = src + n + 8; else if (n < 5888) { if (n - 5632 < 8) cp = src + 4096 + (n - 5632); } else cp = src + 5640 + (n - 5888); }
    f32x4 v[16];
#pragma unroll
    for (int i = 0; i < 16; ++i) { const int k = k0 + 4 * i + (lane >> 4);
        v[i] = (cp != nullptr && k < Ksrc) ? *(const f32x4*)(cp + (size_t)k * srcN) : (f32x4){0.f, 0.f, 0.f, 0.f}; }
#pragma unroll
    for (int i = 0; i < 16; ++i) { LAS float* d = scr + (4 * i + (lane >> 4)) * 65 + (lane & 15) * 4; d[0] = v[i][0]; d[1] = v[i][1]; d[2] = v[i][2]; d[3] = v[i][3]; }
    LDS_WAIT(); asm volatile("" ::: "memory");
    const int c = lane & 7;
    float gk[8];
#pragma unroll
    for (int e = 0; e < 8; ++e) gk[e] = 1.0f;
    if (gain) { const f32x4 a = *(const f32x4*)(gain + k0 + 8 * c), b = *(const f32x4*)(gain + k0 + 8 * c + 4); gk[0] = a[0]; gk[1] = a[1]; gk[2] = a[2]; gk[3] = a[3]; gk[4] = b[0]; gk[5] = b[1]; gk[6] = b[2]; gk[7] = b[3]; }
#pragma unroll
    for (int j = 0; j < 8; ++j) { const int nn = (lane >> 3) + 8 * j; const LAS float* sp = scr + (8 * c) * 65 + nn;
        v4u o; o.x = cvt_pk_bf16(sp[0 * 65] * gk[0], sp[1 * 65] * gk[1]); o.y = cvt_pk_bf16(sp[2 * 65] * gk[2], sp[3 * 65] * gk[3]); o.z = cvt_pk_bf16(sp[4 * 65] * gk[4], sp[5 * 65] * gk[5]); o.w = cvt_pk_bf16(sp[6 * 65] * gk[6], sp[7 * 65] * gk[7]);
        *(v4u*)(WT + (size_t)(n0 + nn) * Kd + k0 + 8 * c) = o; }
    LDS_WAIT(); asm volatile("" ::: "memory");
}

__device__ __forceinline__ void phase_convert(KArg P, int L, LAS unsigned char* lds, int vcu, int G) {
    const int tid = opaque_tid(); const int lane = tid & 63, wave = tid >> 6;
    LAS float* scr = (LAS float*)(lds + wave * 16640);
    const int gw = vcu * 8 + wave, NGW = G * 8;
    unsigned char* ws = ka_ws(P);
    constexpr int I_GU = 16 * 88, I_D = 44 * 16, I_IN = 16 * 124, I_SQ = 16 * 16, I_P = 4 * 16;
    const size_t oGU = (size_t)L * DM * DFF, oSQ = (size_t)L * DM * DM;
    int off = 0;
#define CONV_LOOP(ITEMS, CALL) do { for (int it = (gw - off % NGW + NGW) % NGW; it < (ITEMS); it += NGW) { CALL; } off += (ITEMS); } while (0)
    CONV_LOOP(I_GU, tr_item<1>(ka_in(P, 3) + oGU, ka_in(P, 4) + oGU, DFF, DM, ka_in(P, 2) + L * DM, (bf16*)(ws + WS_WGU1), DM, 88, it, scr, lane));
    CONV_LOOP(I_D,  tr_item<0>(ka_in(P, 5) + oGU, nullptr, DM, DFF, nullptr, (bf16*)(ws + WS_WD1), DFFP, 16, it, scr, lane));
    CONV_LOOP(I_IN, tr_item<2>(ka_in(P, 7) + (size_t)L * DM * NIN, nullptr, NIN, DM, ka_in(P, 6) + L * DM, (bf16*)(ws + WS_WIN), DM, 124, it, scr, lane));
    CONV_LOOP(I_SQ, tr_item<0>(ka_in(P, 16) + oSQ, nullptr, DM, DM, nullptr, (bf16*)(ws + WS_WA), DM, 16, it, scr, lane));
    CONV_LOOP(I_SQ, tr_item<0>(ka_in(P, 17) + oSQ, nullptr, DM, DM, nullptr, (bf16*)(ws + WS_WB), DM, 16, it, scr, lane));
    CONV_LOOP(I_SQ, tr_item<0>(ka_in(P, 18) + oSQ, nullptr, DM, DM, nullptr, (bf16*)(ws + WS_WOUT), DM, 16, it, scr, lane));
    CONV_LOOP(I_GU, tr_item<1>(ka_in(P, 20) + oGU, ka_in(P, 21) + oGU, DFF, DM, ka_in(P, 19) + L * DM, (bf16*)(ws + WS_WGU2), DM, 88, it, scr, lane));
    CONV_LOOP(I_D,  tr_item<0>(ka_in(P, 22) + oGU, nullptr, DM, DFF, nullptr, (bf16*)(ws + WS_WD2), DFFP, 16, it, scr, lane));
    CONV_LOOP(I_SQ, tr_item<0>(ka_in(P, 24) + oSQ, nullptr, DM, DM, ka_in(P, 23) + L * DM, (bf16*)(ws + WS_WPG), DM, 16, it, scr, lane));
    CONV_LOOP(I_P,  tr_item<0>(ka_in(P, 25) + (size_t)L * PLE * DM, nullptr, DM, PLE, nullptr, (bf16*)(ws + WS_WP), PLE, 16, it, scr, lane));
#undef CONV_LOOP
    const float* pl = ka_in(P, 1) + (size_t)L * MROWS * PLE; bf16* pbf = (bf16*)(ws + WS_PBF);
    for (int m0 = gw; m0 < MROWS; m0 += 4 * NGW) { f32x4 v[4];
#pragma unroll
        for (int k = 0; k < 4; ++k) { const int m = (m0 + k * NGW < MROWS) ? m0 + k * NGW : m0; v[k] = *(const f32x4*)(pl + (size_t)m * PLE + lane * 4); }
#pragma unroll
        for (int k = 0; k < 4; ++k) { const int m = m0 + k * NGW; if (m < MROWS) { v2u w; w.x = cvt_pk_bf16(v[k][0], v[k][1]); w.y = cvt_pk_bf16(v[k][2], v[k][3]); *(v2u*)(pbf + (size_t)m * PLE + lane * 4) = w; } } }
    if (L == 0) {
        float* rowss = (float*)(ws + WS_RSA); bf16* hb2 = (bf16*)(ws + WS_HB2); const float* x = ka_in(P, 0);
        for (int m0 = gw; m0 < MROWS; m0 += 2 * NGW) { f32x4 v[2][4];
#pragma unroll
            for (int k = 0; k < 2; ++k) { const int m = (m0 + k * NGW < MROWS) ? m0 + k * NGW : m0;
#pragma unroll
                for (int j = 0; j < 4; ++j) v[k][j] = *(const f32x4*)(x + (size_t)m * DM + j * 256 + lane * 4); }
#pragma unroll
            for (int k = 0; k < 2; ++k) { const int m = m0 + k * NGW; if (m >= MROWS) continue; float ss = 0.f;
#pragma unroll
                for (int j = 0; j < 4; ++j) { const f32x4 t = v[k][j];
                    v2u w; w.x = cvt_pk_bf16(t[0], t[1]); w.y = cvt_pk_bf16(t[2], t[3]); *(v2u*)(hb2 + (size_t)m * DM + j * 256 + lane * 4) = w;
                    ss += (t[0] * t[0] + t[1] * t[1]) + (t[2] * t[2] + t[3] * t[3]); }
                ss = wave_sum_dpp(ss); if (lane < 16) rowss[(size_t)m * 16 + lane] = (lane == 0) ? ss : 0.f; } }
    }
}

__device__ __forceinline__ void conv_pass(KArg P, int L, int vcu, int G) {
    const int tid = opaque_tid();
    bf16* Z = (bf16*)(ka_ws(P) + WS_Z); const bf16* halo = (const bf16*)(ka_ws(P) + WS_HALO);
    const float* cwp = ka_in(P, 8) + (size_t)L * 4 * 2048; const float* cbp = ka_in(P, 9) + (size_t)L * 2048;
    for (int rg = vcu * 2 + (tid >> 8); rg < 512; rg += 2 * G) {
        const int col = (tid & 255) * 8;
        float cw[4][8], cb[8];
#pragma unroll
        for (int j = 0; j < 4; ++j) { const f32x4 a = *(const f32x4*)(cwp + j * 2048 + col), b = *(const f32x4*)(cwp + j * 2048 + col + 4);
            cw[j][0] = a[0]; cw[j][1] = a[1]; cw[j][2] = a[2]; cw[j][3] = a[3]; cw[j][4] = b[0]; cw[j][5] = b[1]; cw[j][6] = b[2]; cw[j][7] = b[3]; }
        { const f32x4 a = *(const f32x4*)(cbp + col), b = *(const f32x4*)(cbp + col + 4); cb[0] = a[0]; cb[1] = a[1]; cb[2] = a[2]; cb[3] = a[3]; cb[4] = b[0]; cb[5] = b[1]; cb[6] = b[2]; cb[7] = b[3]; }
        v4u w0 = (v4u){0u, 0u, 0u, 0u}, w1 = w0, w2 = w0;
        if ((rg & 63) != 0) { const bf16* hp = halo + (size_t)(rg - 1) * 3 * 2048 + col; w0 = *(const v4u*)hp; w1 = *(const v4u*)(hp + 2048); w2 = *(const v4u*)(hp + 4096); }
        const float sc = (col < 1024) ? 0.0625f : 1.0f;
        bf16* zp = Z + (size_t)rg * 64 * ZW + col;
        for (int i0 = 0; i0 < 64; i0 += 8) {
            v4u x[8];
#pragma unroll
            for (int r = 0; r < 8; ++r) x[r] = *(const v4u*)(zp + (size_t)(i0 + r) * ZW);
#pragma unroll
            for (int r = 0; r < 8; ++r) {
                const v4u x3 = x[r]; float o[8];
#define CONV_E(e, W0, W1, W2, W3) o[e] = cb[e] + cw[0][e] * (W0) + cw[1][e] * (W1) + cw[2][e] * (W2) + cw[3][e] * (W3)
                CONV_E(0, bflo(w0.x), bflo(w1.x), bflo(w2.x), bflo(x3.x)); CONV_E(1, bfhi(w0.x), bfhi(w1.x), bfhi(w2.x), bfhi(x3.x));
                CONV_E(2, bflo(w0.y), bflo(w1.y), bflo(w2.y), bflo(x3.y)); CONV_E(3, bfhi(w0.y), bfhi(w1.y), bfhi(w2.y), bfhi(x3.y));
                CONV_E(4, bflo(w0.z), bflo(w1.z), bflo(w2.z), bflo(x3.z)); CONV_E(5, bfhi(w0.z), bfhi(w1.z), bfhi(w2.z), bfhi(x3.z));
                CONV_E(6, bflo(w0.w), bflo(w1.w), bflo(w2.w), bflo(x3.w)); CONV_E(7, bfhi(w0.w), bfhi(w1.w), bfhi(w2.w), bfhi(x3.w));
#undef CONV_E
#pragma unroll
                for (int e = 0; e < 8; ++e) o[e] = o[e] * sigm(o[e]) * sc;
                *(v4u*)(zp + (size_t)(i0 + r) * ZW) = (v4u){cvt_pk_bf16(o[0], o[1]), cvt_pk_bf16(o[2], o[3]), cvt_pk_bf16(o[4], o[5]), cvt_pk_bf16(o[6], o[7])};
                w0 = w1; w1 = w2; w2 = x3; }
        }
    }
}

constexpr int ML_QS = 0, ML_KS = 33792, ML_KT = 67584, ML_VT = 104448, ML_VWT = 109056, ML_CB = 113664, ML_PS = 130560, ML_FL = 139776;
constexpr int FL_A = 0, FL_MX = 64, FL_WIN = 128, FL_FLOOR = 192, FL_WST = 256, FL_SC = 320, FL_WSTB = 328, FL_GSZ = 360;
constexpr int FL_QN = 720;
constexpr int ML_NB = ML_FL + 784 * 4;
#define MFMA16(a, b, c) __builtin_amdgcn_mfma_f32_16x16x32_bf16((a), (b), (c), 0, 0, 0)

__device__ __forceinline__ void mlstm_unit(KArg P, int L, int b, int h, int vs, LAS unsigned char* lds) {
    const int tid = opaque_tid(), lane = tid & 63, w = __builtin_amdgcn_readfirstlane(tid >> 6), c = lane & 15, g = lane >> 4;
    bf16* Z = (bf16*)(ka_ws(P) + WS_Z); const float* gif = (const float*)(ka_ws(P) + WS_GIF);
    LAS float* FL = (LAS float*)(lds + ML_FL);
    const int cgp = lane, isk = cgp >> 5;
    const int zcol = (isk ? 1024 : 0) + h * 256 + (cgp & 31) * 8;
    const float bi = ka_in(P, 10)[L * 4 + h], bfg = ka_in(P, 11)[L * 4 + h];
    const size_t rowbase = (size_t)b * SEQ;
    for (int i = tid; i < 32 * 264 / 2; i += 512) ((LAS unsigned*)(lds + ML_CB))[i] = 0u;
    if (tid < 128) ((LAS unsigned*)(lds + ML_NB))[tid] = 0u;
    f32x4 Cn[2] = {(f32x4){0.f, 0.f, 0.f, 0.f}, (f32x4){0.f, 0.f, 0.f, 0.f}};
    f32x4 Cacc[2][2];
#pragma unroll
    for (int a = 0; a < 2; ++a)
#pragma unroll
        for (int d = 0; d < 2; ++d) Cacc[a][d] = (f32x4){0.f, 0.f, 0.f, 0.f};
    float m_st = 0.f;
    v4u raw[8]; v4u vraw = (v4u){0u, 0u, 0u, 0u}; float zi = 0.f, zf = 0.f;
    auto prefetch = [&](int ch) {
        const int t0 = ch * 64;
#pragma unroll
        for (int r = 0; r < 8; ++r) raw[r] = *(const v4u*)(Z + (rowbase + t0 + w * 8 + r) * ZW + zcol);
        if (tid < 256) vraw = *(const v4u*)(Z + (rowbase + t0 + (tid >> 2)) * ZW + ZC_V + h * 256 + vs * 32 + (tid & 3) * 8);
        if (tid >= 448) { zi = gif[(rowbase + t0 + lane) * 8 + h]; zf = gif[(rowbase + t0 + lane) * 8 + 4 + h]; }
    };
    auto gates = [&](LAS float* gb) {
        const float ig = zi + bi; const float xf = zf + bfg; const float lf = fminf(xf, 0.f) - __logf(1.0f + __expf(-fabsf(xf)));
        const float bsum = wave_scan_add(lf);
        const float a = ig - bsum; const float pm = wave_scan_max(a);
        const float Mx = fmaxf(m_st, pm);
        const float M63 = __int_as_float(__builtin_amdgcn_readlane(__float_as_int(Mx), 63)), blast = __int_as_float(__builtin_amdgcn_readlane(__float_as_int(bsum), 63));
        gb[FL_A + lane] = a; gb[FL_MX + lane] = Mx; gb[FL_WIN + lane] = __expf(m_st - Mx); gb[FL_FLOOR + lane] = __expf(-(bsum + Mx)); { const float wst = __expf(a - M63); gb[FL_WST + lane] = wst; ((LAS bf16*)(gb + FL_WSTB))[lane] = (bf16)(cvt_pk_bf16(wst, 0.f) & 0xffffu); }
        if (lane == 0) gb[FL_SC] = __expf(m_st - M63);
        m_st = blast + M63;
    };
    auto stage_qk = [&]() {
#pragma unroll
        for (int r = 0; r < 8; ++r) *(LAS v4u*)(lds + (isk ? ML_KS : ML_QS) + (w * 8 + r) * 528 + (cgp & 31) * 16) = raw[r];
    };
    auto stage_kt_v = [&](LAS float* gbn) {
        if (isk) {
#pragma unroll
            for (int e = 0; e < 8; ++e) {
                v4u t;
#define PKW(r) ((e >> 1) == 0 ? raw[r].x : (e >> 1) == 1 ? raw[r].y : (e >> 1) == 2 ? raw[r].z : raw[r].w)
                if (e & 1) { t.x = (PKW(0) >> 16) | (PKW(1) & 0xffff0000u); t.y = (PKW(2) >> 16) | (PKW(3) & 0xffff0000u); t.z = (PKW(4) >> 16) | (PKW(5) & 0xffff0000u); t.w = (PKW(6) >> 16) | (PKW(7) & 0xffff0000u); }
                else { t.x = (PKW(0) & 0xffffu) | (PKW(1) << 16); t.y = (PKW(2) & 0xffffu) | (PKW(3) << 16); t.z = (PKW(4) & 0xffffu) | (PKW(5) << 16); t.w = (PKW(6) & 0xffffu) | (PKW(7) << 16); }
#undef PKW
                *(LAS v4u*)(lds + ML_KT + ((cgp & 31) * 8 + e) * 144 + ((w ^ (((cgp & 31) >> 1) & 7)) * 16)) = t; }
        }
        if (tid < 256) { const int s = tid >> 2, part = tid & 3; const float ws_ = gbn[FL_WST + s];
            const unsigned xs[4] = {vraw.x, vraw.y, vraw.z, vraw.w};
#pragma unroll
            for (int e = 0; e < 8; ++e) { const unsigned wd = xs[e >> 1]; const float v = (e & 1) ? bfhi(wd) : bflo(wd);
                *(LAS bf16*)(lds + ML_VT + (part * 8 + e) * 144 + s * 2) = (bf16)((e & 1) ? (wd >> 16) : (wd & 0xffffu));
                *(LAS bf16*)(lds + ML_VWT + (part * 8 + e) * 144 + s * 2) = (bf16)(cvt_pk_bf16(v * ws_, 0.f) & 0xffffu); } }
    };
    prefetch(0);
    if (w == 7) gates(FL);
    __syncthreads();
    stage_qk(); stage_kt_v(FL);
    __syncthreads();
    const int ttile = w >> 1, par = w & 1;
    for (int ch = 0; ch < 64; ++ch) {
        const int t0 = ch * 64;
        LAS float* GB = FL + (ch & 1) * FL_GSZ;
        if (ch + 1 < 64) prefetch(ch + 1);
        f32x4 accS0 = (f32x4){0.f, 0.f, 0.f, 0.f}, accS1 = accS0, accI = accS0, accN = accS0;
        const bf16x8 zero8 = (bf16x8){0, 0, 0, 0, 0, 0, 0, 0};
        {
            const LAS unsigned char* qp = lds + ML_QS + (ttile * 16 + c) * 528 + g * 16;
            const LAS unsigned char* k0p = lds + ML_KS + ((par * 2 + 0) * 16 + c) * 528 + g * 16;
            const LAS unsigned char* k1p = lds + ML_KS + ((par * 2 + 1) * 16 + c) * 528 + g * 16;
            const LAS unsigned char* cp = lds + ML_CB + (par * 16 + c) * 528 + g * 16;
#pragma unroll 2
            for (int kk = 0; kk < 8; ++kk) {
                const bf16x8 a = *(const LAS bf16x8*)(qp + kk * 64);
                const bf16x8 b0 = *(const LAS bf16x8*)(k0p + kk * 64), b1 = *(const LAS bf16x8*)(k1p + kk * 64), bc = *(const LAS bf16x8*)(cp + kk * 64);
                accS0 = MFMA16(a, b0, accS0); accS1 = MFMA16(a, b1, accS1); accI = MFMA16(a, bc, accI);
                { const bf16x8 bn = *(const LAS bf16x8*)(lds + ML_NB + kk * 64 + g * 16); accN = MFMA16(a, bn, accN); } }
#pragma unroll
            for (int r = 0; r < 4; ++r) { const int t = ttile * 16 + 4 * g + r; const float Mt = GB[FL_MX + t];
                const int s0 = (par * 2) * 16 + c, s1 = s0 + 16;
                const float w0 = (s0 <= t) ? __expf(GB[FL_A + s0] - Mt) : 0.f, w1 = (s1 <= t) ? __expf(GB[FL_A + s1] - Mt) : 0.f;
                *(LAS bf16*)(lds + ML_PS + t * 144 + s0 * 2) = (bf16)(cvt_pk_bf16(accS0[r] * w0, 0.f) & 0xffffu);
                *(LAS bf16*)(lds + ML_PS + t * 144 + s1 * 2) = (bf16)(cvt_pk_bf16(accS1[r] * w1, 0.f) & 0xffffu); }
        }
        __syncthreads();
        {
            f32x4 accP = (f32x4){0.f, 0.f, 0.f, 0.f}, accR = accP;
            const bf16x8 ones8 = (bf16x8){0x3f80, 0x3f80, 0x3f80, 0x3f80, 0x3f80, 0x3f80, 0x3f80, 0x3f80};
#pragma unroll
            for (int ks = 0; ks < 2; ++ks) {
                const bf16x8 a = *(const LAS bf16x8*)(lds + ML_PS + (ttile * 16 + c) * 144 + ks * 64 + g * 16);
                const bf16x8 bv = *(const LAS bf16x8*)(lds + ML_VT + (par * 16 + c) * 144 + ks * 64 + g * 16);
                accP = MFMA16(a, bv, accP); accR = MFMA16(a, ones8, accR); }
#pragma unroll
            for (int r = 0; r < 4; ++r) { const int t = ttile * 16 + 4 * g + r; const float wi = GB[FL_WIN + t];
                const float num = accP[r] + wi * accI[r]; const float den = accR[r] + wi * accN[r];
                const float hv = num * __builtin_amdgcn_rcpf(fmaxf(fabsf(den), GB[FL_FLOOR + t]));
                Z[(rowbase + t0 + t) * ZW + ZC_V + h * 256 + vs * 32 + par * 16 + c] = (bf16)(cvt_pk_bf16(hv, 0.f) & 0xffffu); }
            const float decay = GB[FL_SC];
            const LAS unsigned char* wsb = (const LAS unsigned char*)(GB + FL_WSTB);
#pragma unroll
            for (int kt = 0; kt < 2; ++kt) {
                bf16x8 bk[2];
#pragma unroll
                for (int ks = 0; ks < 2; ++ks) bk[ks] = *(const LAS bf16x8*)(lds + ML_KT + ((2 * w + kt) * 16 + c) * 144 + (((ks * 4 + g) ^ ((2 * w + kt) & 7)) * 16));
#pragma unroll
                for (int vt = 0; vt < 2; ++vt) {
                    f32x4 cc = Cacc[kt][vt] * decay;
#pragma unroll
                    for (int ks = 0; ks < 2; ++ks) { const bf16x8 a = *(const LAS bf16x8*)(lds + ML_VWT + (vt * 16 + c) * 144 + ks * 64 + g * 16); cc = MFMA16(a, bk[ks], cc); }
                    Cacc[kt][vt] = cc;
#pragma unroll
                    for (int r = 0; r < 4; ++r) *(LAS bf16*)(lds + ML_CB + (vt * 16 + 4 * g + r) * 528 + ((2 * w + kt) * 16 + c) * 2) = (bf16)(cvt_pk_bf16(cc[r], 0.f) & 0xffffu);
                }
                f32x4 cn = Cn[kt] * decay;
#pragma unroll
                for (int ks = 0; ks < 2; ++ks) { const bf16x8 an = *(const LAS bf16x8*)(wsb + ks * 64 + g * 16); cn = MFMA16(an, bk[ks], cn); }
                Cn[kt] = cn;
                if (g == 0) *(LAS bf16*)(lds + ML_NB + ((2 * w + kt) * 16 + c) * 2) = (bf16)(cvt_pk_bf16(cn[0], 0.f) & 0xffffu);
            }
            if (w == 7 && ch + 1 < 64) gates(FL + ((ch + 1) & 1) * FL_GSZ);
            if (ch + 1 < 64) stage_qk();
        }
        __syncthreads();
        if (ch + 1 < 64) stage_kt_v(FL + ((ch + 1) & 1) * FL_GSZ);
    }
    __syncthreads();
}

constexpr int AT_K = 0, AT_VT = 36864;
__device__ __forceinline__ void attn_unit(KArg P, int L, int b, int nb, int kvh, LAS unsigned char* lds) {
    const int tid = opaque_tid(), lane = tid & 63, w = __builtin_amdgcn_readfirstlane(tid >> 6), c = lane & 15, g = lane >> 4;
    bf16* Z = (bf16*)(ka_ws(P) + WS_Z);
    const float* gq = ka_in(P, 13) + L * 64; const float* gk = ka_in(P, 14) + L * 64; const float* sinks = ka_in(P, 15) + L * 16;
    const size_t rowbase = (size_t)b * SEQ;
#pragma unroll
    for (int r = 0; r < 4; ++r) { const int item = tid + 512 * r, key = item >> 3, part = item & 7; const int t = nb * 128 - 128 + key;
        v4u kx = (v4u){0u, 0u, 0u, 0u}, vx = kx;
        if (t >= 0) { kx = *(const v4u*)(Z + (rowbase + t) * ZW + ZC_AK + kvh * 64 + part * 8); vx = *(const v4u*)(Z + (rowbase + t) * ZW + ZC_AV + kvh * 64 + part * 8); }
        float kf[8] = {bflo(kx.x), bfhi(kx.x), bflo(kx.y), bfhi(kx.y), bflo(kx.z), bfhi(kx.z), bflo(kx.w), bfhi(kx.w)};
        float ss = 0.f;
#pragma unroll
        for (int e = 0; e < 8; ++e) ss += kf[e] * kf[e];
        ss += __shfl_xor(ss, 1); ss += __shfl_xor(ss, 2); ss += __shfl_xor(ss, 4);
        const float rk = rsqrtf(ss * (1.0f / 64.0f) + EPS);
#pragma unroll
        for (int e = 0; e < 8; ++e) kf[e] = kf[e] * rk * gk[part * 8 + e];
        *(LAS v4u*)(lds + AT_K + key * 144 + part * 16) = (v4u){cvt_pk_bf16(kf[0], kf[1]), cvt_pk_bf16(kf[2], kf[3]), cvt_pk_bf16(kf[4], kf[5]), cvt_pk_bf16(kf[6], kf[7])};
        const unsigned xs[4] = {vx.x, vx.y, vx.z, vx.w};
#pragma unroll
        for (int e = 0; e < 8; ++e) { const unsigned wd = xs[e >> 1]; *(LAS bf16*)(lds + AT_VT + (part * 8 + e) * 528 + (key ^ (part << 2)) * 2) = (bf16)((e & 1) ? (wd >> 16) : (wd & 0xffffu)); }
    }
    __syncthreads();
    const int tile0 = w & ~1;
    const int qi = 16 * w + c;
    for (int hg = 0; hg < 4; ++hg) {
        const int head = kvh * 4 + hg; const float sink = sinks[head];
        bf16* qrow = Z + (rowbase + nb * 128 + qi) * ZW + ZC_AQ + head * 64;
        bf16x8 qf[2];
        { const v4u x0 = *(const v4u*)(qrow + g * 8), x1 = *(const v4u*)(qrow + 32 + g * 8);
          float f[16] = {bflo(x0.x), bfhi(x0.x), bflo(x0.y), bfhi(x0.y), bflo(x0.z), bfhi(x0.z), bflo(x0.w), bfhi(x0.w), bflo(x1.x), bfhi(x1.x), bflo(x1.y), bfhi(x1.y), bflo(x1.z), bfhi(x1.z), bflo(x1.w), bfhi(x1.w)};
          float ss = 0.f;
#pragma unroll
          for (int e = 0; e < 16; ++e) ss += f[e] * f[e];
          ss += __shfl_xor(ss, 16); ss += __shfl_xor(ss, 32);
          const float rq = rsqrtf(ss * (1.0f / 64.0f) + EPS) * 0.125f;
#pragma unroll
          for (int e = 0; e < 8; ++e) { f[e] *= rq * gq[g * 8 + e]; f[8 + e] *= rq * gq[32 + g * 8 + e]; }
          v4u p0 = (v4u){cvt_pk_bf16(f[0], f[1]), cvt_pk_bf16(f[2], f[3]), cvt_pk_bf16(f[4], f[5]), cvt_pk_bf16(f[6], f[7])};
          v4u p1 = (v4u){cvt_pk_bf16(f[8], f[9]), cvt_pk_bf16(f[10], f[11]), cvt_pk_bf16(f[12], f[13]), cvt_pk_bf16(f[14], f[15])};
          qf[0] = __builtin_bit_cast(bf16x8, p0); qf[1] = __builtin_bit_cast(bf16x8, p1); }
        const int odd = w & 1;
        f32x4 sc[10]; float mx = sink;
#pragma unroll
        for (int tt = 0; tt < 10; ++tt) {
            f32x4 a = (f32x4){-1e30f, -1e30f, -1e30f, -1e30f};
            const bool empty = odd ? (tt == 0) : (tt == 9);
            if (!empty) {
                a = (f32x4){0.f, 0.f, 0.f, 0.f};
#pragma unroll
                for (int ks = 0; ks < 2; ++ks) { const bf16x8 kfr = *(const LAS bf16x8*)(lds + AT_K + ((tile0 + tt) * 16 + c) * 144 + ks * 64 + g * 16); a = MFMA16(kfr, qf[ks], a); }
                const bool partial = odd ? (tt == 1 || tt == 9) : (tt == 0 || tt == 8);
                if (partial || nb == 0) {
#pragma unroll
                    for (int r = 0; r < 4; ++r) { const int kj = (tile0 + tt) * 16 + 4 * g + r; const bool valid = (kj >= qi + 1) && (kj <= qi + 128) && (nb > 0 || kj >= 128);
                        a[r] = valid ? a[r] : -1e30f; } }
#pragma unroll
                for (int r = 0; r < 4; ++r) mx = fmaxf(mx, a[r]);
            }
            sc[tt] = a; }
        mx = fmaxf(mx, __shfl_xor(mx, 16)); mx = fmaxf(mx, __shfl_xor(mx, 32));
        float sum = 0.f;
#pragma unroll
        for (int tt = 0; tt < 10; ++tt)
#pragma unroll
            for (int r = 0; r < 4; ++r) { const float p = (sc[tt][r] > -1e29f) ? __expf(sc[tt][r] - mx) : 0.f; sc[tt][r] = p; sum += p; }
        sum += __shfl_xor(sum, 16); sum += __shfl_xor(sum, 32);
        const float inv = 1.0f / (sum + __expf(sink - mx));
        f32x4 oacc[4];
#pragma unroll
        for (int dt = 0; dt < 4; ++dt) oacc[dt] = (f32x4){0.f, 0.f, 0.f, 0.f};
#pragma unroll
        for (int u = 0; u < 5; ++u) {
            v4u pb = (v4u){cvt_pk_bf16(sc[2 * u][0], sc[2 * u][1]), cvt_pk_bf16(sc[2 * u][2], sc[2 * u][3]), cvt_pk_bf16(sc[2 * u + 1][0], sc[2 * u + 1][1]), cvt_pk_bf16(sc[2 * u + 1][2], sc[2 * u + 1][3])};
            const bf16x8 pfr = __builtin_bit_cast(bf16x8, pb);
#pragma unroll
            for (int dt = 0; dt < 4; ++dt) {
                const int sw = (dt * 2 + (c >> 3)) & 7;
                const LAS unsigned char* vr = lds + AT_VT + (dt * 16 + c) * 528;
                const v2u lo = *(const LAS v2u*)(vr + ((((tile0 + 2 * u) * 4 + g) ^ sw) * 8)), hi = *(const LAS v2u*)(vr + ((((tile0 + 2 * u + 1) * 4 + g) ^ sw) * 8));
                const v4u av = (v4u){lo.x, lo.y, hi.x, hi.y};
                oacc[dt] = MFMA16(__builtin_bit_cast(bf16x8, av), pfr, oacc[dt]); } }
#pragma unroll
        for (int dt = 0; dt < 4; ++dt) { const f32x4 o = oacc[dt] * inv; v2u wv; wv.x = cvt_pk_bf16(o[0], o[1]); wv.y = cvt_pk_bf16(o[2], o[3]);
            *(v2u*)(qrow + dt * 16 + 4 * g) = wv; }
    }
    __syncthreads();
}

__device__ __forceinline__ void phase_fin(KArg P, int L, int vcu, int G) {
    const int tid = opaque_tid(); const int lane = tid & 63, wave = tid >> 6; const int gw = vcu * 8 + wave, NGW = G * 8;
    bf16* Z = (bf16*)(ka_ws(P) + WS_Z); const float* gn = ka_in(P, 12) + L * DM;
    for (int base = gw; base < MROWS * 4; base += 8 * NGW) {
        v2u hv[8], ov[8];
#pragma unroll
        for (int k = 0; k < 8; ++k) { int pair = base + k * NGW; if (pair >= MROWS * 4) pair = gw; const int row = pair >> 2, h = pair & 3;
            hv[k] = *(const v2u*)(Z + (size_t)row * ZW + ZC_V + h * 256 + lane * 4); ov[k] = *(const v2u*)(Z + (size_t)row * ZW + ZC_O + h * 256 + lane * 4); }
#pragma unroll
        for (int k = 0; k < 8; ++k) { const int pair = base + k * NGW; if (pair >= MROWS * 4) continue; const int row = pair >> 2, h = pair & 3;
            const f32x4 gv = *(const f32x4*)(gn + h * 256 + lane * 4);
            const float x0 = bflo(hv[k].x), x1 = bfhi(hv[k].x), x2 = bflo(hv[k].y), x3 = bfhi(hv[k].y);
            const float ss = wave_sum_dpp((x0 * x0 + x1 * x1) + (x2 * x2 + x3 * x3));
            const float r = rsqrtf(ss * (1.0f / 256.0f) + EPS);
            v2u o; o.x = cvt_pk_bf16(bflo(ov[k].x) * x0 * r * gv[0], bfhi(ov[k].x) * x1 * r * gv[1]); o.y = cvt_pk_bf16(bflo(ov[k].y) * x2 * r * gv[2], bfhi(ov[k].y) * x3 * r * gv[3]);
            *(v2u*)(Z + (size_t)row * ZW + ZC_V + h * 256 + lane * 4) = o; } }
}


#define XB_TMO      128
#define XB_XCNT(j)  (256  + 64 * (j))
#define XB_XSUB(j)  (1280 + 64 * (j))
#define XB_XGEN(j)  (2304 + 64 * (j))
#define XB_TOP      3328
#define XB_TOPGEN   3392
#define XCD_BAR_WORDS 3456
#define XB_SPIN_CAP (1u << 24)
constexpr size_t WS_BAR = 60 * MiB;
constexpr int LDS_XB = 147400;
__device__ __forceinline__ unsigned xb_ld(unsigned* p)              { return __hip_atomic_load(p, __ATOMIC_RELAXED, __HIP_MEMORY_SCOPE_AGENT); }
__device__ __forceinline__ unsigned xb_add(unsigned* p, unsigned v) { return __hip_atomic_fetch_add(p, v, __ATOMIC_RELAXED, __HIP_MEMORY_SCOPE_AGENT); }
__device__ __forceinline__ unsigned xb_xcc_id() { return (unsigned)__builtin_amdgcn_s_getreg((3 << 11) | 20) & 0xFu; }
#define XB_SPIN(cond, bar) do { unsigned _sp = 0; while (cond) { __builtin_amdgcn_s_sleep(1); \
    if ((++_sp & 255u) == 0u) { if (xb_ld(&(bar)[XB_TMO])) break; if (_sp > XB_SPIN_CAP) { atomicAdd(&(bar)[XB_TMO], 1u); break; } } } } while (0)
__device__ __forceinline__ void xcd_barrier_complete(unsigned* bar, unsigned x, unsigned& nloc, unsigned& nx) {
    const unsigned G = gridDim.x * gridDim.y * gridDim.z;
    unsigned sum, cnt, mine, sp = 0u;
    for (;;) {
        sum = 0u; cnt = 0u; mine = 0u;
#pragma unroll
        for (unsigned j = 0; j < 16; ++j) { const unsigned c = xb_ld(&bar[XB_XCNT(j)]); sum += c; cnt += (c > 0u) ? 1u : 0u; mine = (j == x) ? c : mine; }
        if (sum == G) break;
        __builtin_amdgcn_s_sleep(1);
        if ((++sp & 255u) == 0u) { if (xb_ld(&bar[XB_TMO])) break; if (sp > XB_SPIN_CAP) { atomicAdd(&bar[XB_TMO], 1u); break; } }
    }
    nloc = mine > 0u ? mine : 1u; nx = cnt > 0u ? cnt : 1u;
}
__device__ __forceinline__ void xcd_barrier(unsigned* bar, volatile LAS unsigned* st) {
    asm volatile("s_waitcnt vmcnt(0)" ::: "memory");
    __syncthreads();
    if (threadIdx.x == 0) {
        const unsigned x = xb_xcc_id();
        __builtin_amdgcn_s_waitcnt(0);
        unsigned nloc = st[0], nx = st[1];
        if (nloc == 0u) { xcd_barrier_complete(bar, x, nloc, nx); st[0] = nloc; st[1] = nx; }
        const unsigned old = xb_add(&bar[XB_XSUB(x)], 1u);
        const unsigned gen = old / nloc;
        if (old + 1u == (gen + 1u) * nloc) {
            __builtin_amdgcn_fence(__ATOMIC_RELEASE, "agent");
            asm volatile("s_waitcnt vmcnt(0)" ::: "memory");
            const unsigned og = xb_add(&bar[XB_TOP], 1u);
            const unsigned tg = og / nx;
            if (og + 1u == (tg + 1u) * nx) xb_add(&bar[XB_TOPGEN], 1u);
            else XB_SPIN(xb_ld(&bar[XB_TOPGEN]) == tg, bar);
            __builtin_amdgcn_fence(__ATOMIC_ACQUIRE, "agent");
            xb_add(&bar[XB_XGEN(x)], 1u);
            asm volatile("s_waitcnt vmcnt(0)" ::: "memory");
        } else {
            XB_SPIN(xb_ld(&bar[XB_XGEN(x)]) == gen, bar);
            __builtin_amdgcn_fence(__ATOMIC_ACQUIRE, "agent");
            asm volatile("s_waitcnt vmcnt(0)" ::: "memory");
        }
    }
    __syncthreads();
}

constexpr int PH_PER_LAYER = 12;
#define PH_STOP 24
__global__ void __launch_bounds__(512, 2) hybrid_fwd(Params Pk) {
    LAS unsigned char* lds = (LAS unsigned char*)g_lds;
    cg::grid_group grid = cg::this_grid();
    if (threadIdx.x < 2) ((LAS unsigned*)(lds + LDS_XB))[threadIdx.x] = 0u;
    { const KArg P0 = ka_get(); unsigned* bar0 = (unsigned*)(ka_ws(P0) + WS_BAR); if (threadIdx.x == 0) (void)xb_add(&bar0[XB_XCNT(xb_xcc_id())], 1u); }
    __syncthreads();
    bool first = true;
    const int ph_lo = Pk.ph_lo, ph_hi = Pk.ph_hi;
    for (int ph = ph_lo; ph < ph_hi; ++ph) {
        if (!first) {
            if (ph_lo < 0) {
                asm volatile("s_waitcnt vmcnt(0) lgkmcnt(0)" ::: "memory"); grid.sync(); __builtin_amdgcn_fence(__ATOMIC_ACQUIRE, "agent"); asm volatile("s_waitcnt vmcnt(0)" ::: "memory");
            } else { const KArg Pb = ka_get(); xcd_barrier((unsigned*)(ka_ws(Pb) + WS_BAR), (volatile LAS unsigned*)(lds + LDS_XB)); }
        }
        first = false;
        const KArg P = ka_get();
        unsigned char* ws = ka_ws(P); float* out = ka_out(P); int G = gridDim.x, bx = blockIdx.x;
        asm volatile("" : "+s"(G), "+s"(bx));
        const int vcu = (G % 8 == 0) ? (bx % 8) * (G / 8) + bx / 8 : bx;
        bf16* Z = (bf16*)(ws + WS_Z); bf16* HB = (bf16*)(ws + WS_HB); bf16* HB2 = (bf16*)(ws + WS_HB2); bf16* HID = (bf16*)(ws + WS_HID); bf16* PPb = (bf16*)(ws + WS_PP); bf16* T = (bf16*)out;
        const int L = ph / PH_PER_LAYER, q = ph % PH_PER_LAYER;
        float* RSA = (float*)(ws + WS_RSA); float* RSB = (float*)(ws + WS_RSB);
        pg8::StaticOrder S;
        switch (q) {
                case 0: phase_convert(P, L, lds, vcu, G); break;
        case 1: { pg8::Gemm gm{HB2, (const bf16*)(ws + WS_WGU1), MROWS, 5632, DM, DM, DM}; S.init(MROWS, 5632, G, bx);
                  EpiSwiglu E{HID, RSA}; pg8::gemm_phase<EpiSwiglu, true>(lds, gm, S, E); } break;
        case 2: { pg8::Gemm gm{HID, (const bf16*)(ws + WS_WD1), MROWS, DM, DFFP, DFFP, DFFP}; S.init(MROWS, DM, G, bx);
                  EpiRes<0> E{L == 0 ? ka_in(P, 0) : nullptr, nullptr, HB, RSB, 0.5f, nullptr, nullptr, L == 0 ? nullptr : HB2}; pg8::gemm_phase<EpiRes<0>, true>(lds, gm, S, E); } break;
        case 3: { pg8::Gemm gm{HB, (const bf16*)(ws + WS_WIN), MROWS, 5888, DM, DM, DM}; S.init(MROWS, 5888, G, bx);
                  EpiBf<4> E{Z, ZW, nullptr, 0, nullptr, 0, RSB, (float*)(ws + WS_GIF), (bf16*)(ws + WS_HALO)}; pg8::gemm_phase<EpiBf<4>, true>(lds, gm, S, E); } break;
        case 4: {
            conv_pass(P, L, vcu, G);
            for (int u = vcu; u < 1024; u += G) attn_unit(P, L, u >> 7, (u >> 2) & 31, u & 3, lds);
        } break;
        case 5: {
            for (int u = bx; u < 256; u += G) { const int bh = (u >> 6) * 8 + (u & 7), vs = (u >> 3) & 7; mlstm_unit(P, L, bh >> 2, bh & 3, vs, lds); }
        } break;
        case 6: { phase_fin(P, L, vcu, G);
                  pg8::Gemm gm{HB, (const bf16*)(ws + WS_WIN) + (size_t)5888 * DM, MROWS, 2048, DM, DM, DM}; S.init(MROWS, 2048, G, bx);
                  EpiBf<1> E{Z, ZW, nullptr, 0, nullptr, 0, RSB, nullptr, nullptr}; pg8::gemm_phase<EpiBf<1>, true>(lds, gm, S, E); } break;
        case 7: {
                  { pg8::Gemm gm{Z + ZC_V, (const bf16*)(ws + WS_WA), MROWS, DM, DM, ZW, DM}; S.init(MROWS, DM, G, bx);
                    EpiBf<2> E{T, DM, Z, ZW, nullptr, 0, nullptr, nullptr, nullptr}; pg8::gemm_phase<EpiBf<2>, true>(lds, gm, S, E); }
                  { pg8::Gemm gm{Z + ZC_AQ, (const bf16*)(ws + WS_WB), MROWS, DM, DM, ZW, DM}; S.init(MROWS, DM, G, bx);
                    EpiBf<3> E{Z, ZW, T, DM, Z + 1024, ZW, nullptr, nullptr, nullptr}; pg8::gemm_phase<EpiBf<3>, true>(lds, gm, S, E); } } break;
        case 8: { pg8::Gemm gm{Z, (const bf16*)(ws + WS_WOUT), MROWS, DM, DM, ZW, DM}; S.init(MROWS, DM, G, bx);
                  EpiRes<0> E{nullptr, nullptr, HB, RSA, 1.0f, nullptr, nullptr, HB}; pg8::gemm_phase<EpiRes<0>, true>(lds, gm, S, E); } break;
        case 9: { pg8::Gemm gm{HB, (const bf16*)(ws + WS_WGU2), MROWS, 5632, DM, DM, DM}; S.init(MROWS, 5632, G, bx);
                  EpiSwiglu E{HID, RSA}; pg8::gemm_phase<EpiSwiglu, true>(lds, gm, S, E); } break;
        case 10: { { pg8::Gemm gm{HID, (const bf16*)(ws + WS_WD2), MROWS, DM, DFFP, DFFP, DFFP}; S.init(MROWS, DM, G, bx);
                     EpiRes<0> E{nullptr, nullptr, HB, RSB, 0.5f, nullptr, nullptr, HB}; pg8::gemm_phase<EpiRes<0>, true>(lds, gm, S, E); }
                   { pg8::Gemm gm{(const bf16*)(ws + WS_PBF), (const bf16*)(ws + WS_WP), MROWS, DM, PLE, PLE, PLE}; S.init(MROWS, DM, G, bx);
                     EpiBf<0> E{PPb, DM, nullptr, 0, nullptr, 0, nullptr, nullptr}; pg8::gemm_phase<EpiBf<0>, true>(lds, gm, S, E); } } break;
        case 11: { pg8::Gemm gm{HB, (const bf16*)(ws + WS_WPG), MROWS, DM, DM, DM, DM}; S.init(MROWS, DM, G, bx);
                   EpiRes<1> E{nullptr, L == 1 ? out : nullptr, L == 1 ? nullptr : HB2, RSA, 1.0f, RSB, PPb, HB}; pg8::gemm_phase<EpiRes<1>, true>(lds, gm, S, E); } break;
        }
    }
}

extern "C" void kernel_launch(void* const* d_in, const int* in_sizes, int n_in, void* d_out, int out_size, void* d_ws, size_t ws_size, hipStream_t stream) {
    static int grid = 0;
    if (grid == 0) {
        if (n_in != 26 || out_size != MROWS * DM || ws_size < WS_END) { fprintf(stderr, "kernel_launch: unexpected problem (n_in %d out %d ws %zu)\n", n_in, out_size, ws_size); grid = -1; return; }
        int dev = 0, cus = 0, per_cu = 0;
        hipGetDevice(&dev); hipDeviceGetAttribute(&cus, hipDeviceAttributeMultiprocessorCount, dev);
        hipFuncSetAttribute((const void*)hybrid_fwd, hipFuncAttributeMaxDynamicSharedMemorySize, LDS_BYTES);
        hipOccupancyMaxActiveBlocksPerMultiprocessor(&per_cu, (const void*)hybrid_fwd, 512, LDS_BYTES);
        if (per_cu < 1) { fprintf(stderr, "kernel_launch: occupancy query says %d blocks/CU\n", per_cu); per_cu = 1; }
        (void)hipGetLastError();
        grid = cus;
    }
    if (grid < 0) return;
    if (hipMemsetAsync((char*)d_ws + WS_BAR, 0, 16384, stream) != hipSuccess) { fprintf(stderr, "kernel_launch: memset of barrier words failed\n"); return; }
    Params p{};
    for (int i = 0; i < 26; ++i) p.in[i] = (const float*)d_in[i];
    p.out = (float*)d_out; p.ws = (unsigned char*)d_ws; p.ph_lo = 0; p.ph_hi = PH_STOP;
    void* args[] = {&p};
    hipError_t e = hipLaunchCooperativeKernel((const void*)hybrid_fwd, dim3(grid), dim3(512), args, LDS_BYTES, stream);
    if (e != hipSuccess) fprintf(stderr, "cooperative launch failed: %s (grid %d)\n", hipGetErrorString(e), grid);
}
```
